# Optimizing an MI355X kernel written in HIP

```python
import jax, jax.numpy as jnp
from jax import lax
import numpy as np

D_MODEL = 1024
BATCH = 4
SEQ = 8192
DEPTH = 2
DEC_BATCH = 32
DEC_SEQ = 64
PAST_LEN = 2048

CHUNK = 64
PLE_DIM = 256
FFN_DIM = 2816
SB_HEADS = 8
SB_HEAD_DIM = 64
SB_WIDTH = SB_HEADS * SB_HEAD_DIM
SB_BLOCK = 128
GLA_HEADS = 4
GLA_KEY_DIM = 32
GLA_VAL_DIM = 64
GLA_KEY_WIDTH = GLA_HEADS * GLA_KEY_DIM
GLA_VAL_WIDTH = GLA_HEADS * GLA_VAL_DIM
GLA_GATE_RANK = 16
GLA_GATE_TAU = 16.0
POOL_WINDOWS = (2, 4, 8, 16)
POOL_GROUP_DIM = 64
POOL_WIDTH = len(POOL_WINDOWS) * POOL_GROUP_DIM
POOL_HIST = 15
N_BRANCH = 3
IN_SPLITS = (SB_WIDTH, SB_WIDTH, SB_WIDTH, GLA_KEY_WIDTH, GLA_KEY_WIDTH, GLA_VAL_WIDTH, GLA_GATE_RANK, GLA_VAL_WIDTH, POOL_WIDTH, N_BRANCH * D_MODEL)
IN_WIDTH = sum(IN_SPLITS)
RMS_EPS = 1e-6

kernel_name = 'hybrid_streaming_encoder_step'


def rms_norm(x, g):
    xf = x.astype(jnp.float32)
    y = xf * lax.rsqrt(jnp.mean(xf * xf, axis=-1, keepdims=True) + RMS_EPS)
    return (y * g.astype(jnp.float32)).astype(x.dtype)


def swiglu(x, w_in, w_out):
    a, b = jnp.split(x @ w_in, 2, axis=-1)
    return (jax.nn.silu(a) * b) @ w_out


def stick_breaking(q, k, v, n_past):
    B, T, H, d = q.shape
    qb = min(SB_BLOCK, T)
    nb = T // qb
    scale = SB_HEAD_DIM ** -0.5
    q_blocks = q.reshape(B, nb, qb, H, d).transpose(1, 0, 3, 2, 4)
    pos_blocks = (n_past + jnp.arange(T)).reshape(nb, qb)
    kh = k.transpose(0, 2, 1, 3)
    vh = v.transpose(0, 2, 1, 3)
    k_pos = jnp.arange(k.shape[1])

    def block(args):
        qblk, qpos = args
        z = jnp.einsum('bhqd,bhkd->bhqk', qblk, kh, preferred_element_type=jnp.float32) * scale
        mask = k_pos[None, :] < qpos[:, None]
        log_keep = jnp.where(mask, -jax.nn.softplus(z), 0.0)
        log_w = jax.nn.log_sigmoid(z) + lax.cumsum(log_keep, axis=3, reverse=True) - log_keep
        w = jnp.where(mask, jnp.exp(log_w), 0.0)
        return jnp.einsum('bhqk,bhkd->bhqd', w.astype(vh.dtype), vh)

    out = lax.map(block, (q_blocks, pos_blocks))
    return out.transpose(1, 0, 3, 2, 4).reshape(B, T, H * d)


def gla(q, k, v, log_alpha, s0):
    B, T, H, _ = q.shape
    c = min(CHUNK, T)
    n = T // c

    def chunks(a):
        return a.astype(jnp.float32).reshape(B, n, c, H, a.shape[-1]).transpose(1, 0, 3, 2, 4)

    causal = jnp.tril(jnp.ones((c, c), dtype=bool))

    def step(s, inp):
        qc, kc, vc, gc = inp
        b = jnp.cumsum(gc, axis=2)
        inter = jnp.einsum('bhtd,bhde->bhte', qc * jnp.exp(b), s)
        diff = b[:, :, :, None, :] - b[:, :, None, :, :]
        decay = jnp.exp(jnp.where(causal[:, :, None], diff, -jnp.inf))
        scores = jnp.einsum('bhtd,bhsd,bhtsd->bhts', qc, kc, decay)
        intra = jnp.einsum('bhts,bhse->bhte', scores, vc)
        b_last = b[:, :, -1:, :]
        s_new = jnp.exp(b_last[:, :, 0, :])[..., None] * s + jnp.einsum('bhsd,bhse->bhde', kc * jnp.exp(b_last - b), vc)
        return s_new, inter + intra

    s_fin, o = lax.scan(step, s0.astype(jnp.float32), (chunks(q), chunks(k), chunks(v), chunks(log_alpha)))
    return o.transpose(1, 0, 3, 2, 4).reshape(B, T, H, -1), s_fin


def pool_mixer(u, hist, n_past, pool_w, pool_scale):
    B, T, _ = u.shape
    ext = jnp.concatenate([hist.astype(jnp.float32), u.astype(jnp.float32)], axis=1)
    cs = jnp.concatenate([jnp.zeros((B, 1, POOL_WIDTH), jnp.float32), jnp.cumsum(ext, axis=1)], axis=1)
    pos = n_past + jnp.arange(T)
    uf = u.astype(jnp.float32)
    outs = []
    for gi, w in enumerate(POOL_WINDOWS):
        lo, hi = gi * POOL_GROUP_DIM, (gi + 1) * POOL_GROUP_DIM
        wsum = cs[:, POOL_HIST + 1:, lo:hi] - cs[:, POOL_HIST + 1 - w:POOL_HIST + 1 - w + T, lo:hi]
        cnt = jnp.minimum(w, pos + 1).astype(jnp.float32)[None, :, None]
        outs.append(wsum / cnt - uf[..., lo:hi])
    d = jnp.stack(outs, axis=2)
    y = jnp.einsum('btgc,gcd->btgd', d, pool_w.astype(jnp.float32)).reshape(B, T, POOL_WIDTH)
    y = y * pool_scale.astype(jnp.float32)
    return y.astype(u.dtype), ext[:, -POOL_HIST:]


def token_mixer(h, k_cache, v_cache, s0, pool_hist, w):
    B, T, _ = h.shape
    n_past = k_cache.shape[1]
    proj = h @ w['w_in']
    parts = []
    off = 0
    for size in IN_SPLITS:
        parts.append(proj[..., off:off + size])
        off += size
    q_a, k_a, v_a, q_b, k_b, v_b, r_b, o_b, u_c, gate_logits = parts

    k_a = k_a.reshape(B, T, SB_HEADS, SB_HEAD_DIM).astype(k_cache.dtype)
    v_a = v_a.reshape(B, T, SB_HEADS, SB_HEAD_DIM).astype(v_cache.dtype)
    k_all = jnp.concatenate([k_cache, k_a], axis=1)
    v_all = jnp.concatenate([v_cache, v_a], axis=1)
    y_a = stick_breaking(q_a.reshape(B, T, SB_HEADS, SB_HEAD_DIM), k_all, v_all, n_past).astype(h.dtype)

    log_alpha = jax.nn.log_sigmoid((r_b @ w['gla_w_gate'] + w['gla_b_gate']).astype(jnp.float32)) / GLA_GATE_TAU
    o, s_new = gla(q_b.reshape(B, T, GLA_HEADS, GLA_KEY_DIM) * (GLA_KEY_DIM ** -0.5),
                   k_b.reshape(B, T, GLA_HEADS, GLA_KEY_DIM),
                   v_b.reshape(B, T, GLA_HEADS, GLA_VAL_DIM),
                   log_alpha.reshape(B, T, GLA_HEADS, GLA_KEY_DIM), s0)
    o = rms_norm(o, w['gla_norm'].reshape(GLA_HEADS, GLA_VAL_DIM)).reshape(B, T, GLA_VAL_WIDTH)
    y_b = o.astype(h.dtype) * jax.nn.silu(o_b)

    y_c, pool_new = pool_mixer(u_c, pool_hist, n_past, w['pool_w'], w['pool_scale'])

    gates = jax.nn.sigmoid(gate_logits.astype(jnp.float32)).astype(h.dtype).reshape(B, T, N_BRANCH, D_MODEL)
    merged = (gates[:, :, 0] * (y_a @ w['w_branch_a'])
              + gates[:, :, 1] * (y_b @ w['w_branch_b'])
              + gates[:, :, 2] * (y_c @ w['w_branch_c']))
    return merged @ w['w_out'], k_a, v_a, s_new.astype(s0.dtype), pool_new.astype(pool_hist.dtype)


def run_trunk(x, p, k_cache, v_cache, s_gla, s_pool, weights):
    ks, vs, ss, ps = [], [], [], []
    for i in range(DEPTH):
        w = {name: arr[i] for name, arr in weights.items()}
        x = x + 0.5 * swiglu(rms_norm(x, w['ffn1_norm']), w['ffn1_w_in'], w['ffn1_w_out'])
        mix, k_new, v_new, s_new, pool_new = token_mixer(rms_norm(x, w['mix_norm']), k_cache[i], v_cache[i], s_gla[i], s_pool[i], w)
        x = x + mix
        x = x + 0.5 * swiglu(rms_norm(x, w['ffn2_norm']), w['ffn2_w_in'], w['ffn2_w_out'])
        x = x + jax.nn.sigmoid(rms_norm(x, w['ple_norm']) @ w['ple_w_gate']) * (p[i] @ w['ple_w_proj'])
        ks.append(k_new)
        vs.append(v_new)
        ss.append(s_new)
        ps.append(pool_new)
    return x, jnp.stack(ks), jnp.stack(vs), jnp.stack(ss), jnp.stack(ps)


def setup_inputs(seed: int = 0) -> dict:
    key = jax.random.key(seed)
    ks = jax.random.split(key, 32)

    def normal(k, shape, scale):
        return jax.random.normal(k, shape, jnp.float32) * scale

    return {
        'x_prompt': normal(ks[0], (BATCH, SEQ, D_MODEL), 1.0),
        'x_sample': normal(ks[1], (DEC_BATCH, DEC_SEQ, D_MODEL), 1.0),
        'cache_sb_k': normal(ks[2], (DEPTH, DEC_BATCH, PAST_LEN, SB_HEADS, SB_HEAD_DIM), 1.0),
        'cache_sb_v': normal(ks[3], (DEPTH, DEC_BATCH, PAST_LEN, SB_HEADS, SB_HEAD_DIM), 1.0),
        'state_gla': normal(ks[4], (DEPTH, DEC_BATCH, GLA_HEADS, GLA_KEY_DIM, GLA_VAL_DIM), 1.0),
        'state_pool': normal(ks[5], (DEPTH, DEC_BATCH, POOL_HIST, POOL_WIDTH), 1.0),
        'p_prompt': normal(ks[6], (DEPTH, BATCH, SEQ, PLE_DIM), 1.0),
        'p_sample': normal(ks[7], (DEPTH, DEC_BATCH, DEC_SEQ, PLE_DIM), 1.0),
        'ffn1_norm': 1.0 + normal(ks[8], (DEPTH, D_MODEL), 0.02),
        'ffn1_w_in': normal(ks[9], (DEPTH, D_MODEL, 2 * FFN_DIM), D_MODEL ** -0.5),
        'ffn1_w_out': normal(ks[10], (DEPTH, FFN_DIM, D_MODEL), FFN_DIM ** -0.5),
        'mix_norm': 1.0 + normal(ks[11], (DEPTH, D_MODEL), 0.02),
        'w_in': normal(ks[12], (DEPTH, D_MODEL, IN_WIDTH), D_MODEL ** -0.5),
        'gla_w_gate': normal(ks[13], (DEPTH, GLA_GATE_RANK, GLA_KEY_WIDTH), GLA_GATE_RANK ** -0.5),
        'gla_b_gate': normal(ks[14], (DEPTH, GLA_KEY_WIDTH), 0.01),
        'gla_norm': 1.0 + normal(ks[15], (DEPTH, GLA_VAL_WIDTH), 0.02),
        'pool_w': normal(ks[16], (DEPTH, len(POOL_WINDOWS), POOL_GROUP_DIM, POOL_GROUP_DIM), POOL_GROUP_DIM ** -0.5),
        'pool_scale': 1.0 + normal(ks[17], (DEPTH, POOL_WIDTH), 0.02),
        'w_branch_a': normal(ks[18], (DEPTH, SB_WIDTH, D_MODEL), SB_WIDTH ** -0.5),
        'w_branch_b': normal(ks[19], (DEPTH, GLA_VAL_WIDTH, D_MODEL), GLA_VAL_WIDTH ** -0.5),
        'w_branch_c': normal(ks[20], (DEPTH, POOL_WIDTH, D_MODEL), POOL_WIDTH ** -0.5),
        'w_out': normal(ks[21], (DEPTH, D_MODEL, D_MODEL), D_MODEL ** -0.5),
        'ffn2_norm': 1.0 + normal(ks[22], (DEPTH, D_MODEL), 0.02),
        'ffn2_w_in': normal(ks[23], (DEPTH, D_MODEL, 2 * FFN_DIM), D_MODEL ** -0.5),
        'ffn2_w_out': normal(ks[24], (DEPTH, FFN_DIM, D_MODEL), FFN_DIM ** -0.5),
        'ple_norm': 1.0 + normal(ks[25], (DEPTH, D_MODEL), 0.02),
        'ple_w_gate': normal(ks[26], (DEPTH, D_MODEL, D_MODEL), D_MODEL ** -0.5),
        'ple_w_proj': normal(ks[27], (DEPTH, PLE_DIM, D_MODEL), PLE_DIM ** -0.5),
        'final_norm': 1.0 + normal(ks[28], (D_MODEL,), 0.02),
    }


def reference(x_prompt, x_sample, cache_sb_k, cache_sb_v, state_gla, state_pool, p_prompt, p_sample,
              ffn1_norm, ffn1_w_in, ffn1_w_out, mix_norm, w_in, gla_w_gate, gla_b_gate, gla_norm,
              pool_w, pool_scale, w_branch_a, w_branch_b, w_branch_c, w_out,
              ffn2_norm, ffn2_w_in, ffn2_w_out, ple_norm, ple_w_gate, ple_w_proj, final_norm):
    weights = dict(ffn1_norm=ffn1_norm, ffn1_w_in=ffn1_w_in, ffn1_w_out=ffn1_w_out, mix_norm=mix_norm,
                   w_in=w_in, gla_w_gate=gla_w_gate, gla_b_gate=gla_b_gate, gla_norm=gla_norm,
                   pool_w=pool_w, pool_scale=pool_scale, w_branch_a=w_branch_a, w_branch_b=w_branch_b,
                   w_branch_c=w_branch_c, w_out=w_out, ffn2_norm=ffn2_norm, ffn2_w_in=ffn2_w_in,
                   ffn2_w_out=ffn2_w_out, ple_norm=ple_norm, ple_w_gate=ple_w_gate, ple_w_proj=ple_w_proj)
    b_prompt = x_prompt.shape[0]
    empty_kv = jnp.zeros((DEPTH, b_prompt, 0, SB_HEADS, SB_HEAD_DIM), cache_sb_k.dtype)
    zero_gla = jnp.zeros((DEPTH, b_prompt, GLA_HEADS, GLA_KEY_DIM, GLA_VAL_DIM), state_gla.dtype)
    zero_pool = jnp.zeros((DEPTH, b_prompt, POOL_HIST, POOL_WIDTH), state_pool.dtype)
    h_prompt, sb_k_prompt, sb_v_prompt, gla_state_prompt, pool_state_prompt = run_trunk(
        x_prompt, p_prompt, empty_kv, empty_kv, zero_gla, zero_pool, weights)
    h_sample, sb_k_sample, sb_v_sample, gla_state_sample, pool_state_sample = run_trunk(
        x_sample, p_sample, cache_sb_k, cache_sb_v, state_gla, state_pool, weights)
    y_prompt = rms_norm(h_prompt, final_norm)
    y_sample = rms_norm(h_sample, final_norm)
    return (y_prompt, y_sample, sb_k_prompt, sb_v_prompt, gla_state_prompt, pool_state_prompt,
            sb_k_sample, sb_v_sample, gla_state_sample, pool_state_sample)
```

```cpp
#include <hip/hip_runtime.h>
#include <hip/hip_cooperative_groups.h>
#include <cstdio>
#include <cstdint>
namespace cg = cooperative_groups;

#ifndef MK_SKIPMASK
#define MK_SKIPMASK 0
#endif
#ifndef MK_NOATTN
#define MK_NOATTN 0
#endif
#ifndef MK_NOGLAOUT
#define MK_NOGLAOUT 0
#endif
#ifndef MK_ONE_LAUNCH
#define MK_ONE_LAUNCH 1
#endif

#define LAS __attribute__((address_space(3)))
typedef unsigned short bf16_t;
typedef short bf16x8 __attribute__((ext_vector_type(8)));
typedef float f32x4 __attribute__((ext_vector_type(4)));
typedef unsigned u32x4 __attribute__((ext_vector_type(4)));
typedef unsigned u32x2 __attribute__((ext_vector_type(2)));

constexpr int M = 34816;
constexpr int MP = 32768;
constexpr int D = 1024, FF = 2816, NIN = 5888, PW = 5888  , INW = 5648;
constexpr int NCH = 544;
constexpr float EPS = 1e-6f;
constexpr size_t O_Y = 0, O_KP = 35651584, O_VP = 69206016, O_GP = 102760448, O_PP = 102825984, O_KS = 102856704, O_VS = 104953856, O_GS = 107051008, O_PS = 107575296;
constexpr int C_QA = 0, C_KA = 512, C_VA = 1024, C_QB = 1536, C_KB = 1664, C_VB = 1792, C_OB = 2048, C_UC = 2304, C_G = 2560, C_RB = 5632;

constexpr size_t WL_1IN = 0, WL_1OUT = WL_1IN + (size_t)5632 * 1024, WL_IN = WL_1OUT + (size_t)1024 * 2816, WL_BR = WL_IN + (size_t)5888 * 1024, WL_OUT = WL_BR + 1048576,
                 WL_2IN = WL_OUT + 1048576, WL_2OUT = WL_2IN + (size_t)5632 * 1024, WL_PG = WL_2OUT + (size_t)1024 * 2816, WL_PP = WL_PG + 1048576, WL_END = WL_PP + 262144;
constexpr size_t MiB = 1u << 20;
constexpr size_t WS_W = 0;
constexpr size_t WS_XB = 104 * MiB;
constexpr size_t WS_PB = 172 * MiB;
constexpr size_t WS_BIG = 208 * MiB;
constexpr size_t WS_Y = 600 * MiB;
constexpr size_t WS_MG = 668 * MiB;
constexpr size_t WS_SCR = 736 * MiB;
constexpr size_t WS_SS = 934 * MiB;
constexpr size_t WS_DS = 878 * MiB;
constexpr size_t WS_ST = 896 * MiB;
constexpr size_t WS_B = 914 * MiB;
constexpr size_t WS_DEC = 932 * MiB;
constexpr size_t WS_CTL = 933 * MiB;
constexpr size_t WS_NEED = 944 * MiB;
static_assert(2 * WL_END * 2 <= 104 * MiB, "weights fit");

__device__ __forceinline__ unsigned f2bf(float f) { unsigned u = __builtin_bit_cast(unsigned, f); return (u + 0x7fffu + ((u >> 16) & 1u)) >> 16; }
__device__ __forceinline__ unsigned pk2(float lo, float hi) { unsigned r; asm("v_cvt_pk_bf16_f32 %0, %1, %2" : "=v"(r) : "v"(lo), "v"(hi)); return r; }
__device__ __forceinline__ float bflo(unsigned u) { return __uint_as_float(u << 16); }
__device__ __forceinline__ float bfhi(unsigned u) { return __uint_as_float(u & 0xffff0000u); }
__device__ __forceinline__ float bf2f(bf16_t b) { return __uint_as_float((unsigned)b << 16); }
__device__ __forceinline__ float fexp(float x) { return __builtin_amdgcn_exp2f(x * 1.4426950408889634f); }
__device__ __forceinline__ float flog(float x) { return __builtin_amdgcn_logf(x) * 0.6931471805599453f; }
__device__ __forceinline__ float sigm(float x) { return __builtin_amdgcn_rcpf(1.0f + fexp(-x)); }
__device__ __forceinline__ float softplus(float z) { return fmaxf(z, 0.f) + flog(1.0f + fexp(-fabsf(z))); }
__device__ __forceinline__ float rstd_of(const float* ss, int row) {
    const f32x4* p = (const f32x4*)(ss + (size_t)row * 32);
    float s = 0.f;
#pragma unroll
    for (int i = 0; i < 8; ++i) { const f32x4 a = p[i]; s += (a[0] + a[1]) + (a[2] + a[3]); }
    return __builtin_amdgcn_rsqf(s * (1.0f / 1024.0f) + EPS);
}

namespace pg8 {
constexpr int BM = 256, BK = 64, HALF = 128, HTB = HALF * BK * 2, STAGE_BYTES = 8 * HTB, NXCD = 8, WGM = 8;
__host__ __device__ __forceinline__ int lds_byte(int r, int c) { const int st = (r >> 4) * 2 + (c >> 5), rr = r & 15, cc = c & 31, ob = rr * 64 + cc * 2; return st * 1024 + (ob ^ (((ob >> 9) & 1) << 5)); }
__host__ __device__ __forceinline__ void stage_rc(int b, int& R, int& C) { const int st = b / 1024, sb = b % 1024, swz = sb ^ (((sb >> 9) & 1) << 5); R = (st >> 1) * 16 + swz / 64; C = (st & 1) * 32 + (swz % 64) / 2; }
__host__ __device__ __forceinline__ int perm32(int rho) { const int n = rho >> 4, i = rho & 15; return 8 * (i >> 2) + 4 * n + (i & 3); }

struct Unit { int pm, pn, kind, k0, nt, qm; };
struct Gemm { const bf16_t* A; const bf16_t* Bt; int lda, ldb; };

struct Sched {
    int nM, nN, nwg, G, c, nsub, nt0, quart;
    __device__ __forceinline__ void init(int M_, int N_, int G_, int c_, int nt) { nM = M_ / BM; nN = N_ / BM; nwg = nM * nN; G = G_; c = c_; nsub = 1; nt0 = nt; quart = 0; }
    __device__ __forceinline__ bool next(int i, Unit& u) const {
        const int ti = i / nsub, sk = i - ti * nsub;
        long L = (long)ti * G + c; int qm = 0xF;
        const int nfull = nwg / G;
        if (quart && ti >= nfull) {
            const long li = (long)(ti - nfull) * G + c; if (li >= 4L * (nwg - nfull * G)) return false;
            L = (long)nfull * G + (li >> 2); qm = 1 << (int)(li & 3);
        } else if (L >= nwg) return false;
        u.qm = qm;
        int wgid = (int)L; { const int q = nwg / NXCD, r = nwg % NXCD, xcd = wgid % NXCD, off = wgid / NXCD; wgid = (xcd < r ? xcd * (q + 1) : r * (q + 1) + (xcd - r) * q) + off; }
        const int nig = WGM * nN, gid = wgid / nig, fm = gid * WGM, gsz = (nM - fm) < WGM ? (nM - fm) : WGM;
        u.pm = fm + ((wgid % nig) % gsz); u.pn = (wgid % nig) / gsz; u.kind = sk; u.k0 = (sk > 0) ? 256 + 256 * sk : 0; u.nt = (sk > 0) ? 4 : nt0; return true;
    }
};

#define PG8_KLOOP(C0, C1, C2, C3) \
        for (int t = 0; t < nt; t += 2) { \
            const bool last = (t == nt - 2); \
            const char* a1 = cA + (size_t)(t + 1) * kstep; \
            const char* a2 = last ? nA : cA + (size_t)(t + 2) * kstep; const char* b2 = last ? nB : cB + (size_t)(t + 2) * kstep; \
            const char* a3 = a2 + kstep; const char* b3 = b2 + kstep; \
            PG8_LDB(B0, 0, 0); PG8_LDB(B1, 0, 1); PG8_SCHED; PG8_LDA(At, 0, 0); PG8_STAGE(PG8_SA(1, 1), a1 + hstepA, voffA); \
            PG8_WAIT_V(8); PG8_WAIT_L(0); PG8_BAR; if (C0) PG8_MMA(0, 0, At, B0); if (C1) PG8_MMA(0, 1, At, B1); PG8_BAR; PG8_SCHED; \
            PG8_LDA(At, 0, 1); PG8_STAGE(PG8_SB(0, 0), b2, voffB); PG8_STAGE(PG8_SB(0, 1), b2 + hstepB, voffB); PG8_STAGE(PG8_SA(0, 0), a2, voffA); \
            PG8_WAIT_V(8); PG8_WAIT_L(0); PG8_BAR; if (C2) PG8_MMA(1, 0, At, B0); if (C3) PG8_MMA(1, 1, At, B1); PG8_BAR; PG8_SCHED; \
            PG8_LDB(B0, 1, 0); PG8_LDB(B1, 1, 1); PG8_SCHED; PG8_LDA(At, 1, 0); PG8_STAGE(PG8_SA(0, 1), a2 + hstepA, voffA); \
            PG8_WAIT_V(8); PG8_WAIT_L(0); PG8_BAR; if (C0) PG8_MMA(0, 0, At, B0); if (C1) PG8_MMA(0, 1, At, B1); PG8_BAR; PG8_SCHED; \
            PG8_LDA(At, 1, 1); PG8_STAGE(PG8_SB(1, 0), b3, voffB); PG8_STAGE(PG8_SB(1, 1), b3 + hstepB, voffB); PG8_STAGE(PG8_SA(1, 0), a3, voffA); \
            PG8_WAIT_V(8); PG8_WAIT_L(0); PG8_BAR; if (C2) PG8_MMA(1, 0, At, B0); if (C3) PG8_MMA(1, 1, At, B1); PG8_BAR; PG8_SCHED; \
        }
template <class Epi, class Sch>
__device__ __forceinline__ void gemm_phase(LAS unsigned char* lds, const int tid, const Gemm g, const Sch& S, const Epi& E, const float* ss) {
    const int wid = __builtin_amdgcn_readfirstlane(tid >> 6), lane = tid & 63, wr = wid >> 2, wc = wid & 3, fr = lane & 15, fq = lane >> 4;
    unsigned voffA[2], voffB[2];
#pragma unroll
    for (int i = 0; i < 2; ++i) { int R, C; stage_rc(tid * 16 + i * 8192, R, C); const int Rb = (R & ~31) + perm32(R & 31);
        voffA[i] = (unsigned)(R * g.lda + C) * 2u; voffB[i] = (unsigned)(Rb * g.ldb + C) * 2u; }
    const size_t kstep = (size_t)(BK * 2);
    const size_t hstepA = (size_t)HALF * g.lda * 2, hstepB = (size_t)HALF * g.ldb * 2;
    const size_t tstepA = 2 * hstepA, tstepB = 2 * hstepB;
    const unsigned ldsw = (unsigned)wid * 1024u;
    const int aoff = lds_byte(wr * 64 + fr, fq * 8), boff = lds_byte(wc * 32 + fr, fq * 8);
    LAS float* rtab = (LAS float*)(lds + STAGE_BYTES);
#define PG8_RTAB(pm_, buf_) do { if (ss) { const int r_ = tid >> 1, h_ = tid & 1; const f32x4* p_ = (const f32x4*)(ss + ((size_t)(pm_) * 256 + r_) * 32 + h_ * 16); \
        const f32x4 a_ = p_[0], b_ = p_[1], c_ = p_[2], d_ = p_[3]; float s_ = (((a_[0] + a_[1]) + (a_[2] + a_[3])) + ((b_[0] + b_[1]) + (b_[2] + b_[3]))) + (((c_[0] + c_[1]) + (c_[2] + c_[3])) + ((d_[0] + d_[1]) + (d_[2] + d_[3]))); \
        s_ += __shfl_xor(s_, 1); if (!h_) rtab[(buf_) * 256 + r_] = __builtin_amdgcn_rsqf(s_ * (1.0f / 1024.0f) + EPS); } } while (0)
#define PG8_SA(b, h) (((b) * 2 + (h)) * HTB)
#define PG8_SB(b, h) ((4 + (b) * 2 + (h)) * HTB)
#define PG8_STAGE(bufoff, gbase, voff) do { _Pragma("unroll") for (int _i = 0; _i < 2; ++_i) \
        __builtin_amdgcn_global_load_lds((const unsigned*)((const char*)(gbase) + (voff)[_i]), (LAS unsigned*)(lds + (bufoff) + ldsw + _i * 8192), 16, 0, 0); } while (0)
#define PG8_LDA(dst, b, h) do { _Pragma("unroll") for (int m = 0; m < 4; ++m) _Pragma("unroll") for (int k = 0; k < 2; ++k) dst[m][k] = *(const LAS bf16x8*)(lds + PG8_SA(b, h) + aoff + m * 2048 + k * 1024); } while (0)
#define PG8_LDB(dst, b, h) do { _Pragma("unroll") for (int n = 0; n < 2; ++n) _Pragma("unroll") for (int k = 0; k < 2; ++k) dst[n][k] = *(const LAS bf16x8*)(lds + PG8_SB(b, h) + boff + n * 2048 + k * 1024); } while (0)
#define PG8_MMA(ai, bj, At, Bt) do { __builtin_amdgcn_s_setprio(1); _Pragma("unroll") for (int m = 0; m < 4; ++m) _Pragma("unroll") for (int n = 0; n < 2; ++n) _Pragma("unroll") for (int k = 0; k < 2; ++k) \
        acc[ai][bj][m][n] = __builtin_amdgcn_mfma_f32_16x16x32_bf16(Bt[n][k], At[m][k], acc[ai][bj][m][n], 0, 0, 0); __builtin_amdgcn_s_setprio(0); } while (0)
#define PG8_WAIT_V(n) asm volatile("s_waitcnt vmcnt(" #n ")" ::: "memory")
#define PG8_WAIT_L(n) asm volatile("s_waitcnt lgkmcnt(" #n ")" ::: "memory")
#define PG8_BAR __builtin_amdgcn_s_barrier()
#define PG8_SCHED __builtin_amdgcn_sched_barrier(0)
    Unit cur, nxt; int ui = 0;
    if (!S.next(0, cur)) return;
    f32x4 acc[2][2][4][2];
#pragma unroll
    for (int a = 0; a < 2; ++a)
#pragma unroll
        for (int b = 0; b < 2; ++b)
#pragma unroll
            for (int m = 0; m < 4; ++m)
#pragma unroll
                for (int n = 0; n < 2; ++n) acc[a][b][m][n] = (f32x4){0.f, 0.f, 0.f, 0.f};
    bf16x8 At[4][2], B0[2][2], B1[2][2];
    const char* cA = (const char*)g.A + (size_t)cur.pm * tstepA + (size_t)cur.k0 * 2; const char* cB = (const char*)g.Bt + (size_t)cur.pn * tstepB + (size_t)cur.k0 * 2;
    PG8_RTAB(cur.pm, 0);
    PG8_STAGE(PG8_SB(0, 0), cB, voffB); PG8_STAGE(PG8_SB(0, 1), cB + hstepB, voffB); PG8_STAGE(PG8_SA(0, 0), cA, voffA); PG8_STAGE(PG8_SA(0, 1), cA + hstepA, voffA);
    if (wr == 1) PG8_BAR;
    PG8_WAIT_V(2); PG8_BAR;
    PG8_STAGE(PG8_SB(1, 0), cB + kstep, voffB); PG8_STAGE(PG8_SA(1, 0), cA + kstep, voffA); PG8_STAGE(PG8_SB(1, 1), cB + hstepB + kstep, voffB);
    PG8_WAIT_V(6); PG8_BAR;
    for (;;) {
        const bool has_next = S.next(ui + 1, nxt);
        const char* nA = has_next ? (const char*)g.A + (size_t)nxt.pm * tstepA + (size_t)nxt.k0 * 2 : cA; const char* nB = has_next ? (const char*)g.Bt + (size_t)nxt.pn * tstepB + (size_t)nxt.k0 * 2 : cB;
        const int nt = cur.nt, qm = cur.qm;
        if (qm == 0xF) { PG8_KLOOP(true, true, true, true) } else { PG8_KLOOP((qm & 1), (qm & 2), (qm & 4), (qm & 8)) }
        if (wr == 0) PG8_BAR;
        E(acc, cur, wr, wc, fr, fq, rtab + (ui & 1) * 256);
        if (!has_next) break;
#pragma unroll
        for (int a = 0; a < 2; ++a)
#pragma unroll
            for (int b = 0; b < 2; ++b)
#pragma unroll
                for (int m = 0; m < 4; ++m)
#pragma unroll
                    for (int n = 0; n < 2; ++n) acc[a][b][m][n] = (f32x4){0.f, 0.f, 0.f, 0.f};
        cur = nxt; cA = nA; cB = nB; ++ui;
        PG8_RTAB(cur.pm, ui & 1);
        if (wr == 1) PG8_BAR;
    }
    PG8_WAIT_V(0);
    PG8_BAR;
#undef PG8_SA
#undef PG8_RTAB
#undef PG8_SB
#undef PG8_STAGE
#undef PG8_LDA
#undef PG8_LDB
#undef PG8_MMA
#undef PG8_WAIT_V
#undef PG8_WAIT_L
#undef PG8_BAR
#undef PG8_SCHED
}
}
using pg8::Unit;

#define EPI_FENCE() asm volatile("" ::: "memory")
struct EpiSwiglu {
    bf16_t* hid;
    __device__ __forceinline__ void operator()(const f32x4 (&acc)[2][2][4][2], const Unit& u, int wr, int wc, int fr, int fq, const LAS float* rt) const {
        const int row0 = u.pm * 256 + wr * 64 + fr, col = u.pn * 128 + wc * 32 + 8 * fq;
#pragma unroll
        for (int ai = 0; ai < 2; ++ai)
#pragma unroll
            for (int m = 0; m < 4; ++m) {
                const int rl = ai * 128 + m * 16; const int row = row0 + rl; const float rs = rt[wr * 64 + fr + rl];
                float h[8];
#pragma unroll
                for (int n = 0; n < 2; ++n)
#pragma unroll
                    for (int i = 0; i < 4; ++i) { const float a = acc[ai][0][m][n][i] * rs, b = acc[ai][1][m][n][i] * rs; h[4 * n + i] = a * sigm(a) * b; }
                u32x4 w; w.x = pk2(h[0], h[1]); w.y = pk2(h[2], h[3]); w.z = pk2(h[4], h[5]); w.w = pk2(h[6], h[7]);
                *(u32x4*)(hid + (size_t)row * FF + col) = w;
            }
    }
};
struct EpiWin {
    bf16_t* proj; float* out; int layer;
    __device__ __forceinline__ void operator()(const f32x4 (&acc)[2][2][4][2], const Unit& u, int wr, int wc, int fr, int fq, const LAS float* rt) const {
        const int row0 = u.pm * 256 + wr * 64 + fr, pn = u.pn;
        const bool isgate = (pn >= 10 && pn < 22), iskv = (pn >= 2 && pn < 6), ispool = (pn == 9);
#pragma unroll
        for (int ai = 0; ai < 2; ++ai)
#pragma unroll
            for (int m = 0; m < 4; ++m) {
                const int rl = ai * 128 + m * 16; const int row = row0 + rl; const float rs = rt[wr * 64 + fr + rl];
#pragma unroll
                for (int bj = 0; bj < 2; ++bj) {
                    if (!((u.qm >> (ai * 2 + bj)) & 1)) continue;
                    const int ct = bj * 128 + wc * 32 + 8 * fq;
                    f32x4 v0 = acc[ai][bj][m][0] * rs, v1 = acc[ai][bj][m][1] * rs;
                    if (isgate) {
#pragma unroll
                        for (int i = 0; i < 4; ++i) { v0[i] = sigm(v0[i]); v1[i] = sigm(v1[i]); }
                    }
                    u32x4 w; w.x = pk2(v0[0], v0[1]); w.y = pk2(v0[2], v0[3]); w.z = pk2(v1[0], v1[1]); w.w = pk2(v1[2], v1[3]);
                    *(u32x4*)(proj + (size_t)row * PW + pn * 256 + ct) = w;
                    if (iskv) {
                        const int c512 = (pn & 1) * 256 + ct; const bool isv = pn >= 4;
                        float* dst = row < MP ? out + (isv ? O_VP : O_KP) + ((size_t)layer * MP + row) * 512 + c512
                                              : out + (isv ? O_VS : O_KS) + ((size_t)layer * 2048 + (row - MP)) * 512 + c512;
                        *(f32x4*)dst = v0; *(f32x4*)(dst + 4) = v1;
                    }
                    if (ispool) {
                        if (row < MP) { const int t = row & 8191, b = row >> 13; if (t >= 8177) { float* dst = out + O_PP + ((size_t)(layer * 4 + b) * 15 + (t - 8177)) * 256 + ct; *(f32x4*)dst = v0; *(f32x4*)(dst + 4) = v1; } }
                        else { const int r = row - MP, t = r & 63, sb = r >> 6; if (t >= 49) { float* dst = out + O_PS + ((size_t)(layer * 32 + sb) * 15 + (t - 49)) * 256 + ct; *(f32x4*)dst = v0; *(f32x4*)(dst + 4) = v1; } }
                    }
                }
            }
    }
};
struct EpiRes {
    float* x; bf16_t* xb; float* ss_out; const bf16_t* scr; float alpha; int mode; const float* xin0; const float* xin1;
    __device__ __forceinline__ void operator()(const f32x4 (&acc)[2][2][4][2], const Unit& u, int wr, int wc, int fr, int fq, const LAS float* rt) const {
        const int row0 = u.pm * 256 + wr * 64 + fr, colb = u.pn * 256 + wc * 32 + 8 * fq;
#pragma unroll
        for (int ai = 0; ai < 2; ++ai) {
            if (!((u.qm >> (2 * ai)) & 3)) continue;
#pragma unroll
            for (int mp = 0; mp < 2; ++mp) {
                f32x4 xv[2][2][2]; u32x4 sv[2][2];
                const float* xr = xin0 ? (u.pm < MP / 256 ? xin0 : xin1 - (size_t)MP * D) : x;
#pragma unroll
                for (int mi = 0; mi < 2; ++mi)
#pragma unroll
                    for (int bj = 0; bj < 2; ++bj) {
                        const size_t off = (size_t)(row0 + ai * 128 + (2 * mp + mi) * 16) * D + colb + bj * 128;
                        xv[mi][bj][0] = *(const f32x4*)(xr + off); xv[mi][bj][1] = *(const f32x4*)(xr + off + 4);
                    }
#pragma unroll
                for (int mi = 0; mi < 2; ++mi) {
                    const int m = 2 * mp + mi, rl = ai * 128 + m * 16, row = row0 + rl;
                    const float rs = (mode == 1) ? rt[wr * 64 + fr + rl] : 1.f;
                    if (mode == 1) {
#pragma unroll
                        for (int bj = 0; bj < 2; ++bj) { const size_t off = (size_t)row * D + colb + bj * 128; sv[mi][bj] = *(const u32x4*)(scr + off); }
                    }
#pragma unroll
                    for (int bj = 0; bj < 2; ++bj) {
                        if (!((u.qm >> (ai * 2 + bj)) & 1)) continue;
                        const size_t off = (size_t)row * D + colb + bj * 128;
                        f32x4 v0 = acc[ai][bj][m][0], v1 = acc[ai][bj][m][1];
                        if (mode == 1) {
#pragma unroll
                            for (int i = 0; i < 4; ++i) { v0[i] = sigm(v0[i] * rs); v1[i] = sigm(v1[i] * rs); }
                            { const u32x4 p4 = sv[mi][bj]; v0[0] *= bflo(p4.x); v0[1] *= bfhi(p4.x); v0[2] *= bflo(p4.y); v0[3] *= bfhi(p4.y); v1[0] *= bflo(p4.z); v1[1] *= bfhi(p4.z); v1[2] *= bflo(p4.w); v1[3] *= bfhi(p4.w); }
                        } else { v0 = v0 * alpha; v1 = v1 * alpha; }
                        const f32x4 x0 = xv[mi][bj][0] + v0, x1 = xv[mi][bj][1] + v1;
                        *(f32x4*)(x + off) = x0; *(f32x4*)(x + off + 4) = x1;
                        u32x4 w; w.x = pk2(x0[0], x0[1]); w.y = pk2(x0[2], x0[3]); w.z = pk2(x1[0], x1[1]); w.w = pk2(x1[2], x1[3]);
                        *(u32x4*)(xb + off) = w;
                        float ssum = (x0[0] * x0[0] + x0[1] * x0[1]) + (x0[2] * x0[2] + x0[3] * x0[3]) + (x1[0] * x1[0] + x1[1] * x1[1]) + (x1[2] * x1[2] + x1[3] * x1[3]);
                        ssum += __shfl_xor(ssum, 16); ssum += __shfl_xor(ssum, 32);
                        if (fq == 0) ss_out[(size_t)row * 32 + u.pn * 8 + bj * 4 + wc] = ssum;
                    }
                }
                EPI_FENCE();
            }
        }
    }
};
struct EpiBranch {
    const bf16_t* proj; bf16_t* scr; bf16_t* merged; int mode;
    template <int BR>
    __device__ __forceinline__ void run(const f32x4 (&acc)[2][2][4][2], const Unit& u, int wr, int wc, int fr, int fq) const {
        const int row0 = u.pm * 256 + wr * 64 + fr, colb = u.pn * 256 + wc * 32 + 8 * fq;
#pragma unroll
        for (int ai = 0; ai < 2; ++ai) {
            if (!((u.qm >> (2 * ai)) & 3)) continue;
#pragma unroll
            for (int mp = 0; mp < 2; ++mp) {
                u32x4 gt[2][2], sv[2][2];
#pragma unroll
                for (int mi = 0; mi < 2; ++mi)
#pragma unroll
                    for (int bj = 0; bj < 2; ++bj) {
                        const int row = row0 + ai * 128 + (2 * mp + mi) * 16, col = colb + bj * 128; const size_t off = (size_t)row * D + col;
                        if (BR < 3) gt[mi][bj] = *(const u32x4*)(proj + (size_t)row * PW + C_G + BR * 1024 + col);
                        if (BR == 1 || BR == 2) sv[mi][bj] = *(const u32x4*)(scr + off);
                    }
#pragma unroll
                for (int mi = 0; mi < 2; ++mi)
#pragma unroll
                    for (int bj = 0; bj < 2; ++bj) {
                        if (!((u.qm >> (ai * 2 + bj)) & 1)) continue;
                        const int m = 2 * mp + mi, row = row0 + ai * 128 + m * 16, col = colb + bj * 128; const size_t off = (size_t)row * D + col;
                        f32x4 v0 = acc[ai][bj][m][0], v1 = acc[ai][bj][m][1];
                        if (BR < 3) { const u32x4 g4 = gt[mi][bj];
                            v0[0] *= bflo(g4.x); v0[1] *= bfhi(g4.x); v0[2] *= bflo(g4.y); v0[3] *= bfhi(g4.y);
                            v1[0] *= bflo(g4.z); v1[1] *= bfhi(g4.z); v1[2] *= bflo(g4.w); v1[3] *= bfhi(g4.w); }
                        if (BR == 1 || BR == 2) { const u32x4 p4 = sv[mi][bj]; v0[0] += bflo(p4.x); v0[1] += bfhi(p4.x); v0[2] += bflo(p4.y); v0[3] += bfhi(p4.y); v1[0] += bflo(p4.z); v1[1] += bfhi(p4.z); v1[2] += bflo(p4.w); v1[3] += bfhi(p4.w); }
                        { u32x4 w; w.x = pk2(v0[0], v0[1]); w.y = pk2(v0[2], v0[3]); w.z = pk2(v1[0], v1[1]); w.w = pk2(v1[2], v1[3]); *(u32x4*)((BR == 2 ? merged : scr) + off) = w; }
                    }
                EPI_FENCE();
            }
        }
    }
    __device__ __forceinline__ void operator()(const f32x4 (&acc)[2][2][4][2], const Unit& u, int wr, int wc, int fr, int fq, const LAS float* rt) const {
        if (mode == 1) run<3>(acc, u, wr, wc, fr, fq);
        else if (u.kind == 0) run<0>(acc, u, wr, wc, fr, fq);
        else if (u.kind == 1) run<1>(acc, u, wr, wc, fr, fq);
        else run<2>(acc, u, wr, wc, fr, fq);
    }
};

struct Args { const float* in[29]; float* out; unsigned char* ws; int ph_lo, ph_hi; };
constexpr int NPH = 26;
constexpr int LDS_BYTES = 147456;

struct Ctx {
    const float* const* in; float* out; unsigned char* ws; LAS unsigned char* lds; unsigned char* ldsg; int tid, lane, wave, G, bx;
};

enum { MAP_ID = 0, MAP_SWIGLU = 1, MAP_WIN = 2 };
__device__ __forceinline__ int map_col(int mode, int n) {
    if (mode == MAP_ID) return n;
    if (mode == MAP_SWIGLU) { const int p = n >> 8, j = n & 255; return j < 128 ? p * 128 + j : FF + p * 128 + (j - 128); }
    if (n < 2048) return n;
    if (n < 2304) return 2064 + (n - 2048);
    if (n < 2560) return 2320 + (n - 2304);
    if (n < 5632) return 2576 + (n - 2560);
    if (n < 5648) return 2048 + (n - 5632);
    return -1;
}
__device__ __forceinline__ void tconv(const Ctx& c, const float* src, int ldsrc, int K, bf16_t* dst, int lddst, int Nout, int mode, const float* g) {
    float* tile = (float*)c.ldsg;
    const int ntn = Nout / 64, ntk = K / 256, nt = ntn * ntk;
    for (int it = c.bx; it < nt; it += c.G) {
        const int tn = it % ntn, tk = it / ntn, n0 = tn * 64, k0 = tk * 256;
        const int nn = c.tid & 63, sc = map_col(mode, n0 + nn), kq = c.tid >> 6;
        float v[32];
#pragma unroll
        for (int i = 0; i < 32; ++i) { const int kk = kq + 8 * i; v[i] = (sc >= 0) ? src[(size_t)(k0 + kk) * ldsrc + sc] : 0.f; }
        if (g) {
#pragma unroll
            for (int i = 0; i < 32; ++i) v[i] *= g[k0 + kq + 8 * i];
        }
#pragma unroll
        for (int i = 0; i < 32; ++i) tile[(kq + 8 * i) * 65 + nn] = v[i];
        __syncthreads();
        { const int n2 = c.tid >> 3, kg = c.tid & 7;
#pragma unroll
          for (int j = 0; j < 4; ++j) { const float* s = tile + (kg * 8 + 64 * j) * 65 + n2;
              u32x4 o; o.x = pk2(s[0], s[65]); o.y = pk2(s[130], s[195]); o.z = pk2(s[260], s[325]); o.w = pk2(s[390], s[455]);
              *(u32x4*)(dst + (size_t)(n0 + n2) * lddst + k0 + kg * 8 + 64 * j) = o; } }
        __syncthreads();
    }
}
__device__ __forceinline__ float wave_sum(float v) {
#pragma unroll
    for (int o = 1; o < 64; o <<= 1) v += __shfl_xor(v, o);
    return v;
}
__device__ __forceinline__ void prologue(const Ctx& c) {
    bf16_t* W = (bf16_t*)(c.ws + WS_W);
    for (int l = 0; l < 2; ++l) {
        bf16_t* Wl = W + (size_t)l * WL_END;
        tconv(c, c.in[9] + (size_t)l * D * 2 * FF, 2 * FF, D, Wl + WL_1IN, D, 2 * FF, MAP_SWIGLU, c.in[8] + l * D);
        tconv(c, c.in[10] + (size_t)l * FF * D, D, FF, Wl + WL_1OUT, FF, D, MAP_ID, nullptr);
        tconv(c, c.in[12] + (size_t)l * D * INW, INW, D, Wl + WL_IN, D, NIN, MAP_WIN, c.in[11] + l * D);
        tconv(c, c.in[18] + (size_t)l * 512 * D, D, 512, Wl + WL_BR, D, D, MAP_ID, nullptr);
        tconv(c, c.in[19] + (size_t)l * 256 * D, D, 256, Wl + WL_BR + 512, D, D, MAP_ID, nullptr);
        tconv(c, c.in[21] + (size_t)l * D * D, D, D, Wl + WL_OUT, D, D, MAP_ID, nullptr);
        tconv(c, c.in[23] + (size_t)l * D * 2 * FF, 2 * FF, D, Wl + WL_2IN, D, 2 * FF, MAP_SWIGLU, c.in[22] + l * D);
        tconv(c, c.in[24] + (size_t)l * FF * D, D, FF, Wl + WL_2OUT, FF, D, MAP_ID, nullptr);
        tconv(c, c.in[26] + (size_t)l * D * D, D, D, Wl + WL_PG, D, D, MAP_ID, c.in[25] + l * D);
        tconv(c, c.in[27] + (size_t)l * 256 * D, D, 256, Wl + WL_PP, 256, D, MAP_ID, nullptr);
        const float* pw = c.in[16] + (size_t)l * 4 * 64 * 64; const float* psc = c.in[17] + l * 256; const float* wc = c.in[20] + (size_t)l * 256 * D;
        for (int idx = c.bx * 512 + c.tid; idx < 256 * 1024; idx += c.G * 512) {
            const int n = idx & 1023, kc = idx >> 10, gq = kc >> 6, cc = kc & 63; float s = 0.f;
            for (int dd = 0; dd < 64; ++dd) s += pw[(gq * 64 + cc) * 64 + dd] * psc[gq * 64 + dd] * wc[(size_t)(gq * 64 + dd) * D + n];
            Wl[WL_BR + (size_t)n * D + 768 + kc] = (bf16_t)f2bf(s);
        }
    }
    bf16_t* xb = (bf16_t*)(c.ws + WS_XB); float* ss0 = (float*)(c.ws + WS_SS);
    for (int row = c.bx * 8 + c.wave; row < M; row += c.G * 8) {
        const float* src = row < MP ? c.in[0] + (size_t)row * D : c.in[1] + (size_t)(row - MP) * D;
        f32x4 v[4]; float s = 0.f;
#pragma unroll
        for (int j = 0; j < 4; ++j) { v[j] = *(const f32x4*)(src + c.lane * 4 + 256 * j); s += (v[j][0] * v[j][0] + v[j][1] * v[j][1]) + (v[j][2] * v[j][2] + v[j][3] * v[j][3]); }
        s = wave_sum(s);
#pragma unroll
        for (int j = 0; j < 4; ++j) { u32x2 w; w.x = pk2(v[j][0], v[j][1]); w.y = pk2(v[j][2], v[j][3]); *(u32x2*)(xb + (size_t)row * D + c.lane * 4 + 256 * j) = w; }
        if (c.lane < 32) ss0[(size_t)row * 32 + c.lane] = c.lane == 0 ? s : 0.f;
    }
    bf16_t* pb = (bf16_t*)(c.ws + WS_PB);
#pragma unroll 4
    for (size_t i4 = (size_t)c.bx * 512 + c.tid; i4 < (size_t)2 * M * 64; i4 += (size_t)c.G * 512) {
        const size_t e = i4 * 4; const int l = (int)(e / ((size_t)M * 256)); const size_t r = e - (size_t)l * M * 256; const int row = (int)(r >> 8), cc = (int)(r & 255);
        const float* src = row < MP ? c.in[6] + ((size_t)l * MP + row) * 256 + cc : c.in[7] + ((size_t)l * 2048 + (row - MP)) * 256 + cc;
        const f32x4 v = *(const f32x4*)src; u32x2 w; w.x = pk2(v[0], v[1]); w.y = pk2(v[2], v[3]); *(u32x2*)(pb + e) = w;
    }
}

__device__ __forceinline__ int next_item(const Ctx& c, int slot) {
    volatile int* sh = (volatile int*)(c.ldsg + 147392);
    __syncthreads();
    if (c.tid == 0) *sh = (int)__hip_atomic_fetch_add((unsigned*)(c.ws + WS_CTL) + 64 * (1 + slot), 1u, __ATOMIC_RELAXED, __HIP_MEMORY_SCOPE_AGENT);
    __syncthreads();
    return *sh;
}
__device__ __forceinline__ void gla_local_unit(const Ctx& c, int l, int g, int h) {
    float* L = (float*)c.ldsg; float* rs = L; float* wg = L + 1024; float* bg = L + 1536; float* la = L + 1600; float* kt = L + 3712; float* vs = L + 5824;
    const bf16_t* proj = (const bf16_t*)(c.ws + WS_BIG); const int m0 = g * 64, tid = c.tid;
    { const int e = tid * 2, row = e >> 4, cc = e & 15; const unsigned w = *(const unsigned*)(proj + (size_t)(m0 + row) * PW + C_RB + cc); rs[e] = bflo(w); rs[e + 1] = bfhi(w); }
    { const int j = tid >> 5, d = tid & 31; wg[tid] = c.in[13][(size_t)(l * 16 + j) * 128 + h * 32 + d]; }
    if (tid < 32) bg[tid] = c.in[14][l * 128 + h * 32 + tid];
    __syncthreads();
#pragma unroll
    for (int i = 0; i < 4; ++i) { const int o = tid + 512 * i, t = o >> 5, d = o & 31; float a = bg[d];
#pragma unroll
        for (int j = 0; j < 16; ++j) a += rs[t * 16 + j] * wg[j * 32 + d];
        la[t * 33 + d] = (fminf(a, 0.f) - flog(1.0f + fexp(-fabsf(a)))) * (1.0f / 16.0f); }
    __syncthreads();
    {
#pragma unroll
        for (int j = 0; j < 4; ++j) { const int d = c.wave * 4 + j; float v = la[c.lane * 33 + d];
#pragma unroll
            for (int o = 1; o < 64; o <<= 1) { const float n = __shfl_up(v, o); if (c.lane >= o) v += n; }
            la[c.lane * 33 + d] = v; }
    }
    __syncthreads();
    float* bws = (float*)(c.ws + WS_B);
#pragma unroll
    for (int i = 0; i < 4; ++i) { const int o = tid + 512 * i, t = o >> 5, d = o & 31; const float b = la[t * 33 + d];
        bws[(size_t)(m0 + t) * 128 + h * 32 + d] = b;
        kt[t * 33 + d] = bf2f(proj[(size_t)(m0 + t) * PW + C_KB + h * 32 + d]) * fexp(-b); }
    { const int t = tid >> 3, e0 = (tid & 7) * 8; const u32x4 w = *(const u32x4*)(proj + (size_t)(m0 + t) * PW + C_VB + h * 64 + e0); float* d = vs + t * 64 + e0;
      d[0] = bflo(w.x); d[1] = bfhi(w.x); d[2] = bflo(w.y); d[3] = bfhi(w.y); d[4] = bflo(w.z); d[5] = bfhi(w.z); d[6] = bflo(w.w); d[7] = bfhi(w.w); }
    __syncthreads();
    { const int d = tid >> 4, e0 = (tid & 15) * 4; f32x4 a = {0.f, 0.f, 0.f, 0.f};
      for (int t = 0; t < 64; ++t) { const float kk = kt[t * 33 + d]; const f32x4 v = *(const f32x4*)(vs + t * 64 + e0); a = a + v * kk; }
      *(f32x4*)((float*)(c.ws + WS_DS) + ((size_t)(g * 4 + h) * 32 + d) * 64 + e0) = a; }
    if (tid < 32) ((float*)(c.ws + WS_DEC))[(size_t)(g * 4 + h) * 32 + tid] = fexp(la[63 * 33 + tid]);
    __syncthreads();
}
__device__ __forceinline__ void pool_unit(const Ctx& c, int l, int g) {
    float* ext = (float*)c.ldsg;
    const bf16_t* proj = (const bf16_t*)(c.ws + WS_BIG); bf16_t* Y = (bf16_t*)(c.ws + WS_Y);
    const int m0 = g * 64, tid = c.tid; const bool samp = g >= 512; const int cidx = samp ? 0 : (g & 127);
#pragma unroll
    for (int it = 0; it < 5; ++it) { const int q = tid + 512 * it;
        if (q < 79 * 32) { const int j = q >> 5, c8 = (q & 31) * 8; float* d = ext + j * 256 + c8;
            if (j >= 15 || cidx > 0) { const u32x4 w = *(const u32x4*)(proj + (size_t)(m0 + j - 15) * PW + C_UC + c8);
                *(f32x4*)d = (f32x4){bflo(w.x), bfhi(w.x), bflo(w.y), bfhi(w.y)}; *(f32x4*)(d + 4) = (f32x4){bflo(w.z), bfhi(w.z), bflo(w.w), bfhi(w.w)}; }
            else if (samp) { const float* sp = c.in[5] + ((size_t)(l * 32 + (g - 512)) * 15 + j) * 256 + c8; *(f32x4*)d = *(const f32x4*)sp; *(f32x4*)(d + 4) = *(const f32x4*)(sp + 4); }
            else { *(f32x4*)d = (f32x4){0.f, 0.f, 0.f, 0.f}; *(f32x4*)(d + 4) = (f32x4){0.f, 0.f, 0.f, 0.f}; } } }
    __syncthreads();
    { const int cc = tid & 255, ts = tid >> 8, gi = cc >> 6, w = 2 << gi;
      for (int i = 0; i < 32; ++i) { const int t = ts * 32 + i; float s = 0.f;
          for (int j = 0; j < w; ++j) s += ext[(15 + t - j) * 256 + cc];
          const int pos = samp ? 2048 + t : cidx * 64 + t; const float cnt = (float)min(w, pos + 1);
          const float dv = s / cnt - ext[(15 + t) * 256 + cc];
          Y[(size_t)(m0 + t) * D + 768 + cc] = (bf16_t)f2bf(dv); } }
    __syncthreads();
}

__device__ __forceinline__ void scan_unit(const Ctx& c, int l, int su) {
    const float* dS = (const float*)(c.ws + WS_DS); const float* dec = (const float*)(c.ws + WS_DEC); float* St = (float*)(c.ws + WS_ST);
    int g0, n, h, idx; float S; float* outp;
    if (su < 64) { const int bh = su >> 2, b = bh >> 2; h = bh & 3; idx = (su & 3) * 512 + c.tid; g0 = b * 128; n = 128; S = 0.f; outp = c.out + O_GP + ((size_t)(l * 4 + b) * 4 + h) * 2048 + idx; }
    else { const int s2 = su - 64, sbh = s2 >> 2, sb = sbh >> 2; h = sbh & 3; idx = (s2 & 3) * 512 + c.tid; g0 = 512 + sb; n = 1; S = c.in[4][((size_t)(l * 32 + sb) * 4 + h) * 2048 + idx]; outp = c.out + O_GS + ((size_t)(l * 32 + sb) * 4 + h) * 2048 + idx; }
    const int d = idx >> 6;
#pragma unroll 8
    for (int cc = 0; cc < n; ++cc) { const size_t gh = (size_t)(g0 + cc) * 4 + h; const float dd = dS[gh * 2048 + idx], de = dec[gh * 32 + d]; St[gh * 2048 + idx] = S; S = de * (S + dd); }
    *outp = S;
}
__device__ __forceinline__ void attn_unit(const Ctx& c, int l, int au) {
    bf16_t* Ks = (bf16_t*)c.ldsg; bf16_t* Vt = (bf16_t*)(c.ldsg + 18432); int* flags = (int*)(c.ldsg + 35840);
    const bf16_t* proj = (const bf16_t*)(c.ws + WS_BIG); bf16_t* Y = (bf16_t*)(c.ws + WS_Y);
    int R0, n_past, qb, hp, sb = 0;
    if (au < 2048) { const int b = au >> 9, rem = au & 511; qb = rem >> 2; hp = rem & 3; R0 = b * 8192; n_past = 0; }
    else { const int a2 = au - 2048; sb = a2 >> 2; hp = a2 & 3; qb = 0; R0 = MP + sb * 64; n_past = 2048; }
    const int tid = c.tid, w = c.wave, lane = c.lane, fr = lane & 15, fq = lane >> 4, hsel = w >> 2, hh = 2 * hp + hsel, qsub = w & 3;
    const int qrow = R0 + qb * 64 + qsub * 16 + fr, qpos = n_past + qb * 64 + qsub * 16 + fr;
    bf16x8 qf[2];
#pragma unroll
    for (int ks = 0; ks < 2; ++ks) qf[ks] = *(const bf16x8*)(proj + (size_t)qrow * PW + C_QA + hh * 64 + 32 * ks + 8 * fq);
    f32x4 O[4];
#pragma unroll
    for (int i = 0; i < 4; ++i) O[i] = (f32x4){0.f, 0.f, 0.f, 0.f};
    float carry = 0.f; bool wdone = false;
    int kt = (n_past + qb * 64) >> 6;
    const int lh = tid >> 8, lj = (tid >> 2) & 63, d0 = (tid & 3) * 16, lhead = 2 * hp + lh;
    for (;;) {
        {
            const int kpos = kt * 64 + lj; unsigned kk[8], vv[8];
            if (kpos < n_past) {
                const size_t o = (((size_t)(l * 32 + sb) * 2048 + kpos) * 512) + lhead * 64 + d0; const float* kp = c.in[2] + o; const float* vp = c.in[3] + o;
#pragma unroll
                for (int i = 0; i < 4; ++i) { const f32x4 a = *(const f32x4*)(kp + 4 * i), b = *(const f32x4*)(vp + 4 * i); kk[2 * i] = pk2(a[0], a[1]); kk[2 * i + 1] = pk2(a[2], a[3]); vv[2 * i] = pk2(b[0], b[1]); vv[2 * i + 1] = pk2(b[2], b[3]); }
            } else {
                const bf16_t* rp = proj + (size_t)(R0 + kpos - n_past) * PW + lhead * 64 + d0;
                const u32x4 a0 = *(const u32x4*)(rp + C_KA), a1 = *(const u32x4*)(rp + C_KA + 8), b0 = *(const u32x4*)(rp + C_VA), b1 = *(const u32x4*)(rp + C_VA + 8);
                kk[0] = a0.x; kk[1] = a0.y; kk[2] = a0.z; kk[3] = a0.w; kk[4] = a1.x; kk[5] = a1.y; kk[6] = a1.z; kk[7] = a1.w;
                vv[0] = b0.x; vv[1] = b0.y; vv[2] = b0.z; vv[3] = b0.w; vv[4] = b1.x; vv[5] = b1.y; vv[6] = b1.z; vv[7] = b1.w;
            }
            bf16_t* kd = Ks + (lh * 64 + lj) * 72 + d0;
            *(u32x4*)kd = (u32x4){kk[0], kk[1], kk[2], kk[3]}; *(u32x4*)(kd + 8) = (u32x4){kk[4], kk[5], kk[6], kk[7]};
#pragma unroll
            for (int i = 0; i < 8; ++i) { Vt[(lh * 64 + d0 + 2 * i) * 68 + lj] = (bf16_t)(vv[i] & 0xffffu); Vt[(lh * 64 + d0 + 2 * i + 1) * 68 + lj] = (bf16_t)(vv[i] >> 16); }
        }
        __syncthreads();
        {
            f32x4 sa[4];
#pragma unroll
            for (int u = 0; u < 4; ++u) { sa[u] = (f32x4){0.f, 0.f, 0.f, 0.f};
#pragma unroll
                for (int ks = 0; ks < 2; ++ks) { const bf16x8 kf = *(const bf16x8*)(Ks + (hsel * 64 + 16 * u + fr) * 72 + 32 * ks + 8 * fq); sa[u] = __builtin_amdgcn_mfma_f32_16x16x32_bf16(kf, qf[ks], sa[u], 0, 0, 0); } }
            float lk[4][4], lw[4][4], ls[4], suf[4], T[4];
#pragma unroll
            for (int u = 0; u < 4; ++u) { ls[u] = 0.f;
#pragma unroll
                for (int i = 0; i < 4; ++i) { const float z = sa[u][i] * 0.125f; const int kpos = kt * 64 + 16 * u + 4 * fq + i; const bool valid = kpos < qpos;
                    const float sp = softplus(z); lk[u][i] = valid ? -sp : 0.f; lw[u][i] = valid ? (z - sp) : -1e30f; ls[u] += lk[u][i]; } }
#pragma unroll
            for (int u = 0; u < 4; ++u) { const float a = __shfl_xor(ls[u], 16), t1 = ls[u] + a, o = __shfl_xor(t1, 32); T[u] = t1 + o; suf[u] = ((fq & 1) ? 0.f : a) + ((fq & 2) ? 0.f : o); }
            float base = carry; float wv[4][4];
#pragma unroll
            for (int u = 3; u >= 0; --u) { float run = base + suf[u];
#pragma unroll
                for (int i = 3; i >= 0; --i) { wv[u][i] = fexp(lw[u][i] + run); run += lk[u][i]; }
                base += T[u]; }
            carry = base;
#pragma unroll
            for (int k2 = 0; k2 < 2; ++k2) {
                u32x4 pw; pw.x = pk2(wv[2 * k2][0], wv[2 * k2][1]); pw.y = pk2(wv[2 * k2][2], wv[2 * k2][3]); pw.z = pk2(wv[2 * k2 + 1][0], wv[2 * k2 + 1][1]); pw.w = pk2(wv[2 * k2 + 1][2], wv[2 * k2 + 1][3]);
                const bf16x8 pf = __builtin_bit_cast(bf16x8, pw);
#pragma unroll
                for (int db = 0; db < 4; ++db) { const bf16_t* vp = Vt + (hsel * 64 + 16 * db + fr) * 68 + 32 * k2 + 4 * fq; const u32x2 lo = *(const u32x2*)vp, hi = *(const u32x2*)(vp + 16);
                    const bf16x8 vf = __builtin_bit_cast(bf16x8, (u32x4){lo.x, lo.y, hi.x, hi.y}); O[db] = __builtin_amdgcn_mfma_f32_16x16x32_bf16(vf, pf, O[db], 0, 0, 0); }
            }
            wdone = __all(carry < -46.f) != 0;
        }
        --kt;
        if (lane == 0) flags[w] = wdone ? 1 : 0;
        __syncthreads();
        int alld = 1;
#pragma unroll
        for (int i = 0; i < 8; ++i) alld &= flags[i];
        if (alld || kt < 0) break;
    }
#pragma unroll
    for (int db = 0; db < 4; ++db) { u32x2 o; o.x = pk2(O[db][0], O[db][1]); o.y = pk2(O[db][2], O[db][3]); *(u32x2*)(Y + (size_t)qrow * D + hh * 64 + 16 * db + 4 * fq) = o; }
    __syncthreads();
}

__device__ __forceinline__ void gla_out_unit(const Ctx& c, int l, int g, int h) {
    float* L = (float*)c.ldsg; float* qs = L; float* ktT = L + 2112; float* vs = L + 4288; float* sc = L + 8640; float* Ss = L + 12800;
    const bf16_t* proj = (const bf16_t*)(c.ws + WS_BIG); bf16_t* Y = (bf16_t*)(c.ws + WS_Y); const float* bws = (const float*)(c.ws + WS_B);
    const int m0 = g * 64, tid = c.tid;
#pragma unroll
    for (int i = 0; i < 4; ++i) { const int o = tid + 512 * i, t = o >> 5, d = o & 31; const float b = bws[(size_t)(m0 + t) * 128 + h * 32 + d];
        const bf16_t* pr = proj + (size_t)(m0 + t) * PW + h * 32 + d;
        qs[t * 33 + d] = bf2f(pr[C_QB]) * 0.17677669529663687f * fexp(b); ktT[d * 68 + t] = bf2f(pr[C_KB]) * fexp(-b);
        Ss[o] = ((const float*)(c.ws + WS_ST))[(size_t)(g * 4 + h) * 2048 + o]; }
    { const int t = tid >> 3, e0 = (tid & 7) * 8; const u32x4 w = *(const u32x4*)(proj + (size_t)(m0 + t) * PW + C_VB + h * 64 + e0); float* d = vs + t * 68 + e0;
      d[0] = bflo(w.x); d[1] = bfhi(w.x); d[2] = bflo(w.y); d[3] = bfhi(w.y); d[4] = bflo(w.z); d[5] = bfhi(w.z); d[6] = bflo(w.w); d[7] = bfhi(w.w); }
    __syncthreads();
    const int t = tid >> 3, g8 = (tid & 7) * 8;
    { float a[8];
#pragma unroll
      for (int j = 0; j < 8; ++j) a[j] = 0.f;
      for (int d = 0; d < 32; ++d) { const float q = qs[t * 33 + d]; const f32x4 k0 = *(const f32x4*)(ktT + d * 68 + g8), k1 = *(const f32x4*)(ktT + d * 68 + g8 + 4);
#pragma unroll
          for (int j = 0; j < 4; ++j) { a[j] += q * k0[j]; a[4 + j] += q * k1[j]; } }
#pragma unroll
      for (int j = 0; j < 8; ++j) sc[t * 65 + g8 + j] = (g8 + j <= t) ? a[j] : 0.f; }
    __syncthreads();
    { float o[8];
#pragma unroll
      for (int j = 0; j < 8; ++j) o[j] = 0.f;
      for (int s = 0; s <= t; ++s) { const float p = sc[t * 65 + s]; const f32x4 v0 = *(const f32x4*)(vs + s * 68 + g8), v1 = *(const f32x4*)(vs + s * 68 + g8 + 4);
#pragma unroll
          for (int j = 0; j < 4; ++j) { o[j] += p * v0[j]; o[4 + j] += p * v1[j]; } }
      for (int d = 0; d < 32; ++d) { const float q = qs[t * 33 + d]; const f32x4 s0 = *(const f32x4*)(Ss + d * 64 + g8), s1 = *(const f32x4*)(Ss + d * 64 + g8 + 4);
#pragma unroll
          for (int j = 0; j < 4; ++j) { o[j] += q * s0[j]; o[4 + j] += q * s1[j]; } }
      float q2 = 0.f;
#pragma unroll
      for (int j = 0; j < 8; ++j) q2 += o[j] * o[j];
      q2 += __shfl_xor(q2, 1); q2 += __shfl_xor(q2, 2); q2 += __shfl_xor(q2, 4);
      const float r = __builtin_amdgcn_rsqf(q2 * (1.0f / 64.0f) + EPS);
      const u32x4 ow = *(const u32x4*)(proj + (size_t)(m0 + t) * PW + C_OB + h * 64 + g8);
      float ob[8] = {bflo(ow.x), bfhi(ow.x), bflo(ow.y), bfhi(ow.y), bflo(ow.z), bfhi(ow.z), bflo(ow.w), bfhi(ow.w)};
      const float* gn = c.in[15] + l * 256 + h * 64 + g8; float y[8];
#pragma unroll
      for (int j = 0; j < 8; ++j) y[j] = o[j] * r * gn[j] * (ob[j] * sigm(ob[j]));
      u32x4 w; w.x = pk2(y[0], y[1]); w.y = pk2(y[2], y[3]); w.z = pk2(y[4], y[5]); w.w = pk2(y[6], y[7]);
      *(u32x4*)(Y + (size_t)(m0 + t) * D + 512 + h * 64 + g8) = w; }
    __syncthreads();
}

__device__ __forceinline__ void grid_bar(unsigned* ctr, unsigned target) {
    asm volatile("s_waitcnt vmcnt(0)" ::: "memory");
    __syncthreads();
    if (threadIdx.x == 0) {
        __builtin_amdgcn_fence(__ATOMIC_RELEASE, "agent");
        asm volatile("s_waitcnt vmcnt(0)" ::: "memory");
        __hip_atomic_fetch_add(ctr, 1u, __ATOMIC_RELAXED, __HIP_MEMORY_SCOPE_AGENT);
        while (__hip_atomic_load(ctr, __ATOMIC_RELAXED, __HIP_MEMORY_SCOPE_AGENT) < target) __builtin_amdgcn_s_sleep(1);
        __builtin_amdgcn_fence(__ATOMIC_ACQUIRE, "agent");
        asm volatile("s_waitcnt vmcnt(0)" ::: "memory");
    }
    __syncthreads();
}

__global__ void __launch_bounds__(512, 2) fwd_mega(Args args) {
    extern __shared__ __attribute__((aligned(16))) unsigned char lds[];
    cg::grid_group grid = cg::this_grid();
    Ctx c; c.in = args.in; c.out = args.out; c.ws = args.ws; c.lds = (LAS unsigned char*)lds; c.ldsg = lds;
    c.tid = threadIdx.x; c.lane = c.tid & 63; c.wave = __builtin_amdgcn_readfirstlane(c.tid >> 6); c.G = gridDim.x; c.bx = blockIdx.x;
    for (int ph = args.ph_lo; ph < args.ph_hi; ++ph) {
        { int t_ = threadIdx.x; asm volatile("" : "+v"(t_)); c.tid = t_; c.lane = t_ & 63; c.wave = __builtin_amdgcn_readfirstlane(t_ >> 6); }
        unsigned char* ws = args.ws; float* outp = args.out; asm volatile("" : "+s"(ws), "+s"(outp)); c.ws = ws; c.out = outp;
        bf16_t* xb = (bf16_t*)(ws + WS_XB); bf16_t* big = (bf16_t*)(ws + WS_BIG); bf16_t* Yb = (bf16_t*)(ws + WS_Y); bf16_t* mg = (bf16_t*)(ws + WS_MG);
        float* scr = (float*)(ws + WS_SCR); float* ss0 = (float*)(ws + WS_SS); float* ss1 = ss0 + (size_t)M * 32; float* xw = outp + O_Y;
        if (ph == 0) prologue(c);
        else if (ph == 25) {
            const float* gf = args.in[28];
            for (int row = c.bx * 8 + c.wave; row < M; row += c.G * 8) { const float rs = rstd_of(ss0, row);
#pragma unroll
                for (int j = 0; j < 4; ++j) { float* p = xw + (size_t)row * D + c.lane * 4 + 256 * j; const f32x4 v = *(const f32x4*)p, gg = *(const f32x4*)(gf + c.lane * 4 + 256 * j); *(f32x4*)p = v * rs * gg; } }
        } else {
            const int l = (ph - 1) / 12, k = (ph - 1) % 12;
            if ((MK_SKIPMASK >> k) & 1) continue;
            const bf16_t* Wl = (const bf16_t*)(ws + WS_W) + (size_t)l * WL_END;
            if (k == 0 || k == 8) {
                pg8::Gemm g{(k == 0 && l > 0) ? mg : xb, Wl + (k == 0 ? WL_1IN : WL_2IN), D, D}; pg8::Sched S;     S.init(M, 2 * FF, c.G, c.bx, 16);
                EpiSwiglu E{big}; pg8::gemm_phase(c.lds, c.tid, g, S, E, ss0);
            } else if (k == 1 || k == 9 || k == 7 || k == 11) {
                pg8::Gemm g; pg8::Sched S; EpiRes E{xw, xb, nullptr, (const bf16_t*)scr, 1.f, 0, nullptr, nullptr}; const float* ssin = nullptr;
                if (k == 1 || k == 9) { g = pg8::Gemm{big, Wl + (k == 1 ? WL_1OUT : WL_2OUT), FF, FF}; S.init(M, D, c.G, c.bx, 44); S.quart = 1; E.alpha = 0.5f; E.ss_out = ss1; if (l == 0 && k == 1) { E.xin0 = args.in[0]; E.xin1 = args.in[1]; } }
                else if (k == 7) { g = pg8::Gemm{mg, Wl + WL_OUT, D, D}; S.init(M, D, c.G, c.bx, 16); S.quart = 1; E.ss_out = ss0; }
                else { g = pg8::Gemm{xb, Wl + WL_PG, D, D}; S.init(M, D, c.G, c.bx, 16); S.quart = 1; E.ss_out = ss0; ssin = ss1; E.mode = 1; E.xb = mg; }
                pg8::gemm_phase(c.lds, c.tid, g, S, E, ssin);
            } else if (k == 2) {
                pg8::Gemm g{xb, Wl + WL_IN, D, D}; pg8::Sched S; S.init(M, NIN, c.G, c.bx, 16); S.quart = 1;
                EpiWin E{big, outp, l}; pg8::gemm_phase(c.lds, c.tid, g, S, E, ss1);
            } else if (k == 3) {
                for (int it = next_item(c, l * 3 + 0); it < 2176 + NCH; it = next_item(c, l * 3 + 0)) { if (it < NCH) pool_unit(c, l, it); else gla_local_unit(c, l, (it - NCH) >> 2, (it - NCH) & 3); }
            } else if (k == 4) {
                for (int it = next_item(c, l * 3 + 1); it < 576 + 2176; it = next_item(c, l * 3 + 1)) { if (it < 576) scan_unit(c, l, it); else attn_unit(c, l, it - 576); }
            } else if (k == 5) {
                for (int it = next_item(c, l * 3 + 2); it < 2176; it = next_item(c, l * 3 + 2)) gla_out_unit(c, l, it >> 2, it & 3);
            } else {
                pg8::Gemm g; pg8::Sched S; EpiBranch E{big, (bf16_t*)scr, mg, 0};
                if (k == 6) { g = pg8::Gemm{Yb, Wl + WL_BR, D, D}; S.init(M, D, c.G, c.bx, 8); S.nsub = 3; S.quart = 1; }
                else { g = pg8::Gemm{(const bf16_t*)(ws + WS_PB) + (size_t)l * M * 256, Wl + WL_PP, 256, 256}; S.init(M, D, c.G, c.bx, 4); S.quart = 1; E.mode = 1; }
                pg8::gemm_phase(c.lds, c.tid, g, S, E, nullptr);
            }
        }
        if (ph + 1 < args.ph_hi) { if (ph == args.ph_lo) grid.sync(); else grid_bar((unsigned*)(args.ws + WS_CTL), (unsigned)(ph - args.ph_lo) * gridDim.x); }
    }
}

extern "C" void kernel_launch(void* const* d_in, const int* in_sizes, int n_in, void* d_out, int out_size, void* d_ws, size_t ws_size, hipStream_t stream) {
    static int grid = 0;
    if (grid == 0) {
        if (n_in != 29 || ws_size < WS_NEED) { fprintf(stderr, "kernel_launch: unexpected n_in %d / ws %zu\n", n_in, ws_size); grid = -1; return; }
        int dev = 0, cus = 0, per_cu = 0;
        (void)hipGetDevice(&dev); (void)hipDeviceGetAttribute(&cus, hipDeviceAttributeMultiprocessorCount, dev);
        (void)hipFuncSetAttribute((const void*)fwd_mega, hipFuncAttributeMaxDynamicSharedMemorySize, LDS_BYTES);
        (void)hipOccupancyMaxActiveBlocksPerMultiprocessor(&per_cu, (const void*)fwd_mega, 512, LDS_BYTES);
        (void)hipGetLastError();
        if (per_cu < 1) per_cu = 1;
        grid = cus;
    }
    if (grid < 0) return;
    (void)hipMemsetAsync((char*)d_ws + WS_CTL, 0, 4096, stream);
    Args a{};
    for (int i = 0; i < 29; ++i) a.in[i] = (const float*)d_in[i];
    a.out = (float*)d_out; a.ws = (unsigned char*)d_ws;
#if MK_ONE_LAUNCH
    a.ph_lo = 0; a.ph_hi = NPH;
    void* kargs[] = {&a};
    hipError_t e = hipLaunchCooperativeKernel((const void*)fwd_mega, dim3(grid), dim3(512), kargs, LDS_BYTES, stream);
    if (e != hipSuccess) fprintf(stderr, "cooperative launch failed: %s (grid %d)\n", hipGetErrorString(e), grid);
#else
    for (int ph = 0; ph < NPH; ++ph) { a.ph_lo = ph; a.ph_hi = ph + 1; hipLaunchKernelGGL(fwd_mega, dim3(grid), dim3(512), LDS_BYTES, stream, a); }
#endif
}
```

```cpp
#include <hip/hip_runtime.h>
#include <hip/hip_cooperative_groups.h>
#include <cstdio>
#include <cstdint>
namespace cg = cooperative_groups;

#ifndef MK_SKIPMASK
#define MK_SKIPMASK 0
#endif
#ifndef MK_NOATTN
#define MK_NOATTN 0
#endif
#ifndef MK_NOGLAOUT
#define MK_NOGLAOUT 0
#endif
#ifndef MK_ONE_LAUNCH
#define MK_ONE_LAUNCH 1
#endif

#define LAS __attribute__((address_space(3)))
typedef unsigned short bf16_t;
typedef short bf16x8 __attribute__((ext_vector_type(8)));
typedef float f32x4 __attribute__((ext_vector_type(4)));
typedef unsigned u32x4 __attribute__((ext_vector_type(4)));
typedef unsigned u32x2 __attribute__((ext_vector_type(2)));

constexpr int M = 34816;
constexpr int MP = 32768;
constexpr int D = 1024, FF = 2816, NIN = 5888, PW = 5888  , INW = 5648;
constexpr int NCH = 544;
constexpr float EPS = 1e-6f;
constexpr size_t O_Y = 0, O_KP = 35651584, O_VP = 69206016, O_GP = 102760448, O_PP = 102825984, O_KS = 102856704, O_VS = 104953856, O_GS = 107051008, O_PS = 107575296;
constexpr int C_QA = 0, C_KA = 512, C_VA = 1024, C_QB = 1536, C_KB = 1664, C_VB = 1792, C_OB = 2048, C_UC = 2304, C_G = 2560, C_RB = 5632;

constexpr size_t WL_1IN = 0, WL_1OUT = WL_1IN + (size_t)5632 * 1024, WL_IN = WL_1OUT + (size_t)1024 * 2816, WL_BR = WL_IN + (size_t)5888 * 1024, WL_OUT = WL_BR + 1048576,
                 WL_2IN = WL_OUT + 1048576, WL_2OUT = WL_2IN + (size_t)5632 * 1024, WL_PG = WL_2OUT + (size_t)1024 * 2816, WL_PP = WL_PG + 1048576, WL_END = WL_PP + 262144;
constexpr size_t MiB = 1u << 20;
constexpr size_t WS_W = 0;
constexpr size_t WS_XB = 104 * MiB;
constexpr size_t WS_PB = 172 * MiB;
constexpr size_t WS_BIG = 208 * MiB;
constexpr size_t WS_Y = 600 * MiB;
constexpr size_t WS_MG = 668 * MiB;
constexpr size_t WS_SCR = 736 * MiB;
constexpr size_t WS_SS = 934 * MiB;
constexpr size_t WS_DS = 878 * MiB;
constexpr size_t WS_ST = 896 * MiB;
constexpr size_t WS_B = 914 * MiB;
constexpr size_t WS_DEC = 932 * MiB;
constexpr size_t WS_CTL = 933 * MiB;
constexpr size_t WS_NEED = 944 * MiB;
static_assert(2 * WL_END * 2 <= 104 * MiB, "weights fit");

__device__ __forceinline__ unsigned f2bf(float f) { unsigned u = __builtin_bit_cast(unsigned, f); return (u + 0x7fffu + ((u >> 16) & 1u)) >> 16; }
__device__ __forceinline__ unsigned pk2(float lo, float hi) { unsigned r; asm("v_cvt_pk_bf16_f32 %0, %1, %2" : "=v"(r) : "v"(lo), "v"(hi)); return r; }
__device__ __forceinline__ float bflo(unsigned u) { return __uint_as_float(u << 16); }
__device__ __forceinline__ float bfhi(unsigned u) { return __uint_as_float(u & 0xffff0000u); }
__device__ __forceinline__ float bf2f(bf16_t b) { return __uint_as_float((unsigned)b << 16); }
__device__ __forceinline__ float fexp(float x) { return __builtin_amdgcn_exp2f(x * 1.4426950408889634f); }
__device__ __forceinline__ float flog(float x) { return __builtin_amdgcn_logf(x) * 0.6931471805599453f; }
__device__ __forceinline__ float sigm(float x) { return __builtin_amdgcn_rcpf(1.0f + fexp(-x)); }
__device__ __forceinline__ float softplus(float z) { return fmaxf(z, 0.f) + flog(1.0f + fexp(-fabsf(z))); }
__device__ __forceinline__ float rstd_of(const float* ss, int row) {
    const f32x4* p = (const f32x4*)(ss + (size_t)row * 32);
    float s = 0.f;
#pragma unroll
    for (int i = 0; i < 8; ++i) { const f32x4 a = p[i]; s += (a[0] + a[1]) + (a[2] + a[3]); }
    return __builtin_amdgcn_rsqf(s * (1.0f / 1024.0f) + EPS);
}

namespace pg8 {
constexpr int BM = 256, BK = 64, HALF = 128, HTB = HALF * BK * 2, STAGE_BYTES = 8 * HTB, NXCD = 8, WGM = 8;
__host__ __device__ __forceinline__ int lds_byte(int r, int c) { const int st = (r >> 4) * 2 + (c >> 5), rr = r & 15, cc = c & 31, ob = rr * 64 + cc * 2; return st * 1024 + (ob ^ (((ob >> 9) & 1) << 5)); }
__host__ __device__ __forceinline__ void stage_rc(int b, int& R, int& C) { const int st = b / 1024, sb = b % 1024, swz = sb ^ (((sb >> 9) & 1) << 5); R = (st >> 1) * 16 + swz / 64; C = (st & 1) * 32 + (swz % 64) / 2; }
__host__ __device__ __forceinline__ int perm32(int rho) { const int n = rho >> 4, i = rho & 15; return 8 * (i >> 2) + 4 * n + (i & 3); }

struct Unit { int pm, pn, kind, k0, nt, qm; };
struct Gemm { const bf16_t* A; const bf16_t* Bt; int lda, ldb; };

struct Sched {
    int nM, nN, nwg, G, c, nsub, nt0, quart;
    __device__ __forceinline__ void init(int M_, int N_, int G_, int c_, int nt) { nM = M_ / BM; nN = N_ / BM; nwg = nM * nN; G = G_; c = c_; nsub = 1; nt0 = nt; quart = 0; }
    __device__ __forceinline__ bool next(int i, Unit& u) const {
        const int ti = i / nsub, sk = i - ti * nsub;
        long L = (long)ti * G + c; int qm = 0xF;
        const int nfull = nwg / G;
        if (quart && ti >= nfull) {
            const long li = (long)(ti - nfull) * G + c; if (li >= 4L * (nwg - nfull * G)) return false;
            L = (long)nfull * G + (li >> 2); qm = 1 << (int)(li & 3);
        } else if (L >= nwg) return false;
        u.qm = qm;
        int wgid = (int)L; { const int q = nwg / NXCD, r = nwg % NXCD, xcd = wgid % NXCD, off = wgid / NXCD; wgid = (xcd < r ? xcd * (q + 1) : r * (q + 1) + (xcd - r) * q) + off; }
        const int nig = WGM * nN, gid = wgid / nig, fm = gid * WGM, gsz = (nM - fm) < WGM ? (nM - fm) : WGM;
        u.pm = fm + ((wgid % nig) % gsz); u.pn = (wgid % nig) / gsz; u.kind = sk; u.k0 = (sk > 0) ? 256 + 256 * sk : 0; u.nt = (sk > 0) ? 4 : nt0; return true;
    }
};

#define PG8_KLOOP(C0, C1, C2, C3) \
        for (int t = 0; t < nt; t += 2) { \
            const bool last = (t == nt - 2); \
            const char* a1 = cA + (size_t)(t + 1) * kstep; \
            const char* a2 = last ? nA : cA + (size_t)(t + 2) * kstep; const char* b2 = last ? nB : cB + (size_t)(t + 2) * kstep; \
            const char* a3 = a2 + kstep; const char* b3 = b2 + kstep; \
            PG8_LDB(B0, 0, 0); PG8_LDB(B1, 0, 1); PG8_SCHED; PG8_LDA(At, 0, 0); PG8_STAGE(PG8_SA(1, 1), a1 + hstepA, voffA); \
            PG8_WAIT_V(8); PG8_WAIT_L(0); PG8_BAR; if (C0) PG8_MMA(0, 0, At, B0); if (C1) PG8_MMA(0, 1, At, B1); PG8_BAR; PG8_SCHED; \
            PG8_LDA(At, 0, 1); PG8_STAGE(PG8_SB(0, 0), b2, voffB); PG8_STAGE(PG8_SB(0, 1), b2 + hstepB, voffB); PG8_STAGE(PG8_SA(0, 0), a2, voffA); \
            PG8_WAIT_V(8); PG8_WAIT_L(0); PG8_BAR; if (C2) PG8_MMA(1, 0, At, B0); if (C3) PG8_MMA(1, 1, At, B1); PG8_BAR; PG8_SCHED; \
            PG8_LDB(B0, 1, 0); PG8_LDB(B1, 1, 1); PG8_SCHED; PG8_LDA(At, 1, 0); PG8_STAGE(PG8_SA(0, 1), a2 + hstepA, voffA); \
            PG8_WAIT_V(8); PG8_WAIT_L(0); PG8_BAR; if (C0) PG8_MMA(0, 0, At, B0); if (C1) PG8_MMA(0, 1, At, B1); PG8_BAR; PG8_SCHED; \
            PG8_LDA(At, 1, 1); PG8_STAGE(PG8_SB(1, 0), b3, voffB); PG8_STAGE(PG8_SB(1, 1), b3 + hstepB, voffB); PG8_STAGE(PG8_SA(1, 0), a3, voffA); \
            PG8_WAIT_V(8); PG8_WAIT_L(0); PG8_BAR; if (C2) PG8_MMA(1, 0, At, B0); if (C3) PG8_MMA(1, 1, At, B1); PG8_BAR; PG8_SCHED; \
        }
template <class Epi, class Sch>
__device__ __forceinline__ void gemm_phase(LAS unsigned char* lds, const int tid, const Gemm g, const Sch& S, const Epi& E, const float* ss) {
    const int wid = __builtin_amdgcn_readfirstlane(tid >> 6), lane = tid & 63, wr = wid >> 2, wc = wid & 3, fr = lane & 15, fq = lane >> 4;
    unsigned voffA[2], voffB[2];
#pragma unroll
    for (int i = 0; i < 2; ++i) { int R, C; stage_rc(tid * 16 + i * 8192, R, C); const int Rb = (R & ~31) + perm32(R & 31);
        voffA[i] = (unsigned)(R * g.lda + C) * 2u; voffB[i] = (unsigned)(Rb * g.ldb + C) * 2u; }
    const size_t kstep = (size_t)(BK * 2);
    const size_t hstepA = (size_t)HALF * g.lda * 2, hstepB = (size_t)HALF * g.ldb * 2;
    const size_t tstepA = 2 * hstepA, tstepB = 2 * hstepB;
    const unsigned ldsw = (unsigned)wid * 1024u;
    const int aoff = lds_byte(wr * 64 + fr, fq * 8), boff = lds_byte(wc * 32 + fr, fq * 8);
    LAS float* rtab = (LAS float*)(lds + STAGE_BYTES);
    f32x4 rt_a = {0.f, 0.f, 0.f, 0.f}, rt_b = rt_a, rt_c = rt_a, rt_d = rt_a;
#define PG8_RTAB_LOAD(pm_) do { if (ss) { const f32x4* p_ = (const f32x4*)(ss + ((size_t)(pm_) * 256 + (tid >> 1)) * 32 + (tid & 1) * 16); rt_a = p_[0]; rt_b = p_[1]; rt_c = p_[2]; rt_d = p_[3]; } } while (0)
#define PG8_RTAB_FIN(buf_) do { if (ss) { float s_ = (((rt_a[0] + rt_a[1]) + (rt_a[2] + rt_a[3])) + ((rt_b[0] + rt_b[1]) + (rt_b[2] + rt_b[3]))) + (((rt_c[0] + rt_c[1]) + (rt_c[2] + rt_c[3])) + ((rt_d[0] + rt_d[1]) + (rt_d[2] + rt_d[3]))); \
        s_ += __shfl_xor(s_, 1); if (!(tid & 1)) rtab[(buf_) * 256 + (tid >> 1)] = __builtin_amdgcn_rsqf(s_ * (1.0f / 1024.0f) + EPS); } } while (0)
#define PG8_SA(b, h) (((b) * 2 + (h)) * HTB)
#define PG8_SB(b, h) ((4 + (b) * 2 + (h)) * HTB)
#define PG8_STAGE(bufoff, gbase, voff) do { _Pragma("unroll") for (int _i = 0; _i < 2; ++_i) \
        __builtin_amdgcn_global_load_lds((const unsigned*)((const char*)(gbase) + (voff)[_i]), (LAS unsigned*)(lds + (bufoff) + ldsw + _i * 8192), 16, 0, 0); } while (0)
#define PG8_LDA(dst, b, h) do { _Pragma("unroll") for (int m = 0; m < 4; ++m) _Pragma("unroll") for (int k = 0; k < 2; ++k) dst[m][k] = *(const LAS bf16x8*)(lds + PG8_SA(b, h) + aoff + m * 2048 + k * 1024); } while (0)
#define PG8_LDB(dst, b, h) do { _Pragma("unroll") for (int n = 0; n < 2; ++n) _Pragma("unroll") for (int k = 0; k < 2; ++k) dst[n][k] = *(const LAS bf16x8*)(lds + PG8_SB(b, h) + boff + n * 2048 + k * 1024); } while (0)
#define PG8_MMA(ai, bj, At, Bt) do { __builtin_amdgcn_s_setprio(1); _Pragma("unroll") for (int m = 0; m < 4; ++m) _Pragma("unroll") for (int n = 0; n < 2; ++n) _Pragma("unroll") for (int k = 0; k < 2; ++k) \
        acc[ai][bj][m][n] = __builtin_amdgcn_mfma_f32_16x16x32_bf16(Bt[n][k], At[m][k], acc[ai][bj][m][n], 0, 0, 0); __builtin_amdgcn_s_setprio(0); } while (0)
#define PG8_WAIT_V(n) asm volatile("s_waitcnt vmcnt(" #n ")" ::: "memory")
#define PG8_WAIT_L(n) asm volatile("s_waitcnt lgkmcnt(" #n ")" ::: "memory")
#define PG8_BAR __builtin_amdgcn_s_barrier()
#define PG8_SCHED __builtin_amdgcn_sched_barrier(0)
    Unit cur, nxt; int ui = 0;
    if (!S.next(0, cur)) return;
    f32x4 acc[2][2][4][2];
#pragma unroll
    for (int a = 0; a < 2; ++a)
#pragma unroll
        for (int b = 0; b < 2; ++b)
#pragma unroll
            for (int m = 0; m < 4; ++m)
#pragma unroll
                for (int n = 0; n < 2; ++n) acc[a][b][m][n] = (f32x4){0.f, 0.f, 0.f, 0.f};
    bf16x8 At[4][2], B0[2][2], B1[2][2];
    const char* cA = (const char*)g.A + (size_t)cur.pm * tstepA + (size_t)cur.k0 * 2; const char* cB = (const char*)g.Bt + (size_t)cur.pn * tstepB + (size_t)cur.k0 * 2;
    PG8_RTAB_LOAD(cur.pm); PG8_RTAB_FIN(0);
    PG8_STAGE(PG8_SB(0, 0), cB, voffB); PG8_STAGE(PG8_SB(0, 1), cB + hstepB, voffB); PG8_STAGE(PG8_SA(0, 0), cA, voffA); PG8_STAGE(PG8_SA(0, 1), cA + hstepA, voffA);
    if (wr == 1) PG8_BAR;
    PG8_WAIT_V(2); PG8_BAR;
    PG8_STAGE(PG8_SB(1, 0), cB + kstep, voffB); PG8_STAGE(PG8_SA(1, 0), cA + kstep, voffA); PG8_STAGE(PG8_SB(1, 1), cB + hstepB + kstep, voffB);
    PG8_WAIT_V(6); PG8_BAR;
    for (;;) {
        const bool has_next = S.next(ui + 1, nxt);
        const char* nA = has_next ? (const char*)g.A + (size_t)nxt.pm * tstepA + (size_t)nxt.k0 * 2 : cA; const char* nB = has_next ? (const char*)g.Bt + (size_t)nxt.pn * tstepB + (size_t)nxt.k0 * 2 : cB;
        const int nt = cur.nt, qm = cur.qm;
        if (qm == 0xF) { PG8_KLOOP(true, true, true, true) } else { PG8_KLOOP((qm & 1), (qm & 2), (qm & 4), (qm & 8)) }
        if (wr == 0) PG8_BAR;
        if (has_next) PG8_RTAB_LOAD(nxt.pm);
        E(acc, cur, wr, wc, fr, fq, rtab + (ui & 1) * 256);
        if (!has_next) break;
#pragma unroll
        for (int a = 0; a < 2; ++a)
#pragma unroll
            for (int b = 0; b < 2; ++b)
#pragma unroll
                for (int m = 0; m < 4; ++m)
#pragma unroll
                    for (int n = 0; n < 2; ++n) acc[a][b][m][n] = (f32x4){0.f, 0.f, 0.f, 0.f};
        cur = nxt; cA = nA; cB = nB; ++ui;
        PG8_RTAB_FIN(ui & 1);
        if (wr == 1) PG8_BAR;
    }
    PG8_WAIT_V(0);
    PG8_BAR;
#undef PG8_SA
#undef PG8_RTAB_LOAD
#undef PG8_RTAB_FIN
#undef PG8_SB
#undef PG8_STAGE
#undef PG8_LDA
#undef PG8_LDB
#undef PG8_MMA
#undef PG8_WAIT_V
#undef PG8_WAIT_L
#undef PG8_BAR
#undef PG8_SCHED
}
}
using pg8::Unit;

#define EPI_FENCE() asm volatile("" ::: "memory")
struct EpiSwiglu {
    bf16_t* hid;
    __device__ __forceinline__ void operator()(const f32x4 (&acc)[2][2][4][2], const Unit& u, int wr, int wc, int fr, int fq, const LAS float* rt) const {
        const int row0 = u.pm * 256 + wr * 64 + fr, col = u.pn * 128 + wc * 32 + 8 * fq;
#pragma unroll
        for (int ai = 0; ai < 2; ++ai)
#pragma unroll
            for (int m = 0; m < 4; ++m) {
                const int rl = ai * 128 + m * 16; const int row = row0 + rl; const float rs = rt[wr * 64 + fr + rl];
                float h[8];
#pragma unroll
                for (int n = 0; n < 2; ++n)
#pragma unroll
                    for (int i = 0; i < 4; ++i) { const float a = acc[ai][0][m][n][i] * rs, b = acc[ai][1][m][n][i] * rs; h[4 * n + i] = a * sigm(a) * b; }
                u32x4 w; w.x = pk2(h[0], h[1]); w.y = pk2(h[2], h[3]); w.z = pk2(h[4], h[5]); w.w = pk2(h[6], h[7]);
                *(u32x4*)(hid + (size_t)row * FF + col) = w;
            }
    }
};
struct EpiWin {
    bf16_t* proj; float* out; int layer;
    __device__ __forceinline__ void operator()(const f32x4 (&acc)[2][2][4][2], const Unit& u, int wr, int wc, int fr, int fq, const LAS float* rt) const {
        const int row0 = u.pm * 256 + wr * 64 + fr, pn = u.pn;
        const bool isgate = (pn >= 10 && pn < 22), iskv = (pn >= 2 && pn < 6), ispool = (pn == 9);
#pragma unroll
        for (int ai = 0; ai < 2; ++ai)
#pragma unroll
            for (int m = 0; m < 4; ++m) {
                const int rl = ai * 128 + m * 16; const int row = row0 + rl; const float rs = rt[wr * 64 + fr + rl];
#pragma unroll
                for (int bj = 0; bj < 2; ++bj) {
                    if (!((u.qm >> (ai * 2 + bj)) & 1)) continue;
                    const int ct = bj * 128 + wc * 32 + 8 * fq;
                    f32x4 v0 = acc[ai][bj][m][0] * rs, v1 = acc[ai][bj][m][1] * rs;
                    if (isgate) {
#pragma unroll
                        for (int i = 0; i < 4; ++i) { v0[i] = sigm(v0[i]); v1[i] = sigm(v1[i]); }
                    }
                    u32x4 w; w.x = pk2(v0[0], v0[1]); w.y = pk2(v0[2], v0[3]); w.z = pk2(v1[0], v1[1]); w.w = pk2(v1[2], v1[3]);
                    *(u32x4*)(proj + (size_t)row * PW + pn * 256 + ct) = w;
                    if (iskv) {
                        const int c512 = (pn & 1) * 256 + ct; const bool isv = pn >= 4;
                        float* dst = row < MP ? out + (isv ? O_VP : O_KP) + ((size_t)layer * MP + row) * 512 + c512
                                              : out + (isv ? O_VS : O_KS) + ((size_t)layer * 2048 + (row - MP)) * 512 + c512;
                        *(f32x4*)dst = v0; *(f32x4*)(dst + 4) = v1;
                    }
                    if (ispool) {
                        if (row < MP) { const int t = row & 8191, b = row >> 13; if (t >= 8177) { float* dst = out + O_PP + ((size_t)(layer * 4 + b) * 15 + (t - 8177)) * 256 + ct; *(f32x4*)dst = v0; *(f32x4*)(dst + 4) = v1; } }
                        else { const int r = row - MP, t = r & 63, sb = r >> 6; if (t >= 49) { float* dst = out + O_PS + ((size_t)(layer * 32 + sb) * 15 + (t - 49)) * 256 + ct; *(f32x4*)dst = v0; *(f32x4*)(dst + 4) = v1; } }
                    }
                }
            }
    }
};
struct EpiRes {
    float* x; bf16_t* xb; float* ss_out; const bf16_t* scr; float alpha; int mode; const float* xin0; const float* xin1;
    __device__ __forceinline__ void operator()(const f32x4 (&acc)[2][2][4][2], const Unit& u, int wr, int wc, int fr, int fq, const LAS float* rt) const {
        const int row0 = u.pm * 256 + wr * 64 + fr, colb = u.pn * 256 + wc * 32 + 8 * fq;
#pragma unroll
        for (int ai = 0; ai < 2; ++ai) {
            if (!((u.qm >> (2 * ai)) & 3)) continue;
#pragma unroll
            for (int mp = 0; mp < 2; ++mp) {
                f32x4 xv[2][2][2]; u32x4 sv[2][2];
                const float* xr = xin0 ? (u.pm < MP / 256 ? xin0 : xin1 - (size_t)MP * D) : x;
#pragma unroll
                for (int mi = 0; mi < 2; ++mi)
#pragma unroll
                    for (int bj = 0; bj < 2; ++bj) {
                        const size_t off = (size_t)(row0 + ai * 128 + (2 * mp + mi) * 16) * D + colb + bj * 128;
                        xv[mi][bj][0] = *(const f32x4*)(xr + off); xv[mi][bj][1] = *(const f32x4*)(xr + off + 4);
                    }
#pragma unroll
                for (int mi = 0; mi < 2; ++mi) {
                    const int m = 2 * mp + mi, rl = ai * 128 + m * 16, row = row0 + rl;
                    const float rs = (mode == 1) ? rt[wr * 64 + fr + rl] : 1.f;
                    if (mode == 1) {
#pragma unroll
                        for (int bj = 0; bj < 2; ++bj) { const size_t off = (size_t)row * D + colb + bj * 128; sv[mi][bj] = *(const u32x4*)(scr + off); }
                    }
#pragma unroll
                    for (int bj = 0; bj < 2; ++bj) {
                        if (!((u.qm >> (ai * 2 + bj)) & 1)) continue;
                        const size_t off = (size_t)row * D + colb + bj * 128;
                        f32x4 v0 = acc[ai][bj][m][0], v1 = acc[ai][bj][m][1];
                        if (mode == 1) {
#pragma unroll
                            for (int i = 0; i < 4; ++i) { v0[i] = sigm(v0[i] * rs); v1[i] = sigm(v1[i] * rs); }
                            { const u32x4 p4 = sv[mi][bj]; v0[0] *= bflo(p4.x); v0[1] *= bfhi(p4.x); v0[2] *= bflo(p4.y); v0[3] *= bfhi(p4.y); v1[0] *= bflo(p4.z); v1[1] *= bfhi(p4.z); v1[2] *= bflo(p4.w); v1[3] *= bfhi(p4.w); }
                        } else { v0 = v0 * alpha; v1 = v1 * alpha; }
                        const f32x4 x0 = xv[mi][bj][0] + v0, x1 = xv[mi][bj][1] + v1;
                        *(f32x4*)(x + off) = x0; *(f32x4*)(x + off + 4) = x1;
                        u32x4 w; w.x = pk2(x0[0], x0[1]); w.y = pk2(x0[2], x0[3]); w.z = pk2(x1[0], x1[1]); w.w = pk2(x1[2], x1[3]);
                        *(u32x4*)(xb + off) = w;
                        float ssum = (x0[0] * x0[0] + x0[1] * x0[1]) + (x0[2] * x0[2] + x0[3] * x0[3]) + (x1[0] * x1[0] + x1[1] * x1[1]) + (x1[2] * x1[2] + x1[3] * x1[3]);
                        ssum += __shfl_xor(ssum, 16); ssum += __shfl_xor(ssum, 32);
                        if (fq == 0) ss_out[(size_t)row * 32 + u.pn * 8 + bj * 4 + wc] = ssum;
                    }
                }
                EPI_FENCE();
            }
        }
    }
};
struct EpiBranch {
    const bf16_t* proj; bf16_t* scr; bf16_t* merged; int mode;
    template <int BR>
    __device__ __forceinline__ void run(const f32x4 (&acc)[2][2][4][2], const Unit& u, int wr, int wc, int fr, int fq) const {
        const int row0 = u.pm * 256 + wr * 64 + fr, colb = u.pn * 256 + wc * 32 + 8 * fq;
#pragma unroll
        for (int ai = 0; ai < 2; ++ai) {
            if (!((u.qm >> (2 * ai)) & 3)) continue;
#pragma unroll
            for (int mp = 0; mp < 2; ++mp) {
                u32x4 gt[2][2], sv[2][2];
#pragma unroll
                for (int mi = 0; mi < 2; ++mi)
#pragma unroll
                    for (int bj = 0; bj < 2; ++bj) {
                        const int row = row0 + ai * 128 + (2 * mp + mi) * 16, col = colb + bj * 128; const size_t off = (size_t)row * D + col;
                        if (BR < 3) gt[mi][bj] = *(const u32x4*)(proj + (size_t)row * PW + C_G + BR * 1024 + col);
                        if (BR == 1 || BR == 2) sv[mi][bj] = *(const u32x4*)(scr + off);
                    }
#pragma unroll
                for (int mi = 0; mi < 2; ++mi)
#pragma unroll
                    for (int bj = 0; bj < 2; ++bj) {
                        if (!((u.qm >> (ai * 2 + bj)) & 1)) continue;
                        const int m = 2 * mp + mi, row = row0 + ai * 128 + m * 16, col = colb + bj * 128; const size_t off = (size_t)row * D + col;
                        f32x4 v0 = acc[ai][bj][m][0], v1 = acc[ai][bj][m][1];
                        if (BR < 3) { const u32x4 g4 = gt[mi][bj];
                            v0[0] *= bflo(g4.x); v0[1] *= bfhi(g4.x); v0[2] *= bflo(g4.y); v0[3] *= bfhi(g4.y);
                            v1[0] *= bflo(g4.z); v1[1] *= bfhi(g4.z); v1[2] *= bflo(g4.w); v1[3] *= bfhi(g4.w); }
                        if (BR == 1 || BR == 2) { const u32x4 p4 = sv[mi][bj]; v0[0] += bflo(p4.x); v0[1] += bfhi(p4.x); v0[2] += bflo(p4.y); v0[3] += bfhi(p4.y); v1[0] += bflo(p4.z); v1[1] += bfhi(p4.z); v1[2] += bflo(p4.w); v1[3] += bfhi(p4.w); }
                        { u32x4 w; w.x = pk2(v0[0], v0[1]); w.y = pk2(v0[2], v0[3]); w.z = pk2(v1[0], v1[1]); w.w = pk2(v1[2], v1[3]); *(u32x4*)((BR == 2 ? merged : scr) + off) = w; }
                    }
                EPI_FENCE();
            }
        }
    }
    __device__ __forceinline__ void operator()(const f32x4 (&acc)[2][2][4][2], const Unit& u, int wr, int wc, int fr, int fq, const LAS float* rt) const {
        if (mode == 1) run<3>(acc, u, wr, wc, fr, fq);
        else if (u.kind == 0) run<0>(acc, u, wr, wc, fr, fq);
        else if (u.kind == 1) run<1>(acc, u, wr, wc, fr, fq);
        else run<2>(acc, u, wr, wc, fr, fq);
    }
};

struct Args { const float* in[29]; float* out; unsigned char* ws; int ph_lo, ph_hi; };
constexpr int NPH = 26;
constexpr int LDS_BYTES = 147456;

struct Ctx {
    const float* const* in; float* out; unsigned char* ws; LAS unsigned char* lds; unsigned char* ldsg; int tid, lane, wave, G, bx;
};

enum { MAP_ID = 0, MAP_SWIGLU = 1, MAP_WIN = 2 };
__device__ __forceinline__ int map_col(int mode, int n) {
    if (mode == MAP_ID) return n;
    if (mode == MAP_SWIGLU) { const int p = n >> 8, j = n & 255; return j < 128 ? p * 128 + j : FF + p * 128 + (j - 128); }
    if (n < 2048) return n;
    if (n < 2304) return 2064 + (n - 2048);
    if (n < 2560) return 2320 + (n - 2304);
    if (n < 5632) return 2576 + (n - 2560);
    if (n < 5648) return 2048 + (n - 5632);
    return -1;
}
__device__ __forceinline__ void tconv(const Ctx& c, const float* src, int ldsrc, int K, bf16_t* dst, int lddst, int Nout, int mode, const float* g, int& toff) {
    float* tile = (float*)c.ldsg;
    const int ntn = Nout / 64, ntk = K / 256, nt = ntn * ntk;
    const int first = (c.bx + c.G - (toff % c.G)) % c.G; toff += nt;
    for (int it = first; it < nt; it += c.G) {
        const int tn = it % ntn, tk = it / ntn, n0 = tn * 64, k0 = tk * 256;
        const int nn = c.tid & 63, sc = map_col(mode, n0 + nn), kq = c.tid >> 6;
        float v[32];
#pragma unroll
        for (int i = 0; i < 32; ++i) { const int kk = kq + 8 * i; v[i] = (sc >= 0) ? src[(size_t)(k0 + kk) * ldsrc + sc] : 0.f; }
        if (g) {
#pragma unroll
            for (int i = 0; i < 32; ++i) v[i] *= g[k0 + kq + 8 * i];
        }
#pragma unroll
        for (int i = 0; i < 32; ++i) tile[(kq + 8 * i) * 65 + nn] = v[i];
        __syncthreads();
        { const int n2 = c.tid >> 3, kg = c.tid & 7;
#pragma unroll
          for (int j = 0; j < 4; ++j) { const float* s = tile + (kg * 8 + 64 * j) * 65 + n2;
              u32x4 o; o.x = pk2(s[0], s[65]); o.y = pk2(s[130], s[195]); o.z = pk2(s[260], s[325]); o.w = pk2(s[390], s[455]);
              *(u32x4*)(dst + (size_t)(n0 + n2) * lddst + k0 + kg * 8 + 64 * j) = o; } }
        __syncthreads();
    }
}
__device__ __forceinline__ float wave_sum(float v) {
#pragma unroll
    for (int o = 1; o < 64; o <<= 1) v += __shfl_xor(v, o);
    return v;
}
__device__ __forceinline__ void prologue(const Ctx& c) {
    bf16_t* W = (bf16_t*)(c.ws + WS_W);
    int toff = 0;
    for (int l = 0; l < 2; ++l) {
        bf16_t* Wl = W + (size_t)l * WL_END;
        tconv(c, c.in[9] + (size_t)l * D * 2 * FF, 2 * FF, D, Wl + WL_1IN, D, 2 * FF, MAP_SWIGLU, c.in[8] + l * D, toff);
        tconv(c, c.in[10] + (size_t)l * FF * D, D, FF, Wl + WL_1OUT, FF, D, MAP_ID, nullptr, toff);
        tconv(c, c.in[12] + (size_t)l * D * INW, INW, D, Wl + WL_IN, D, NIN, MAP_WIN, c.in[11] + l * D, toff);
        tconv(c, c.in[18] + (size_t)l * 512 * D, D, 512, Wl + WL_BR, D, D, MAP_ID, nullptr, toff);
        tconv(c, c.in[19] + (size_t)l * 256 * D, D, 256, Wl + WL_BR + 512, D, D, MAP_ID, nullptr, toff);
        tconv(c, c.in[21] + (size_t)l * D * D, D, D, Wl + WL_OUT, D, D, MAP_ID, nullptr, toff);
        tconv(c, c.in[23] + (size_t)l * D * 2 * FF, 2 * FF, D, Wl + WL_2IN, D, 2 * FF, MAP_SWIGLU, c.in[22] + l * D, toff);
        tconv(c, c.in[24] + (size_t)l * FF * D, D, FF, Wl + WL_2OUT, FF, D, MAP_ID, nullptr, toff);
        tconv(c, c.in[26] + (size_t)l * D * D, D, D, Wl + WL_PG, D, D, MAP_ID, c.in[25] + l * D, toff);
        tconv(c, c.in[27] + (size_t)l * 256 * D, D, 256, Wl + WL_PP, 256, D, MAP_ID, nullptr, toff);
        const float* pw = c.in[16] + (size_t)l * 4 * 64 * 64; const float* psc = c.in[17] + l * 256; const float* wc = c.in[20] + (size_t)l * 256 * D;
        for (int idx = c.bx * 512 + c.tid; idx < 256 * 1024; idx += c.G * 512) {
            const int n = idx & 1023, kc = idx >> 10, gq = kc >> 6, cc = kc & 63; float s = 0.f;
            for (int dd = 0; dd < 64; ++dd) s += pw[(gq * 64 + cc) * 64 + dd] * psc[gq * 64 + dd] * wc[(size_t)(gq * 64 + dd) * D + n];
            Wl[WL_BR + (size_t)n * D + 768 + kc] = (bf16_t)f2bf(s);
        }
    }
    bf16_t* xb = (bf16_t*)(c.ws + WS_XB); float* ss0 = (float*)(c.ws + WS_SS);
    for (int row = c.bx * 8 + c.wave; row < M; row += c.G * 8) {
        const float* src = row < MP ? c.in[0] + (size_t)row * D : c.in[1] + (size_t)(row - MP) * D;
        f32x4 v[4]; float s = 0.f;
#pragma unroll
        for (int j = 0; j < 4; ++j) { v[j] = *(const f32x4*)(src + c.lane * 4 + 256 * j); s += (v[j][0] * v[j][0] + v[j][1] * v[j][1]) + (v[j][2] * v[j][2] + v[j][3] * v[j][3]); }
        s = wave_sum(s);
#pragma unroll
        for (int j = 0; j < 4; ++j) { u32x2 w; w.x = pk2(v[j][0], v[j][1]); w.y = pk2(v[j][2], v[j][3]); *(u32x2*)(xb + (size_t)row * D + c.lane * 4 + 256 * j) = w; }
        if (c.lane < 32) ss0[(size_t)row * 32 + c.lane] = c.lane == 0 ? s : 0.f;
    }
    bf16_t* pb = (bf16_t*)(c.ws + WS_PB);
#pragma unroll 4
    for (size_t i4 = (size_t)c.bx * 512 + c.tid; i4 < (size_t)2 * M * 64; i4 += (size_t)c.G * 512) {
        const size_t e = i4 * 4; const int l = (int)(e / ((size_t)M * 256)); const size_t r = e - (size_t)l * M * 256; const int row = (int)(r >> 8), cc = (int)(r & 255);
        const float* src = row < MP ? c.in[6] + ((size_t)l * MP + row) * 256 + cc : c.in[7] + ((size_t)l * 2048 + (row - MP)) * 256 + cc;
        const f32x4 v = *(const f32x4*)src; u32x2 w; w.x = pk2(v[0], v[1]); w.y = pk2(v[2], v[3]); *(u32x2*)(pb + e) = w;
    }
}

__device__ __forceinline__ int next_item(const Ctx& c, int slot) {
    volatile int* sh = (volatile int*)(c.ldsg + 147392);
    __syncthreads();
    if (c.tid == 0) *sh = (int)__hip_atomic_fetch_add((unsigned*)(c.ws + WS_CTL) + 64 * (1 + slot), 1u, __ATOMIC_RELAXED, __HIP_MEMORY_SCOPE_AGENT);
    __syncthreads();
    return *sh;
}
__device__ __forceinline__ void gla_local_unit(const Ctx& c, int l, int g, int h) {
    float* L = (float*)c.ldsg; float* rs = L; float* wg = L + 1024; float* bg = L + 1536; float* la = L + 1600; float* kt = L + 3712; float* vs = L + 5824;
    const bf16_t* proj = (const bf16_t*)(c.ws + WS_BIG); const int m0 = g * 64, tid = c.tid;
    { const int e = tid * 2, row = e >> 4, cc = e & 15; const unsigned w = *(const unsigned*)(proj + (size_t)(m0 + row) * PW + C_RB + cc); rs[e] = bflo(w); rs[e + 1] = bfhi(w); }
    { const int j = tid >> 5, d = tid & 31; wg[tid] = c.in[13][(size_t)(l * 16 + j) * 128 + h * 32 + d]; }
    if (tid < 32) bg[tid] = c.in[14][l * 128 + h * 32 + tid];
    __syncthreads();
#pragma unroll
    for (int i = 0; i < 4; ++i) { const int o = tid + 512 * i, t = o >> 5, d = o & 31; float a = bg[d];
#pragma unroll
        for (int j = 0; j < 16; ++j) a += rs[t * 16 + j] * wg[j * 32 + d];
        la[t * 33 + d] = (fminf(a, 0.f) - flog(1.0f + fexp(-fabsf(a)))) * (1.0f / 16.0f); }
    __syncthreads();
    {
#pragma unroll
        for (int j = 0; j < 4; ++j) { const int d = c.wave * 4 + j; float v = la[c.lane * 33 + d];
#pragma unroll
            for (int o = 1; o < 64; o <<= 1) { const float n = __shfl_up(v, o); if (c.lane >= o) v += n; }
            la[c.lane * 33 + d] = v; }
    }
    __syncthreads();
    float* bws = (float*)(c.ws + WS_B);
#pragma unroll
    for (int i = 0; i < 4; ++i) { const int o = tid + 512 * i, t = o >> 5, d = o & 31; const float b = la[t * 33 + d];
        bws[(size_t)(m0 + t) * 128 + h * 32 + d] = b;
        kt[t * 33 + d] = bf2f(proj[(size_t)(m0 + t) * PW + C_KB + h * 32 + d]) * fexp(-b); }
    { const int t = tid >> 3, e0 = (tid & 7) * 8; const u32x4 w = *(const u32x4*)(proj + (size_t)(m0 + t) * PW + C_VB + h * 64 + e0); float* d = vs + t * 64 + e0;
      d[0] = bflo(w.x); d[1] = bfhi(w.x); d[2] = bflo(w.y); d[3] = bfhi(w.y); d[4] = bflo(w.z); d[5] = bfhi(w.z); d[6] = bflo(w.w); d[7] = bfhi(w.w); }
    __syncthreads();
    { const int d = tid >> 4, e0 = (tid & 15) * 4; f32x4 a = {0.f, 0.f, 0.f, 0.f};
      for (int t = 0; t < 64; ++t) { const float kk = kt[t * 33 + d]; const f32x4 v = *(const f32x4*)(vs + t * 64 + e0); a = a + v * kk; }
      *(f32x4*)((float*)(c.ws + WS_DS) + ((size_t)(g * 4 + h) * 32 + d) * 64 + e0) = a; }
    if (tid < 32) ((float*)(c.ws + WS_DEC))[(size_t)(g * 4 + h) * 32 + tid] = fexp(la[63 * 33 + tid]);
    __syncthreads();
}
__device__ __forceinline__ void pool_unit(const Ctx& c, int l, int g) {
    float* ext = (float*)c.ldsg;
    const bf16_t* proj = (const bf16_t*)(c.ws + WS_BIG); bf16_t* Y = (bf16_t*)(c.ws + WS_Y);
    const int m0 = g * 64, tid = c.tid; const bool samp = g >= 512; const int cidx = samp ? 0 : (g & 127);
#pragma unroll
    for (int it = 0; it < 5; ++it) { const int q = tid + 512 * it;
        if (q < 79 * 32) { const int j = q >> 5, c8 = (q & 31) * 8; float* d = ext + j * 256 + c8;
            if (j >= 15 || cidx > 0) { const u32x4 w = *(const u32x4*)(proj + (size_t)(m0 + j - 15) * PW + C_UC + c8);
                *(f32x4*)d = (f32x4){bflo(w.x), bfhi(w.x), bflo(w.y), bfhi(w.y)}; *(f32x4*)(d + 4) = (f32x4){bflo(w.z), bfhi(w.z), bflo(w.w), bfhi(w.w)}; }
            else if (samp) { const float* sp = c.in[5] + ((size_t)(l * 32 + (g - 512)) * 15 + j) * 256 + c8; *(f32x4*)d = *(const f32x4*)sp; *(f32x4*)(d + 4) = *(const f32x4*)(sp + 4); }
            else { *(f32x4*)d = (f32x4){0.f, 0.f, 0.f, 0.f}; *(f32x4*)(d + 4) = (f32x4){0.f, 0.f, 0.f, 0.f}; } } }
    __syncthreads();
    { const int cc = tid & 255, ts = tid >> 8, gi = cc >> 6, w = 2 << gi;
      for (int i = 0; i < 32; ++i) { const int t = ts * 32 + i; float s = 0.f;
          for (int j = 0; j < w; ++j) s += ext[(15 + t - j) * 256 + cc];
          const int pos = samp ? 2048 + t : cidx * 64 + t; const float cnt = (float)min(w, pos + 1);
          const float dv = s / cnt - ext[(15 + t) * 256 + cc];
          Y[(size_t)(m0 + t) * D + 768 + cc] = (bf16_t)f2bf(dv); } }
    __syncthreads();
}

__device__ __forceinline__ void scan_unit(const Ctx& c, int l, int su) {
    const float* dS = (const float*)(c.ws + WS_DS); const float* dec = (const float*)(c.ws + WS_DEC); float* St = (float*)(c.ws + WS_ST);
    int g0, n, h, idx; float S; float* outp;
    if (su < 64) { const int bh = su >> 2, b = bh >> 2; h = bh & 3; idx = (su & 3) * 512 + c.tid; g0 = b * 128; n = 128; S = 0.f; outp = c.out + O_GP + ((size_t)(l * 4 + b) * 4 + h) * 2048 + idx; }
    else { const int s2 = su - 64, sbh = s2 >> 2, sb = sbh >> 2; h = sbh & 3; idx = (s2 & 3) * 512 + c.tid; g0 = 512 + sb; n = 1; S = c.in[4][((size_t)(l * 32 + sb) * 4 + h) * 2048 + idx]; outp = c.out + O_GS + ((size_t)(l * 32 + sb) * 4 + h) * 2048 + idx; }
    const int d = idx >> 6;
#pragma unroll 8
    for (int cc = 0; cc < n; ++cc) { const size_t gh = (size_t)(g0 + cc) * 4 + h; const float dd = dS[gh * 2048 + idx], de = dec[gh * 32 + d]; St[gh * 2048 + idx] = S; S = de * (S + dd); }
    *outp = S;
}
__device__ __forceinline__ void attn_unit(const Ctx& c, int l, int au) {
    bf16_t* Ks = (bf16_t*)c.ldsg; bf16_t* Vt = (bf16_t*)(c.ldsg + 18432); int* flags = (int*)(c.ldsg + 35840);
    const bf16_t* proj = (const bf16_t*)(c.ws + WS_BIG); bf16_t* Y = (bf16_t*)(c.ws + WS_Y);
    int R0, n_past, qb, hp, sb = 0;
    if (au < 2048) { const int b = au >> 9, rem = au & 511; qb = rem >> 2; hp = rem & 3; R0 = b * 8192; n_past = 0; }
    else { const int a2 = au - 2048; sb = a2 >> 2; hp = a2 & 3; qb = 0; R0 = MP + sb * 64; n_past = 2048; }
    const int tid = c.tid, w = c.wave, lane = c.lane, fr = lane & 15, fq = lane >> 4, hsel = w >> 2, hh = 2 * hp + hsel, qsub = w & 3;
    const int qrow = R0 + qb * 64 + qsub * 16 + fr, qpos = n_past + qb * 64 + qsub * 16 + fr;
    bf16x8 qf[2];
#pragma unroll
    for (int ks = 0; ks < 2; ++ks) qf[ks] = *(const bf16x8*)(proj + (size_t)qrow * PW + C_QA + hh * 64 + 32 * ks + 8 * fq);
    f32x4 O[4];
#pragma unroll
    for (int i = 0; i < 4; ++i) O[i] = (f32x4){0.f, 0.f, 0.f, 0.f};
    float carry = 0.f; bool wdone = false;
    int kt = (n_past + qb * 64) >> 6;
    const int lh = tid >> 8, lj = (tid >> 2) & 63, d0 = (tid & 3) * 16, lhead = 2 * hp + lh;
    for (;;) {
        {
            const int kpos = kt * 64 + lj; unsigned kk[8], vv[8];
            if (kpos < n_past) {
                const size_t o = (((size_t)(l * 32 + sb) * 2048 + kpos) * 512) + lhead * 64 + d0; const float* kp = c.in[2] + o; const float* vp = c.in[3] + o;
#pragma unroll
                for (int i = 0; i < 4; ++i) { const f32x4 a = *(const f32x4*)(kp + 4 * i), b = *(const f32x4*)(vp + 4 * i); kk[2 * i] = pk2(a[0], a[1]); kk[2 * i + 1] = pk2(a[2], a[3]); vv[2 * i] = pk2(b[0], b[1]); vv[2 * i + 1] = pk2(b[2], b[3]); }
            } else {
                const bf16_t* rp = proj + (size_t)(R0 + kpos - n_past) * PW + lhead * 64 + d0;
                const u32x4 a0 = *(const u32x4*)(rp + C_KA), a1 = *(const u32x4*)(rp + C_KA + 8), b0 = *(const u32x4*)(rp + C_VA), b1 = *(const u32x4*)(rp + C_VA + 8);
                kk[0] = a0.x; kk[1] = a0.y; kk[2] = a0.z; kk[3] = a0.w; kk[4] = a1.x; kk[5] = a1.y; kk[6] = a1.z; kk[7] = a1.w;
                vv[0] = b0.x; vv[1] = b0.y; vv[2] = b0.z; vv[3] = b0.w; vv[4] = b1.x; vv[5] = b1.y; vv[6] = b1.z; vv[7] = b1.w;
            }
            bf16_t* kd = Ks + (lh * 64 + lj) * 72 + d0;
            *(u32x4*)kd = (u32x4){kk[0], kk[1], kk[2], kk[3]}; *(u32x4*)(kd + 8) = (u32x4){kk[4], kk[5], kk[6], kk[7]};
#pragma unroll
            for (int i = 0; i < 8; ++i) { Vt[(lh * 64 + d0 + 2 * i) * 68 + lj] = (bf16_t)(vv[i] & 0xffffu); Vt[(lh * 64 + d0 + 2 * i + 1) * 68 + lj] = (bf16_t)(vv[i] >> 16); }
        }
        __syncthreads();
        {
            f32x4 sa[4];
#pragma unroll
            for (int u = 0; u < 4; ++u) { sa[u] = (f32x4){0.f, 0.f, 0.f, 0.f};
#pragma unroll
                for (int ks = 0; ks < 2; ++ks) { const bf16x8 kf = *(const bf16x8*)(Ks + (hsel * 64 + 16 * u + fr) * 72 + 32 * ks + 8 * fq); sa[u] = __builtin_amdgcn_mfma_f32_16x16x32_bf16(kf, qf[ks], sa[u], 0, 0, 0); } }
            float lk[4][4], lw[4][4], ls[4], suf[4], T[4];
#pragma unroll
            for (int u = 0; u < 4; ++u) { ls[u] = 0.f;
#pragma unroll
                for (int i = 0; i < 4; ++i) { const float z = sa[u][i] * 0.125f; const int kpos = kt * 64 + 16 * u + 4 * fq + i; const bool valid = kpos < qpos;
                    const float sp = softplus(z); lk[u][i] = valid ? -sp : 0.f; lw[u][i] = valid ? (z - sp) : -1e30f; ls[u] += lk[u][i]; } }
#pragma unroll
            for (int u = 0; u < 4; ++u) { const float a = __shfl_xor(ls[u], 16), t1 = ls[u] + a, o = __shfl_xor(t1, 32); T[u] = t1 + o; suf[u] = ((fq & 1) ? 0.f : a) + ((fq & 2) ? 0.f : o); }
            float base = carry; float wv[4][4];
#pragma unroll
            for (int u = 3; u >= 0; --u) { float run = base + suf[u];
#pragma unroll
                for (int i = 3; i >= 0; --i) { wv[u][i] = fexp(lw[u][i] + run); run += lk[u][i]; }
                base += T[u]; }
            carry = base;
#pragma unroll
            for (int k2 = 0; k2 < 2; ++k2) {
                u32x4 pw; pw.x = pk2(wv[2 * k2][0], wv[2 * k2][1]); pw.y = pk2(wv[2 * k2][2], wv[2 * k2][3]); pw.z = pk2(wv[2 * k2 + 1][0], wv[2 * k2 + 1][1]); pw.w = pk2(wv[2 * k2 + 1][2], wv[2 * k2 + 1][3]);
                const bf16x8 pf = __builtin_bit_cast(bf16x8, pw);
#pragma unroll
                for (int db = 0; db < 4; ++db) { const bf16_t* vp = Vt + (hsel * 64 + 16 * db + fr) * 68 + 32 * k2 + 4 * fq; const u32x2 lo = *(const u32x2*)vp, hi = *(const u32x2*)(vp + 16);
                    const bf16x8 vf = __builtin_bit_cast(bf16x8, (u32x4){lo.x, lo.y, hi.x, hi.y}); O[db] = __builtin_amdgcn_mfma_f32_16x16x32_bf16(vf, pf, O[db], 0, 0, 0); }
            }
            wdone = __all(carry < -46.f) != 0;
        }
        --kt;
        if (lane == 0) flags[w] = wdone ? 1 : 0;
        __syncthreads();
        int alld = 1;
#pragma unroll
        for (int i = 0; i < 8; ++i) alld &= flags[i];
        if (alld || kt < 0) break;
    }
#pragma unroll
    for (int db = 0; db < 4; ++db) { u32x2 o; o.x = pk2(O[db][0], O[db][1]); o.y = pk2(O[db][2], O[db][3]); *(u32x2*)(Y + (size_t)qrow * D + hh * 64 + 16 * db + 4 * fq) = o; }
    __syncthreads();
}

__device__ __forceinline__ void gla_out_unit(const Ctx& c, int l, int g, int h) {
    float* L = (float*)c.ldsg; float* qs = L; float* ktT = L + 2112; float* vs = L + 4288; float* sc = L + 8640; float* Ss = L + 12800;
    const bf16_t* proj = (const bf16_t*)(c.ws + WS_BIG); bf16_t* Y = (bf16_t*)(c.ws + WS_Y); const float* bws = (const float*)(c.ws + WS_B);
    const int m0 = g * 64, tid = c.tid;
#pragma unroll
    for (int i = 0; i < 4; ++i) { const int o = tid + 512 * i, t = o >> 5, d = o & 31; const float b = bws[(size_t)(m0 + t) * 128 + h * 32 + d];
        const bf16_t* pr = proj + (size_t)(m0 + t) * PW + h * 32 + d;
        qs[t * 33 + d] = bf2f(pr[C_QB]) * 0.17677669529663687f * fexp(b); ktT[d * 68 + t] = bf2f(pr[C_KB]) * fexp(-b);
        Ss[o] = ((const float*)(c.ws + WS_ST))[(size_t)(g * 4 + h) * 2048 + o]; }
    { const int t = tid >> 3, e0 = (tid & 7) * 8; const u32x4 w = *(const u32x4*)(proj + (size_t)(m0 + t) * PW + C_VB + h * 64 + e0); float* d = vs + t * 68 + e0;
      d[0] = bflo(w.x); d[1] = bfhi(w.x); d[2] = bflo(w.y); d[3] = bfhi(w.y); d[4] = bflo(w.z); d[5] = bfhi(w.z); d[6] = bflo(w.w); d[7] = bfhi(w.w); }
    __syncthreads();
    const int t = tid >> 3, g8 = (tid & 7) * 8;
    { float a[8];
#pragma unroll
      for (int j = 0; j < 8; ++j) a[j] = 0.f;
      for (int d = 0; d < 32; ++d) { const float q = qs[t * 33 + d]; const f32x4 k0 = *(const f32x4*)(ktT + d * 68 + g8), k1 = *(const f32x4*)(ktT + d * 68 + g8 + 4);
#pragma unroll
          for (int j = 0; j < 4; ++j) { a[j] += q * k0[j]; a[4 + j] += q * k1[j]; } }
#pragma unroll
      for (int j = 0; j < 8; ++j) sc[t * 65 + g8 + j] = (g8 + j <= t) ? a[j] : 0.f; }
    __syncthreads();
    { float o[8];
#pragma unroll
      for (int j = 0; j < 8; ++j) o[j] = 0.f;
      for (int s = 0; s <= t; ++s) { const float p = sc[t * 65 + s]; const f32x4 v0 = *(const f32x4*)(vs + s * 68 + g8), v1 = *(const f32x4*)(vs + s * 68 + g8 + 4);
#pragma unroll
          for (int j = 0; j < 4; ++j) { o[j] += p * v0[j]; o[4 + j] += p * v1[j]; } }
      for (int d = 0; d < 32; ++d) { const float q = qs[t * 33 + d]; const f32x4 s0 = *(const f32x4*)(Ss + d * 64 + g8), s1 = *(const f32x4*)(Ss + d * 64 + g8 + 4);
#pragma unroll
          for (int j = 0; j < 4; ++j) { o[j] += q * s0[j]; o[4 + j] += q * s1[j]; } }
      float q2 = 0.f;
#pragma unroll
      for (int j = 0; j < 8; ++j) q2 += o[j] * o[j];
      q2 += __shfl_xor(q2, 1); q2 += __shfl_xor(q2, 2); q2 += __shfl_xor(q2, 4);
      const float r = __builtin_amdgcn_rsqf(q2 * (1.0f / 64.0f) + EPS);
      const u32x4 ow = *(const u32x4*)(proj + (size_t)(m0 + t) * PW + C_OB + h * 64 + g8);
      float ob[8] = {bflo(ow.x), bfhi(ow.x), bflo(ow.y), bfhi(ow.y), bflo(ow.z), bfhi(ow.z), bflo(ow.w), bfhi(ow.w)};
      const float* gn = c.in[15] + l * 256 + h * 64 + g8; float y[8];
#pragma unroll
      for (int j = 0; j < 8; ++j) y[j] = o[j] * r * gn[j] * (ob[j] * sigm(ob[j]));
      u32x4 w; w.x = pk2(y[0], y[1]); w.y = pk2(y[2], y[3]); w.z = pk2(y[4], y[5]); w.w = pk2(y[6], y[7]);
      *(u32x4*)(Y + (size_t)(m0 + t) * D + 512 + h * 64 + g8) = w; }
    __syncthreads();
}

__device__ __forceinline__ void grid_bar(unsigned* ctr, unsigned target) {
    asm volatile("s_waitcnt vmcnt(0)" ::: "memory");
    __syncthreads();
    if (threadIdx.x == 0) {
        __builtin_amdgcn_fence(__ATOMIC_RELEASE, "agent");
        asm volatile("s_waitcnt vmcnt(0)" ::: "memory");
        __hip_atomic_fetch_add(ctr, 1u, __ATOMIC_RELAXED, __HIP_MEMORY_SCOPE_AGENT);
        while (__hip_atomic_load(ctr, __ATOMIC_RELAXED, __HIP_MEMORY_SCOPE_AGENT) < target) __builtin_amdgcn_s_sleep(1);
        __builtin_amdgcn_fence(__ATOMIC_ACQUIRE, "agent");
        asm volatile("s_waitcnt vmcnt(0)" ::: "memory");
    }
    __syncthreads();
}

__global__ void __launch_bounds__(512, 2) fwd_mega(Args args) {
    extern __shared__ __attribute__((aligned(16))) unsigned char lds[];
    cg::grid_group grid = cg::this_grid();
    Ctx c; c.in = args.in; c.out = args.out; c.ws = args.ws; c.lds = (LAS unsigned char*)lds; c.ldsg = lds;
    c.tid = threadIdx.x; c.lane = c.tid & 63; c.wave = __builtin_amdgcn_readfirstlane(c.tid >> 6); c.G = gridDim.x; c.bx = blockIdx.x;
    for (int ph = args.ph_lo; ph < args.ph_hi; ++ph) {
        { int t_ = threadIdx.x; asm volatile("" : "+v"(t_)); c.tid = t_; c.lane = t_ & 63; c.wave = __builtin_amdgcn_readfirstlane(t_ >> 6); }
        unsigned char* ws = args.ws; float* outp = args.out; asm volatile("" : "+s"(ws), "+s"(outp)); c.ws = ws; c.out = outp;
        bf16_t* xb = (bf16_t*)(ws + WS_XB); bf16_t* big = (bf16_t*)(ws + WS_BIG); bf16_t* Yb = (bf16_t*)(ws + WS_Y); bf16_t* mg = (bf16_t*)(ws + WS_MG);
        float* scr = (float*)(ws + WS_SCR); float* ss0 = (float*)(ws + WS_SS); float* ss1 = ss0 + (size_t)M * 32; float* xw = outp + O_Y;
        if (ph == 0) prologue(c);
        else if (ph == 25) {
            const float* gf = args.in[28];
            for (int row = c.bx * 8 + c.wave; row < M; row += c.G * 8) { const float rs = rstd_of(ss0, row);
#pragma unroll
                for (int j = 0; j < 4; ++j) { float* p = xw + (size_t)row * D + c.lane * 4 + 256 * j; const f32x4 v = *(const f32x4*)p, gg = *(const f32x4*)(gf + c.lane * 4 + 256 * j); *(f32x4*)p = v * rs * gg; } }
        } else {
            const int l = (ph - 1) / 12, k = (ph - 1) % 12;
            if ((MK_SKIPMASK >> k) & 1) continue;
            const bf16_t* Wl = (const bf16_t*)(ws + WS_W) + (size_t)l * WL_END;
            if (k == 0 || k == 8) {
                pg8::Gemm g{(k == 0 && l > 0) ? mg : xb, Wl + (k == 0 ? WL_1IN : WL_2IN), D, D}; pg8::Sched S;     S.init(M, 2 * FF, c.G, c.bx, 16);
                EpiSwiglu E{big}; pg8::gemm_phase(c.lds, c.tid, g, S, E, ss0);
            } else if (k == 1 || k == 9 || k == 7 || k == 11) {
                pg8::Gemm g; pg8::Sched S; EpiRes E{xw, xb, nullptr, (const bf16_t*)scr, 1.f, 0, nullptr, nullptr}; const float* ssin = nullptr;
                if (k == 1 || k == 9) { g = pg8::Gemm{big, Wl + (k == 1 ? WL_1OUT : WL_2OUT), FF, FF}; S.init(M, D, c.G, c.bx, 44); S.quart = 1; E.alpha = 0.5f; E.ss_out = ss1; if (l == 0 && k == 1) { E.xin0 = args.in[0]; E.xin1 = args.in[1]; } }
                else if (k == 7) { g = pg8::Gemm{mg, Wl + WL_OUT, D, D}; S.init(M, D, c.G, c.bx, 16); S.quart = 1; E.ss_out = ss0; }
                else { g = pg8::Gemm{xb, Wl + WL_PG, D, D}; S.init(M, D, c.G, c.bx, 16); S.quart = 1; E.ss_out = ss0; ssin = ss1; E.mode = 1; E.xb = mg; }
                pg8::gemm_phase(c.lds, c.tid, g, S, E, ssin);
            } else if (k == 2) {
                pg8::Gemm g{xb, Wl + WL_IN, D, D}; pg8::Sched S; S.init(M, NIN, c.G, c.bx, 16); S.quart = 1;
                EpiWin E{big, outp, l}; pg8::gemm_phase(c.lds, c.tid, g, S, E, ss1);
            } else if (k == 3) {
                for (int it = next_item(c, l * 3 + 0); it < 2176 + NCH; it = next_item(c, l * 3 + 0)) { if (it < NCH) pool_unit(c, l, it); else gla_local_unit(c, l, (it - NCH) >> 2, (it - NCH) & 3); }
            } else if (k == 4) {
                for (int it = next_item(c, l * 3 + 1); it < 576 + 2176; it = next_item(c, l * 3 + 1)) { if (it < 576) scan_unit(c, l, it); else attn_unit(c, l, it - 576); }
            } else if (k == 5) {
                for (int it = next_item(c, l * 3 + 2); it < 2176; it = next_item(c, l * 3 + 2)) gla_out_unit(c, l, it >> 2, it & 3);
            } else {
                pg8::Gemm g; pg8::Sched S; EpiBranch E{big, (bf16_t*)scr, mg, 0};
                if (k == 6) { g = pg8::Gemm{Yb, Wl + WL_BR, D, D}; S.init(M, D, c.G, c.bx, 8); S.nsub = 3; S.quart = 1; }
                else { g = pg8::Gemm{(const bf16_t*)(ws + WS_PB) + (size_t)l * M * 256, Wl + WL_PP, 256, 256}; S.init(M, D, c.G, c.bx, 4); S.quart = 1; E.mode = 1; }
                pg8::gemm_phase(c.lds, c.tid, g, S, E, nullptr);
            }
        }
        if (ph + 1 < args.ph_hi) { if (ph == args.ph_lo) grid.sync(); else grid_bar((unsigned*)(args.ws + WS_CTL), (unsigned)(ph - args.ph_lo) * gridDim.x); }
    }
}

extern "C" void kernel_launch(void* const* d_in, const int* in_sizes, int n_in, void* d_out, int out_size, void* d_ws, size_t ws_size, hipStream_t stream) {
    static int grid = 0;
    if (grid == 0) {
        if (n_in != 29 || ws_size < WS_NEED) { fprintf(stderr, "kernel_launch: unexpected n_in %d / ws %zu\n", n_in, ws_size); grid = -1; return; }
        int dev = 0, cus = 0, per_cu = 0;
        (void)hipGetDevice(&dev); (void)hipDeviceGetAttribute(&cus, hipDeviceAttributeMultiprocessorCount, dev);
        (void)hipFuncSetAttribute((const void*)fwd_mega, hipFuncAttributeMaxDynamicSharedMemorySize, LDS_BYTES);
        (void)hipOccupancyMaxActiveBlocksPerMultiprocessor(&per_cu, (const void*)fwd_mega, 512, LDS_BYTES);
        (void)hipGetLastError();
        if (per_cu < 1) per_cu = 1;
        grid = cus;
    }
    if (grid < 0) return;
    (void)hipMemsetAsync((char*)d_ws + WS_CTL, 0, 4096, stream);
    Args a{};
    for (int i = 0; i < 29; ++i) a.in[i] = (const float*)d_in[i];
    a.out = (float*)d_out; a.ws = (unsigned char*)d_ws;
#if MK_ONE_LAUNCH
    a.ph_lo = 0; a.ph_hi = NPH;
    void* kargs[] = {&a};
    hipError_t e = hipLaunchCooperativeKernel((const void*)fwd_mega, dim3(grid), dim3(512), kargs, LDS_BYTES, stream);
    if (e != hipSuccess) fprintf(stderr, "cooperative launch failed: %s (grid %d)\n", hipGetErrorString(e), grid);
#else
    for (int ph = 0; ph < NPH; ++ph) { a.ph_lo = ph; a.ph_hi = ph + 1; hipLaunchKernelGGL(fwd_mega, dim3(grid), dim3(512), LDS_BYTES, stream, a); }
#endif
}
```

```cpp
#include <hip/hip_runtime.h>
#include <hip/hip_cooperative_groups.h>
#include <cstdio>
#include <cstdint>
namespace cg = cooperative_groups;

#ifndef MK_SKIPMASK
#define MK_SKIPMASK 0
#endif
#ifndef MK_NOATTN
#define MK_NOATTN 0
#endif
#ifndef MK_NOGLAOUT
#define MK_NOGLAOUT 0
#endif
#ifndef MK_ONE_LAUNCH
#define MK_ONE_LAUNCH 1
#endif

#define LAS __attribute__((address_space(3)))
typedef unsigned short bf16_t;
typedef short bf16x8 __attribute__((ext_vector_type(8)));
typedef float f32x4 __attribute__((ext_vector_type(4)));
typedef unsigned u32x4 __attribute__((ext_vector_type(4)));
typedef unsigned u32x2 __attribute__((ext_vector_type(2)));

constexpr int M = 34816;
constexpr int MP = 32768;
constexpr int D = 1024, FF = 2816, NIN = 5888, PW = 5888  , INW = 5648;
constexpr int NCH = 544;
constexpr float EPS = 1e-6f;
constexpr size_t O_Y = 0, O_KP = 35651584, O_VP = 69206016, O_GP = 102760448, O_PP = 102825984, O_KS = 102856704, O_VS = 104953856, O_GS = 107051008, O_PS = 107575296;
constexpr int C_QA = 0, C_KA = 512, C_VA = 1024, C_QB = 1536, C_KB = 1664, C_VB = 1792, C_OB = 2048, C_UC = 2304, C_G = 2560, C_RB = 5632;

constexpr size_t WL_1IN = 0, WL_1OUT = WL_1IN + (size_t)5632 * 1024, WL_IN = WL_1OUT + (size_t)1024 * 2816, WL_BR = WL_IN + (size_t)5888 * 1024, WL_OUT = WL_BR + 1048576,
                 WL_2IN = WL_OUT + 1048576, WL_2OUT = WL_2IN + (size_t)5632 * 1024, WL_PG = WL_2OUT + (size_t)1024 * 2816, WL_PP = WL_PG + 1048576, WL_END = WL_PP + 262144;
constexpr size_t MiB = 1u << 20;
constexpr size_t WS_W = 0;
constexpr size_t WS_XB = 104 * MiB;
constexpr size_t WS_PB = 172 * MiB;
constexpr size_t WS_BIG = 208 * MiB;
constexpr size_t WS_Y = 600 * MiB;
constexpr size_t WS_MG = 668 * MiB;
constexpr size_t WS_SCR = 736 * MiB;
constexpr size_t WS_SS = 934 * MiB;
constexpr size_t WS_DS = 878 * MiB;
constexpr size_t WS_ST = 896 * MiB;
constexpr size_t WS_B = 914 * MiB;
constexpr size_t WS_DEC = 932 * MiB;
constexpr size_t WS_CTL = 933 * MiB;
constexpr size_t WS_NEED = 944 * MiB;
static_assert(2 * WL_END * 2 <= 104 * MiB, "weights fit");

__device__ __forceinline__ unsigned f2bf(float f) { unsigned u = __builtin_bit_cast(unsigned, f); return (u + 0x7fffu + ((u >> 16) & 1u)) >> 16; }
__device__ __forceinline__ unsigned pk2(float lo, float hi) { unsigned r; asm("v_cvt_pk_bf16_f32 %0, %1, %2" : "=v"(r) : "v"(lo), "v"(hi)); return r; }
__device__ __forceinline__ float bflo(unsigned u) { return __uint_as_float(u << 16); }
__device__ __forceinline__ float bfhi(unsigned u) { return __uint_as_float(u & 0xffff0000u); }
__device__ __forceinline__ float bf2f(bf16_t b) { return __uint_as_float((unsigned)b << 16); }
__device__ __forceinline__ float fexp(float x) { return __builtin_amdgcn_exp2f(x * 1.4426950408889634f); }
__device__ __forceinline__ float flog(float x) { return __builtin_amdgcn_logf(x) * 0.6931471805599453f; }
__device__ __forceinline__ float sigm(float x) { return __builtin_amdgcn_rcpf(1.0f + fexp(-x)); }
__device__ __forceinline__ float softplus(float z) { return fmaxf(z, 0.f) + flog(1.0f + fexp(-fabsf(z))); }
__device__ __forceinline__ float rstd_of(const float* ss, int row) {
    const f32x4* p = (const f32x4*)(ss + (size_t)row * 32);
    float s = 0.f;
#pragma unroll
    for (int i = 0; i < 8; ++i) { const f32x4 a = p[i]; s += (a[0] + a[1]) + (a[2] + a[3]); }
    return __builtin_amdgcn_rsqf(s * (1.0f / 1024.0f) + EPS);
}

namespace pg8 {
constexpr int BM = 256, BK = 64, HALF = 128, HTB = HALF * BK * 2, STAGE_BYTES = 8 * HTB, NXCD = 8, WGM = 8;
__host__ __device__ __forceinline__ int lds_byte(int r, int c) { const int st = (r >> 4) * 2 + (c >> 5), rr = r & 15, cc = c & 31, ob = rr * 64 + cc * 2; return st * 1024 + (ob ^ (((ob >> 9) & 1) << 5)); }
__host__ __device__ __forceinline__ void stage_rc(int b, int& R, int& C) { const int st = b / 1024, sb = b % 1024, swz = sb ^ (((sb >> 9) & 1) << 5); R = (st >> 1) * 16 + swz / 64; C = (st & 1) * 32 + (swz % 64) / 2; }
__host__ __device__ __forceinline__ int perm32(int rho) { const int n = rho >> 4, i = rho & 15; return 8 * (i >> 2) + 4 * n + (i & 3); }

struct Unit { int pm, pn, kind, k0, nt, qm; };
struct Gemm { const bf16_t* A; const bf16_t* Bt; int lda, ldb; };

struct Sched {
    int nM, nN, nwg, G, c, nsub, nt0, quart;
    __device__ __forceinline__ void init(int M_, int N_, int G_, int c_, int nt) { nM = M_ / BM; nN = N_ / BM; nwg = nM * nN; G = G_; c = c_; nsub = 1; nt0 = nt; quart = 0; }
    __device__ __forceinline__ bool next(int i, Unit& u) const {
        const int ti = i / nsub, sk = i - ti * nsub;
        long L = (long)ti * G + c; int qm = 0xF;
        const int nfull = nwg / G;
        if (quart && ti >= nfull) {
            const long li = (long)(ti - nfull) * G + c; if (li >= 4L * (nwg - nfull * G)) return false;
            L = (long)nfull * G + (li >> 2); qm = 1 << (int)(li & 3);
        } else if (L >= nwg) return false;
        u.qm = qm;
        int wgid = (int)L; { const int q = nwg / NXCD, r = nwg % NXCD, xcd = wgid % NXCD, off = wgid / NXCD; wgid = (xcd < r ? xcd * (q + 1) : r * (q + 1) + (xcd - r) * q) + off; }
        const int nig = WGM * nN, gid = wgid / nig, fm = gid * WGM, gsz = (nM - fm) < WGM ? (nM - fm) : WGM;
        u.pm = fm + ((wgid % nig) % gsz); u.pn = (wgid % nig) / gsz; u.kind = sk; u.k0 = (sk > 0) ? 256 + 256 * sk : 0; u.nt = (sk > 0) ? 4 : nt0; return true;
    }
};

#define PG8_KLOOP(C0, C1, C2, C3) \
        for (int t = 0; t < nt; t += 2) { \
            const bool last = (t == nt - 2); \
            const char* a1 = cA + (size_t)(t + 1) * kstep; \
            const char* a2 = last ? nA : cA + (size_t)(t + 2) * kstep; const char* b2 = last ? nB : cB + (size_t)(t + 2) * kstep; \
            const char* a3 = a2 + kstep; const char* b3 = b2 + kstep; \
            PG8_LDB(B0, 0, 0); PG8_LDB(B1, 0, 1); PG8_SCHED; PG8_LDA(At, 0, 0); PG8_STAGE(PG8_SA(1, 1), a1 + hstepA, voffA); \
            PG8_WAIT_V(8); PG8_WAIT_L(0); PG8_BAR; if (C0) PG8_MMA(0, 0, At, B0); if (C1) PG8_MMA(0, 1, At, B1); PG8_BAR; PG8_SCHED; \
            PG8_LDA(At, 0, 1); PG8_STAGE(PG8_SB(0, 0), b2, voffB); PG8_STAGE(PG8_SB(0, 1), b2 + hstepB, voffB); PG8_STAGE(PG8_SA(0, 0), a2, voffA); \
            PG8_WAIT_V(8); PG8_WAIT_L(0); PG8_BAR; if (C2) PG8_MMA(1, 0, At, B0); if (C3) PG8_MMA(1, 1, At, B1); PG8_BAR; PG8_SCHED; \
            PG8_LDB(B0, 1, 0); PG8_LDB(B1, 1, 1); PG8_SCHED; PG8_LDA(At, 1, 0); PG8_STAGE(PG8_SA(0, 1), a2 + hstepA, voffA); \
            PG8_WAIT_V(8); PG8_WAIT_L(0); PG8_BAR; if (C0) PG8_MMA(0, 0, At, B0); if (C1) PG8_MMA(0, 1, At, B1); PG8_BAR; PG8_SCHED; \
            PG8_LDA(At, 1, 1); PG8_STAGE(PG8_SB(1, 0), b3, voffB); PG8_STAGE(PG8_SB(1, 1), b3 + hstepB, voffB); PG8_STAGE(PG8_SA(1, 0), a3, voffA); \
            PG8_WAIT_V(8); PG8_WAIT_L(0); PG8_BAR; if (C2) PG8_MMA(1, 0, At, B0); if (C3) PG8_MMA(1, 1, At, B1); PG8_BAR; PG8_SCHED; \
        }
template <class Epi, class Sch>
__device__ __forceinline__ void gemm_phase(LAS unsigned char* lds, const int tid, const Gemm g, const Sch& S, const Epi& E, const float* ss) {
    const int wid = __builtin_amdgcn_readfirstlane(tid >> 6), lane = tid & 63, wr = wid >> 2, wc = wid & 3, fr = lane & 15, fq = lane >> 4;
    unsigned voffA[2], voffB[2];
#pragma unroll
    for (int i = 0; i < 2; ++i) { int R, C; stage_rc(tid * 16 + i * 8192, R, C); const int Rb = (R & ~31) + perm32(R & 31);
        voffA[i] = (unsigned)(R * g.lda + C) * 2u; voffB[i] = (unsigned)(Rb * g.ldb + C) * 2u; }
    const size_t kstep = (size_t)(BK * 2);
    const size_t hstepA = (size_t)HALF * g.lda * 2, hstepB = (size_t)HALF * g.ldb * 2;
    const size_t tstepA = 2 * hstepA, tstepB = 2 * hstepB;
    const unsigned ldsw = (unsigned)wid * 1024u;
    const int aoff = lds_byte(wr * 64 + fr, fq * 8), boff = lds_byte(wc * 32 + fr, fq * 8);
    LAS float* rtab = (LAS float*)(lds + STAGE_BYTES);
    f32x4 rt_a = {0.f, 0.f, 0.f, 0.f}, rt_b = rt_a, rt_c = rt_a, rt_d = rt_a;
#define PG8_RTAB_LOAD(pm_) do { if (ss) { const f32x4* p_ = (const f32x4*)(ss + ((size_t)(pm_) * 256 + (tid >> 1)) * 32 + (tid & 1) * 16); rt_a = p_[0]; rt_b = p_[1]; rt_c = p_[2]; rt_d = p_[3]; } } while (0)
#define PG8_RTAB_FIN(buf_) do { if (ss) { float s_ = (((rt_a[0] + rt_a[1]) + (rt_a[2] + rt_a[3])) + ((rt_b[0] + rt_b[1]) + (rt_b[2] + rt_b[3]))) + (((rt_c[0] + rt_c[1]) + (rt_c[2] + rt_c[3])) + ((rt_d[0] + rt_d[1]) + (rt_d[2] + rt_d[3]))); \
        s_ += __shfl_xor(s_, 1); if (!(tid & 1)) rtab[(buf_) * 256 + (tid >> 1)] = __builtin_amdgcn_rsqf(s_ * (1.0f / 1024.0f) + EPS); } } while (0)
#define PG8_SA(b, h) (((b) * 2 + (h)) * HTB)
#define PG8_SB(b, h) ((4 + (b) * 2 + (h)) * HTB)
#define PG8_STAGE(bufoff, gbase, voff) do { _Pragma("unroll") for (int _i = 0; _i < 2; ++_i) \
        __builtin_amdgcn_global_load_lds((const unsigned*)((const char*)(gbase) + (voff)[_i]), (LAS unsigned*)(lds + (bufoff) + ldsw + _i * 8192), 16, 0, 0); } while (0)
#define PG8_LDA(dst, b, h) do { _Pragma("unroll") for (int m = 0; m < 4; ++m) _Pragma("unroll") for (int k = 0; k < 2; ++k) dst[m][k] = *(const LAS bf16x8*)(lds + PG8_SA(b, h) + aoff + m * 2048 + k * 1024); } while (0)
#define PG8_LDB(dst, b, h) do { _Pragma("unroll") for (int n = 0; n < 2; ++n) _Pragma("unroll") for (int k = 0; k < 2; ++k) dst[n][k] = *(const LAS bf16x8*)(lds + PG8_SB(b, h) + boff + n * 2048 + k * 1024); } while (0)
#define PG8_MMA(ai, bj, At, Bt) do { __builtin_amdgcn_s_setprio(1); _Pragma("unroll") for (int m = 0; m < 4; ++m) _Pragma("unroll") for (int n = 0; n < 2; ++n) _Pragma("unroll") for (int k = 0; k < 2; ++k) \
        acc[ai][bj][m][n] = __builtin_amdgcn_mfma_f32_16x16x32_bf16(Bt[n][k], At[m][k], acc[ai][bj][m][n], 0, 0, 0); __builtin_amdgcn_s_setprio(0); } while (0)
#define PG8_WAIT_V(n) asm volatile("s_waitcnt vmcnt(" #n ")" ::: "memory")
#define PG8_WAIT_L(n) asm volatile("s_waitcnt lgkmcnt(" #n ")" ::: "memory")
#define PG8_BAR __builtin_amdgcn_s_barrier()
#define PG8_SCHED __builtin_amdgcn_sched_barrier(0)
    Unit cur, nxt; int ui = 0;
    if (!S.next(0, cur)) return;
    f32x4 acc[2][2][4][2];
#pragma unroll
    for (int a = 0; a < 2; ++a)
#pragma unroll
        for (int b = 0; b < 2; ++b)
#pragma unroll
            for (int m = 0; m < 4; ++m)
#pragma unroll
                for (int n = 0; n < 2; ++n) acc[a][b][m][n] = (f32x4){0.f, 0.f, 0.f, 0.f};
    bf16x8 At[4][2], B0[2][2], B1[2][2];
    const char* cA = (const char*)g.A + (size_t)cur.pm * tstepA + (size_t)cur.k0 * 2; const char* cB = (const char*)g.Bt + (size_t)cur.pn * tstepB + (size_t)cur.k0 * 2;
    PG8_RTAB_LOAD(cur.pm); PG8_RTAB_FIN(0);
    PG8_STAGE(PG8_SB(0, 0), cB, voffB); PG8_STAGE(PG8_SB(0, 1), cB + hstepB, voffB); PG8_STAGE(PG8_SA(0, 0), cA, voffA); PG8_STAGE(PG8_SA(0, 1), cA + hstepA, voffA);
    if (wr == 1) PG8_BAR;
    PG8_WAIT_V(2); PG8_BAR;
    PG8_STAGE(PG8_SB(1, 0), cB + kstep, voffB); PG8_STAGE(PG8_SA(1, 0), cA + kstep, voffA); PG8_STAGE(PG8_SB(1, 1), cB + hstepB + kstep, voffB);
    PG8_WAIT_V(6); PG8_BAR;
    for (;;) {
        const bool has_next = S.next(ui + 1, nxt);
        const char* nA = has_next ? (const char*)g.A + (size_t)nxt.pm * tstepA + (size_t)nxt.k0 * 2 : cA; const char* nB = has_next ? (const char*)g.Bt + (size_t)nxt.pn * tstepB + (size_t)nxt.k0 * 2 : cB;
        const int nt = cur.nt, qm = cur.qm;
        if (qm == 0xF) { PG8_KLOOP(true, true, true, true) } else { PG8_KLOOP((qm & 1), (qm & 2), (qm & 4), (qm & 8)) }
        if (wr == 0) PG8_BAR;
        if (has_next) PG8_RTAB_LOAD(nxt.pm);
        E(acc, cur, wr, wc, fr, fq, rtab + (ui & 1) * 256);
        if (!has_next) break;
#pragma unroll
        for (int a = 0; a < 2; ++a)
#pragma unroll
            for (int b = 0; b < 2; ++b)
#pragma unroll
                for (int m = 0; m < 4; ++m)
#pragma unroll
                    for (int n = 0; n < 2; ++n) acc[a][b][m][n] = (f32x4){0.f, 0.f, 0.f, 0.f};
        cur = nxt; cA = nA; cB = nB; ++ui;
        PG8_RTAB_FIN(ui & 1);
        if (wr == 1) PG8_BAR;
    }
    PG8_WAIT_V(0);
    PG8_BAR;
#undef PG8_SA
#undef PG8_RTAB_LOAD
#undef PG8_RTAB_FIN
#undef PG8_SB
#undef PG8_STAGE
#undef PG8_LDA
#undef PG8_LDB
#undef PG8_MMA
#undef PG8_WAIT_V
#undef PG8_WAIT_L
#undef PG8_BAR
#undef PG8_SCHED
}
}
using pg8::Unit;

#define EPI_FENCE() asm volatile("" ::: "memory")
struct EpiSwiglu {
    bf16_t* hid;
    __device__ __forceinline__ void operator()(const f32x4 (&acc)[2][2][4][2], const Unit& u, int wr, int wc, int fr, int fq, const LAS float* rt) const {
        const int row0 = u.pm * 256 + wr * 64 + fr, col = u.pn * 128 + wc * 32 + 8 * fq;
#pragma unroll
        for (int ai = 0; ai < 2; ++ai)
#pragma unroll
            for (int m = 0; m < 4; ++m) {
                const int rl = ai * 128 + m * 16; const int row = row0 + rl; const float rs = rt[wr * 64 + fr + rl];
                float h[8];
#pragma unroll
                for (int n = 0; n < 2; ++n)
#pragma unroll
                    for (int i = 0; i < 4; ++i) { const float a = acc[ai][0][m][n][i] * rs, b = acc[ai][1][m][n][i] * rs; h[4 * n + i] = a * sigm(a) * b; }
                u32x4 w; w.x = pk2(h[0], h[1]); w.y = pk2(h[2], h[3]); w.z = pk2(h[4], h[5]); w.w = pk2(h[6], h[7]);
                *(u32x4*)(hid + (size_t)row * FF + col) = w;
            }
    }
};
struct EpiWin {
    bf16_t* proj; float* out; int layer;
    __device__ __forceinline__ void operator()(const f32x4 (&acc)[2][2][4][2], const Unit& u, int wr, int wc, int fr, int fq, const LAS float* rt) const {
        const int row0 = u.pm * 256 + wr * 64 + fr, pn = u.pn;
        const bool isgate = (pn >= 10 && pn < 22), iskv = (pn >= 2 && pn < 6), ispool = (pn == 9);
#pragma unroll
        for (int ai = 0; ai < 2; ++ai)
#pragma unroll
            for (int m = 0; m < 4; ++m) {
                const int rl = ai * 128 + m * 16; const int row = row0 + rl; const float rs = rt[wr * 64 + fr + rl];
#pragma unroll
                for (int bj = 0; bj < 2; ++bj) {
                    if (!((u.qm >> (ai * 2 + bj)) & 1)) continue;
                    const int ct = bj * 128 + wc * 32 + 8 * fq;
                    f32x4 v0 = acc[ai][bj][m][0] * rs, v1 = acc[ai][bj][m][1] * rs;
                    if (isgate) {
#pragma unroll
                        for (int i = 0; i < 4; ++i) { v0[i] = sigm(v0[i]); v1[i] = sigm(v1[i]); }
                    }
                    u32x4 w; w.x = pk2(v0[0], v0[1]); w.y = pk2(v0[2], v0[3]); w.z = pk2(v1[0], v1[1]); w.w = pk2(v1[2], v1[3]);
                    *(u32x4*)(proj + (size_t)row * PW + pn * 256 + ct) = w;
                    if (iskv) {
                        const int c512 = (pn & 1) * 256 + ct; const bool isv = pn >= 4;
                        float* dst = row < MP ? out + (isv ? O_VP : O_KP) + ((size_t)layer * MP + row) * 512 + c512
                                              : out + (isv ? O_VS : O_KS) + ((size_t)layer * 2048 + (row - MP)) * 512 + c512;
                        *(f32x4*)dst = v0; *(f32x4*)(dst + 4) = v1;
                    }
                    if (ispool) {
                        if (row < MP) { const int t = row & 8191, b = row >> 13; if (t >= 8177) { float* dst = out + O_PP + ((size_t)(layer * 4 + b) * 15 + (t - 8177)) * 256 + ct; *(f32x4*)dst = v0; *(f32x4*)(dst + 4) = v1; } }
                        else { const int r = row - MP, t = r & 63, sb = r >> 6; if (t >= 49) { float* dst = out + O_PS + ((size_t)(layer * 32 + sb) * 15 + (t - 49)) * 256 + ct; *(f32x4*)dst = v0; *(f32x4*)(dst + 4) = v1; } }
                    }
                }
            }
    }
};
struct EpiRes {
    float* x; bf16_t* xb; float* ss_out; const bf16_t* scr; float alpha; int mode; const float* xin0; const float* xin1;
    __device__ __forceinline__ void operator()(const f32x4 (&acc)[2][2][4][2], const Unit& u, int wr, int wc, int fr, int fq, const LAS float* rt) const {
        const int row0 = u.pm * 256 + wr * 64 + fr, colb = u.pn * 256 + wc * 32 + 8 * fq;
#pragma unroll
        for (int ai = 0; ai < 2; ++ai) {
            if (!((u.qm >> (2 * ai)) & 3)) continue;
#pragma unroll
            for (int mp = 0; mp < 2; ++mp) {
                f32x4 xv[2][2][2]; u32x4 sv[2][2];
                const float* xr = xin0 ? (u.pm < MP / 256 ? xin0 : xin1 - (size_t)MP * D) : x;
#pragma unroll
                for (int mi = 0; mi < 2; ++mi)
#pragma unroll
                    for (int bj = 0; bj < 2; ++bj) {
                        const size_t off = (size_t)(row0 + ai * 128 + (2 * mp + mi) * 16) * D + colb + bj * 128;
                        xv[mi][bj][0] = *(const f32x4*)(xr + off); xv[mi][bj][1] = *(const f32x4*)(xr + off + 4);
                    }
#pragma unroll
                for (int mi = 0; mi < 2; ++mi) {
                    const int m = 2 * mp + mi, rl = ai * 128 + m * 16, row = row0 + rl;
                    const float rs = (mode == 1) ? rt[wr * 64 + fr + rl] : 1.f;
                    if (mode == 1) {
#pragma unroll
                        for (int bj = 0; bj < 2; ++bj) { const size_t off = (size_t)row * D + colb + bj * 128; sv[mi][bj] = *(const u32x4*)(scr + off); }
                    }
#pragma unroll
                    for (int bj = 0; bj < 2; ++bj) {
                        if (!((u.qm >> (ai * 2 + bj)) & 1)) continue;
                        const size_t off = (size_t)row * D + colb + bj * 128;
                        f32x4 v0 = acc[ai][bj][m][0], v1 = acc[ai][bj][m][1];
                        if (mode == 1) {
#pragma unroll
                            for (int i = 0; i < 4; ++i) { v0[i] = sigm(v0[i] * rs); v1[i] = sigm(v1[i] * rs); }
                            { const u32x4 p4 = sv[mi][bj]; v0[0] *= bflo(p4.x); v0[1] *= bfhi(p4.x); v0[2] *= bflo(p4.y); v0[3] *= bfhi(p4.y); v1[0] *= bflo(p4.z); v1[1] *= bfhi(p4.z); v1[2] *= bflo(p4.w); v1[3] *= bfhi(p4.w); }
                        } else { v0 = v0 * alpha; v1 = v1 * alpha; }
                        const f32x4 x0 = xv[mi][bj][0] + v0, x1 = xv[mi][bj][1] + v1;
                        *(f32x4*)(x + off) = x0; *(f32x4*)(x + off + 4) = x1;
                        u32x4 w; w.x = pk2(x0[0], x0[1]); w.y = pk2(x0[2], x0[3]); w.z = pk2(x1[0], x1[1]); w.w = pk2(x1[2], x1[3]);
                        *(u32x4*)(xb + off) = w;
                        float ssum = (x0[0] * x0[0] + x0[1] * x0[1]) + (x0[2] * x0[2] + x0[3] * x0[3]) + (x1[0] * x1[0] + x1[1] * x1[1]) + (x1[2] * x1[2] + x1[3] * x1[3]);
                        ssum += __shfl_xor(ssum, 16); ssum += __shfl_xor(ssum, 32);
                        if (fq == 0) ss_out[(size_t)row * 32 + u.pn * 8 + bj * 4 + wc] = ssum;
                    }
                }
                EPI_FENCE();
            }
        }
    }
};
struct EpiBranch {
    const bf16_t* proj; bf16_t* scr; bf16_t* merged; int mode;
    template <int BR>
    __device__ __forceinline__ void run(const f32x4 (&acc)[2][2][4][2], const Unit& u, int wr, int wc, int fr, int fq) const {
        const int row0 = u.pm * 256 + wr * 64 + fr, colb = u.pn * 256 + wc * 32 + 8 * fq;
#pragma unroll
        for (int ai = 0; ai < 2; ++ai) {
            if (!((u.qm >> (2 * ai)) & 3)) continue;
#pragma unroll
            for (int mp = 0; mp < 2; ++mp) {
                u32x4 gt[2][2], sv[2][2];
#pragma unroll
                for (int mi = 0; mi < 2; ++mi)
#pragma unroll
                    for (int bj = 0; bj < 2; ++bj) {
                        const int row = row0 + ai * 128 + (2 * mp + mi) * 16, col = colb + bj * 128; const size_t off = (size_t)row * D + col;
                        if (BR < 3) gt[mi][bj] = *(const u32x4*)(proj + (size_t)row * PW + C_G + BR * 1024 + col);
                        if (BR == 1 || BR == 2) sv[mi][bj] = *(const u32x4*)(scr + off);
                    }
#pragma unroll
                for (int mi = 0; mi < 2; ++mi)
#pragma unroll
                    for (int bj = 0; bj < 2; ++bj) {
                        if (!((u.qm >> (ai * 2 + bj)) & 1)) continue;
                        const int m = 2 * mp + mi, row = row0 + ai * 128 + m * 16, col = colb + bj * 128; const size_t off = (size_t)row * D + col;
                        f32x4 v0 = acc[ai][bj][m][0], v1 = acc[ai][bj][m][1];
                        if (BR < 3) { const u32x4 g4 = gt[mi][bj];
                            v0[0] *= bflo(g4.x); v0[1] *= bfhi(g4.x); v0[2] *= bflo(g4.y); v0[3] *= bfhi(g4.y);
                            v1[0] *= bflo(g4.z); v1[1] *= bfhi(g4.z); v1[2] *= bflo(g4.w); v1[3] *= bfhi(g4.w); }
                        if (BR == 1 || BR == 2) { const u32x4 p4 = sv[mi][bj]; v0[0] += bflo(p4.x); v0[1] += bfhi(p4.x); v0[2] += bflo(p4.y); v0[3] += bfhi(p4.y); v1[0] += bflo(p4.z); v1[1] += bfhi(p4.z); v1[2] += bflo(p4.w); v1[3] += bfhi(p4.w); }
                        { u32x4 w; w.x = pk2(v0[0], v0[1]); w.y = pk2(v0[2], v0[3]); w.z = pk2(v1[0], v1[1]); w.w = pk2(v1[2], v1[3]); *(u32x4*)((BR == 2 ? merged : scr) + off) = w; }
                    }
                EPI_FENCE();
            }
        }
    }
    __device__ __forceinline__ void operator()(const f32x4 (&acc)[2][2][4][2], const Unit& u, int wr, int wc, int fr, int fq, const LAS float* rt) const {
        if (mode == 1) run<3>(acc, u, wr, wc, fr, fq);
        else if (u.kind == 0) run<0>(acc, u, wr, wc, fr, fq);
        else if (u.kind == 1) run<1>(acc, u, wr, wc, fr, fq);
        else run<2>(acc, u, wr, wc, fr, fq);
    }
};

struct Args { const float* in[29]; float* out; unsigned char* ws; int ph_lo, ph_hi; };
constexpr int NPH = 26;
constexpr int LDS_BYTES = 147456;

struct Ctx {
    const float* const* in; float* out; unsigned char* ws; LAS unsigned char* lds; unsigned char* ldsg; int tid, lane, wave, G, bx;
};

enum { MAP_ID = 0, MAP_SWIGLU = 1, MAP_WIN = 2 };
__device__ __forceinline__ int map_col(int mode, int n) {
    if (mode == MAP_ID) return n;
    if (mode == MAP_SWIGLU) { const int p = n >> 8, j = n & 255; return j < 128 ? p * 128 + j : FF + p * 128 + (j - 128); }
    if (n < 2048) return n;
    if (n < 2304) return 2064 + (n - 2048);
    if (n < 2560) return 2320 + (n - 2304);
    if (n < 5632) return 2576 + (n - 2560);
    if (n < 5648) return 2048 + (n - 5632);
    return -1;
}
__device__ __forceinline__ void tconv(const Ctx& c, const float* src, int ldsrc, int K, bf16_t* dst, int lddst, int Nout, int mode, const float* g, int& toff) {
    float* tile = (float*)c.ldsg;
    const int ntn = Nout / 64, ntk = K / 256, nt = ntn * ntk;
    const int first = (c.bx + c.G - (toff % c.G)) % c.G; toff += nt;
    for (int it = first; it < nt; it += c.G) {
        const int tn = it % ntn, tk = it / ntn, n0 = tn * 64, k0 = tk * 256;
        const int nn = c.tid & 63, sc = map_col(mode, n0 + nn), kq = c.tid >> 6;
        float v[32];
#pragma unroll
        for (int i = 0; i < 32; ++i) { const int kk = kq + 8 * i; v[i] = (sc >= 0) ? src[(size_t)(k0 + kk) * ldsrc + sc] : 0.f; }
        if (g) {
#pragma unroll
            for (int i = 0; i < 32; ++i) v[i] *= g[k0 + kq + 8 * i];
        }
#pragma unroll
        for (int i = 0; i < 32; ++i) tile[(kq + 8 * i) * 65 + nn] = v[i];
        __syncthreads();
        { const int n2 = c.tid >> 3, kg = c.tid & 7;
#pragma unroll
          for (int j = 0; j < 4; ++j) { const float* s = tile + (kg * 8 + 64 * j) * 65 + n2;
              u32x4 o; o.x = pk2(s[0], s[65]); o.y = pk2(s[130], s[195]); o.z = pk2(s[260], s[325]); o.w = pk2(s[390], s[455]);
              *(u32x4*)(dst + (size_t)(n0 + n2) * lddst + k0 + kg * 8 + 64 * j) = o; } }
        __syncthreads();
    }
}
__device__ __forceinline__ float wave_sum(float v) {
#pragma unroll
    for (int o = 1; o < 64; o <<= 1) v += __shfl_xor(v, o);
    return v;
}
__device__ __forceinline__ void prologue(const Ctx& c) {
    bf16_t* W = (bf16_t*)(c.ws + WS_W);
    int toff = 0;
    for (int l = 0; l < 2; ++l) {
        bf16_t* Wl = W + (size_t)l * WL_END;
        tconv(c, c.in[9] + (size_t)l * D * 2 * FF, 2 * FF, D, Wl + WL_1IN, D, 2 * FF, MAP_SWIGLU, c.in[8] + l * D, toff);
        tconv(c, c.in[10] + (size_t)l * FF * D, D, FF, Wl + WL_1OUT, FF, D, MAP_ID, nullptr, toff);
        tconv(c, c.in[12] + (size_t)l * D * INW, INW, D, Wl + WL_IN, D, NIN, MAP_WIN, c.in[11] + l * D, toff);
        tconv(c, c.in[18] + (size_t)l * 512 * D, D, 512, Wl + WL_BR, D, D, MAP_ID, nullptr, toff);
        tconv(c, c.in[19] + (size_t)l * 256 * D, D, 256, Wl + WL_BR + 512, D, D, MAP_ID, nullptr, toff);
        tconv(c, c.in[21] + (size_t)l * D * D, D, D, Wl + WL_OUT, D, D, MAP_ID, nullptr, toff);
        tconv(c, c.in[23] + (size_t)l * D * 2 * FF, 2 * FF, D, Wl + WL_2IN, D, 2 * FF, MAP_SWIGLU, c.in[22] + l * D, toff);
        tconv(c, c.in[24] + (size_t)l * FF * D, D, FF, Wl + WL_2OUT, FF, D, MAP_ID, nullptr, toff);
        tconv(c, c.in[26] + (size_t)l * D * D, D, D, Wl + WL_PG, D, D, MAP_ID, c.in[25] + l * D, toff);
        tconv(c, c.in[27] + (size_t)l * 256 * D, D, 256, Wl + WL_PP, 256, D, MAP_ID, nullptr, toff);
        const float* pw = c.in[16] + (size_t)l * 4 * 64 * 64; const float* psc = c.in[17] + l * 256; const float* wc = c.in[20] + (size_t)l * 256 * D;
        for (int idx = c.bx * 512 + c.tid; idx < 256 * 1024; idx += c.G * 512) {
            const int n = idx & 1023, kc = idx >> 10, gq = kc >> 6, cc = kc & 63; float s = 0.f;
            for (int dd = 0; dd < 64; ++dd) s += pw[(gq * 64 + cc) * 64 + dd] * psc[gq * 64 + dd] * wc[(size_t)(gq * 64 + dd) * D + n];
            Wl[WL_BR + (size_t)n * D + 768 + kc] = (bf16_t)f2bf(s);
        }
    }
    bf16_t* xb = (bf16_t*)(c.ws + WS_XB); float* ss0 = (float*)(c.ws + WS_SS);
    for (int row = c.bx * 8 + c.wave; row < M; row += c.G * 8) {
        const float* src = row < MP ? c.in[0] + (size_t)row * D : c.in[1] + (size_t)(row - MP) * D;
        f32x4 v[4]; float s = 0.f;
#pragma unroll
        for (int j = 0; j < 4; ++j) { v[j] = *(const f32x4*)(src + c.lane * 4 + 256 * j); s += (v[j][0] * v[j][0] + v[j][1] * v[j][1]) + (v[j][2] * v[j][2] + v[j][3] * v[j][3]); }
        s = wave_sum(s);
#pragma unroll
        for (int j = 0; j < 4; ++j) { u32x2 w; w.x = pk2(v[j][0], v[j][1]); w.y = pk2(v[j][2], v[j][3]); *(u32x2*)(xb + (size_t)row * D + c.lane * 4 + 256 * j) = w; }
        if (c.lane < 32) ss0[(size_t)row * 32 + c.lane] = c.lane == 0 ? s : 0.f;
    }
    bf16_t* pb = (bf16_t*)(c.ws + WS_PB);
#pragma unroll 4
    for (size_t i4 = (size_t)c.bx * 512 + c.tid; i4 < (size_t)2 * M * 64; i4 += (size_t)c.G * 512) {
        const size_t e = i4 * 4; const int l = (int)(e / ((size_t)M * 256)); const size_t r = e - (size_t)l * M * 256; const int row = (int)(r >> 8), cc = (int)(r & 255);
        const float* src = row < MP ? c.in[6] + ((size_t)l * MP + row) * 256 + cc : c.in[7] + ((size_t)l * 2048 + (row - MP)) * 256 + cc;
        const f32x4 v = *(const f32x4*)src; u32x2 w; w.x = pk2(v[0], v[1]); w.y = pk2(v[2], v[3]); *(u32x2*)(pb + e) = w;
    }
}

__device__ __forceinline__ int next_item(const Ctx& c, int slot) {
    volatile int* sh = (volatile int*)(c.ldsg + 147392);
    __syncthreads();
    if (c.tid == 0) *sh = (int)__hip_atomic_fetch_add((unsigned*)(c.ws + WS_CTL) + 64 * (1 + slot), 1u, __ATOMIC_RELAXED, __HIP_MEMORY_SCOPE_AGENT);
    __syncthreads();
    return *sh;
}
__device__ __forceinline__ void gla_local_unit(const Ctx& c, int l, int g, int h) {
    float* L = (float*)c.ldsg; float* rs = L; float* wg = L + 1024; float* bg = L + 1536; float* la = L + 1600; float* kt = L + 3712; float* vs = L + 5824;
    const bf16_t* proj = (const bf16_t*)(c.ws + WS_BIG); const int m0 = g * 64, tid = c.tid;
    { const int e = tid * 2, row = e >> 4, cc = e & 15; const unsigned w = *(const unsigned*)(proj + (size_t)(m0 + row) * PW + C_RB + cc); rs[e] = bflo(w); rs[e + 1] = bfhi(w); }
    { const int j = tid >> 5, d = tid & 31; wg[tid] = c.in[13][(size_t)(l * 16 + j) * 128 + h * 32 + d]; }
    if (tid < 32) bg[tid] = c.in[14][l * 128 + h * 32 + tid];
    __syncthreads();
#pragma unroll
    for (int i = 0; i < 4; ++i) { const int o = tid + 512 * i, t = o >> 5, d = o & 31; float a = bg[d];
#pragma unroll
        for (int j = 0; j < 16; ++j) a += rs[t * 16 + j] * wg[j * 32 + d];
        la[t * 33 + d] = (fminf(a, 0.f) - flog(1.0f + fexp(-fabsf(a)))) * (1.0f / 16.0f); }
    __syncthreads();
    {
#pragma unroll
        for (int j = 0; j < 4; ++j) { const int d = c.wave * 4 + j; float v = la[c.lane * 33 + d];
#pragma unroll
            for (int o = 1; o < 64; o <<= 1) { const float n = __shfl_up(v, o); if (c.lane >= o) v += n; }
            la[c.lane * 33 + d] = v; }
    }
    __syncthreads();
    float* bws = (float*)(c.ws + WS_B);
#pragma unroll
    for (int i = 0; i < 4; ++i) { const int o = tid + 512 * i, t = o >> 5, d = o & 31; const float b = la[t * 33 + d];
        bws[(size_t)(m0 + t) * 128 + h * 32 + d] = b;
        kt[t * 33 + d] = bf2f(proj[(size_t)(m0 + t) * PW + C_KB + h * 32 + d]) * fexp(-b); }
    { const int t = tid >> 3, e0 = (tid & 7) * 8; const u32x4 w = *(const u32x4*)(proj + (size_t)(m0 + t) * PW + C_VB + h * 64 + e0); float* d = vs + t * 64 + e0;
      d[0] = bflo(w.x); d[1] = bfhi(w.x); d[2] = bflo(w.y); d[3] = bfhi(w.y); d[4] = bflo(w.z); d[5] = bfhi(w.z); d[6] = bflo(w.w); d[7] = bfhi(w.w); }
    __syncthreads();
    { const int d = tid >> 4, e0 = (tid & 15) * 4; f32x4 a = {0.f, 0.f, 0.f, 0.f};
      for (int t = 0; t < 64; ++t) { const float kk = kt[t * 33 + d]; const f32x4 v = *(const f32x4*)(vs + t * 64 + e0); a = a + v * kk; }
      *(f32x4*)((float*)(c.ws + WS_DS) + ((size_t)(g * 4 + h) * 32 + d) * 64 + e0) = a; }
    if (tid < 32) ((float*)(c.ws + WS_DEC))[(size_t)(g * 4 + h) * 32 + tid] = fexp(la[63 * 33 + tid]);
    __syncthreads();
}
__device__ __forceinline__ void pool_unit(const Ctx& c, int l, int g) {
    float* ext = (float*)c.ldsg;
    const bf16_t* proj = (const bf16_t*)(c.ws + WS_BIG); bf16_t* Y = (bf16_t*)(c.ws + WS_Y);
    const int m0 = g * 64, tid = c.tid; const bool samp = g >= 512; const int cidx = samp ? 0 : (g & 127);
#pragma unroll
    for (int it = 0; it < 5; ++it) { const int q = tid + 512 * it;
        if (q < 79 * 32) { const int j = q >> 5, c8 = (q & 31) * 8; float* d = ext + j * 256 + c8;
            if (j >= 15 || cidx > 0) { const u32x4 w = *(const u32x4*)(proj + (size_t)(m0 + j - 15) * PW + C_UC + c8);
                *(f32x4*)d = (f32x4){bflo(w.x), bfhi(w.x), bflo(w.y), bfhi(w.y)}; *(f32x4*)(d + 4) = (f32x4){bflo(w.z), bfhi(w.z), bflo(w.w), bfhi(w.w)}; }
            else if (samp) { const float* sp = c.in[5] + ((size_t)(l * 32 + (g - 512)) * 15 + j) * 256 + c8; *(f32x4*)d = *(const f32x4*)sp; *(f32x4*)(d + 4) = *(const f32x4*)(sp + 4); }
            else { *(f32x4*)d = (f32x4){0.f, 0.f, 0.f, 0.f}; *(f32x4*)(d + 4) = (f32x4){0.f, 0.f, 0.f, 0.f}; } } }
    __syncthreads();
    { const int cc = tid & 255, ts = tid >> 8, gi = cc >> 6, w = 2 << gi;
      for (int i = 0; i < 32; ++i) { const int t = ts * 32 + i; float s = 0.f;
          for (int j = 0; j < w; ++j) s += ext[(15 + t - j) * 256 + cc];
          const int pos = samp ? 2048 + t : cidx * 64 + t; const float cnt = (float)min(w, pos + 1);
          const float dv = s / cnt - ext[(15 + t) * 256 + cc];
          Y[(size_t)(m0 + t) * D + 768 + cc] = (bf16_t)f2bf(dv); } }
    __syncthreads();
}

__device__ __forceinline__ void scan_unit(const Ctx& c, int l, int su) {
    const float* dS = (const float*)(c.ws + WS_DS); const float* dec = (const float*)(c.ws + WS_DEC); float* St = (float*)(c.ws + WS_ST);
    int g0, n, h, idx; float S; float* outp;
    if (su < 64) { const int bh = su >> 2, b = bh >> 2; h = bh & 3; idx = (su & 3) * 512 + c.tid; g0 = b * 128; n = 128; S = 0.f; outp = c.out + O_GP + ((size_t)(l * 4 + b) * 4 + h) * 2048 + idx; }
    else { const int s2 = su - 64, sbh = s2 >> 2, sb = sbh >> 2; h = sbh & 3; idx = (s2 & 3) * 512 + c.tid; g0 = 512 + sb; n = 1; S = c.in[4][((size_t)(l * 32 + sb) * 4 + h) * 2048 + idx]; outp = c.out + O_GS + ((size_t)(l * 32 + sb) * 4 + h) * 2048 + idx; }
    const int d = idx >> 6;
#pragma unroll 8
    for (int cc = 0; cc < n; ++cc) { const size_t gh = (size_t)(g0 + cc) * 4 + h; const float dd = dS[gh * 2048 + idx], de = dec[gh * 32 + d]; St[gh * 2048 + idx] = S; S = de * (S + dd); }
    *outp = S;
}
__device__ __forceinline__ void attn_unit(const Ctx& c, int l, int au) {
    bf16_t* Ks = (bf16_t*)c.ldsg; bf16_t* Vt = (bf16_t*)(c.ldsg + 18432); int* flags = (int*)(c.ldsg + 35840);
    const bf16_t* proj = (const bf16_t*)(c.ws + WS_BIG); bf16_t* Y = (bf16_t*)(c.ws + WS_Y);
    int R0, n_past, qb, hp, sb = 0;
    if (au < 2048) { const int b = au >> 9, rem = au & 511; qb = rem >> 2; hp = rem & 3; R0 = b * 8192; n_past = 0; }
    else { const int a2 = au - 2048; sb = a2 >> 2; hp = a2 & 3; qb = 0; R0 = MP + sb * 64; n_past = 2048; }
    const int tid = c.tid, w = c.wave, lane = c.lane, fr = lane & 15, fq = lane >> 4, hsel = w >> 2, hh = 2 * hp + hsel, qsub = w & 3;
    const int qrow = R0 + qb * 64 + qsub * 16 + fr, qpos = n_past + qb * 64 + qsub * 16 + fr;
    bf16x8 qf[2];
#pragma unroll
    for (int ks = 0; ks < 2; ++ks) qf[ks] = *(const bf16x8*)(proj + (size_t)qrow * PW + C_QA + hh * 64 + 32 * ks + 8 * fq);
    f32x4 O[4];
#pragma unroll
    for (int i = 0; i < 4; ++i) O[i] = (f32x4){0.f, 0.f, 0.f, 0.f};
    float carry = 0.f; bool wdone = false;
    int kt = (n_past + qb * 64) >> 6;
    const int lh = tid >> 8, lj = (tid >> 2) & 63, d0 = (tid & 3) * 16, lhead = 2 * hp + lh;
    for (;;) {
        {
            const int kpos = kt * 64 + lj; unsigned kk[8], vv[8];
            if (kpos < n_past) {
                const size_t o = (((size_t)(l * 32 + sb) * 2048 + kpos) * 512) + lhead * 64 + d0; const float* kp = c.in[2] + o; const float* vp = c.in[3] + o;
#pragma unroll
                for (int i = 0; i < 4; ++i) { const f32x4 a = *(const f32x4*)(kp + 4 * i), b = *(const f32x4*)(vp + 4 * i); kk[2 * i] = pk2(a[0], a[1]); kk[2 * i + 1] = pk2(a[2], a[3]); vv[2 * i] = pk2(b[0], b[1]); vv[2 * i + 1] = pk2(b[2], b[3]); }
            } else {
                const bf16_t* rp = proj + (size_t)(R0 + kpos - n_past) * PW + lhead * 64 + d0;
                const u32x4 a0 = *(const u32x4*)(rp + C_KA), a1 = *(const u32x4*)(rp + C_KA + 8), b0 = *(const u32x4*)(rp + C_VA), b1 = *(const u32x4*)(rp + C_VA + 8);
                kk[0] = a0.x; kk[1] = a0.y; kk[2] = a0.z; kk[3] = a0.w; kk[4] = a1.x; kk[5] = a1.y; kk[6] = a1.z; kk[7] = a1.w;
                vv[0] = b0.x; vv[1] = b0.y; vv[2] = b0.z; vv[3] = b0.w; vv[4] = b1.x; vv[5] = b1.y; vv[6] = b1.z; vv[7] = b1.w;
            }
            bf16_t* kd = Ks + (lh * 64 + lj) * 72 + d0;
            *(u32x4*)kd = (u32x4){kk[0], kk[1], kk[2], kk[3]}; *(u32x4*)(kd + 8) = (u32x4){kk[4], kk[5], kk[6], kk[7]};
#pragma unroll
            for (int i = 0; i < 8; ++i) { Vt[(lh * 64 + d0 + 2 * i) * 68 + lj] = (bf16_t)(vv[i] & 0xffffu); Vt[(lh * 64 + d0 + 2 * i + 1) * 68 + lj] = (bf16_t)(vv[i] >> 16); }
        }
        __syncthreads();
        {
            f32x4 sa[4];
#pragma unroll
            for (int u = 0; u < 4; ++u) { sa[u] = (f32x4){0.f, 0.f, 0.f, 0.f};
#pragma unroll
                for (int ks = 0; ks < 2; ++ks) { const bf16x8 kf = *(const bf16x8*)(Ks + (hsel * 64 + 16 * u + fr) * 72 + 32 * ks + 8 * fq); sa[u] = __builtin_amdgcn_mfma_f32_16x16x32_bf16(kf, qf[ks], sa[u], 0, 0, 0); } }
            float lk[4][4], lw[4][4], ls[4], suf[4], T[4];
#pragma unroll
            for (int u = 0; u < 4; ++u) { ls[u] = 0.f;
#pragma unroll
                for (int i = 0; i < 4; ++i) { const float z = sa[u][i] * 0.125f; const int kpos = kt * 64 + 16 * u + 4 * fq + i; const bool valid = kpos < qpos;
                    const float sp = softplus(z); lk[u][i] = valid ? -sp : 0.f; lw[u][i] = valid ? (z - sp) : -1e30f; ls[u] += lk[u][i]; } }
#pragma unroll
            for (int u = 0; u < 4; ++u) { const float a = __shfl_xor(ls[u], 16), t1 = ls[u] + a, o = __shfl_xor(t1, 32); T[u] = t1 + o; suf[u] = ((fq & 1) ? 0.f : a) + ((fq & 2) ? 0.f : o); }
            float base = carry; float wv[4][4];
#pragma unroll
            for (int u = 3; u >= 0; --u) { float run = base + suf[u];
#pragma unroll
                for (int i = 3; i >= 0; --i) { wv[u][i] = fexp(lw[u][i] + run); run += lk[u][i]; }
                base += T[u]; }
            carry = base;
#pragma unroll
            for (int k2 = 0; k2 < 2; ++k2) {
                u32x4 pw; pw.x = pk2(wv[2 * k2][0], wv[2 * k2][1]); pw.y = pk2(wv[2 * k2][2], wv[2 * k2][3]); pw.z = pk2(wv[2 * k2 + 1][0], wv[2 * k2 + 1][1]); pw.w = pk2(wv[2 * k2 + 1][2], wv[2 * k2 + 1][3]);
                const bf16x8 pf = __builtin_bit_cast(bf16x8, pw);
#pragma unroll
                for (int db = 0; db < 4; ++db) { const bf16_t* vp = Vt + (hsel * 64 + 16 * db + fr) * 68 + 32 * k2 + 4 * fq; const u32x2 lo = *(const u32x2*)vp, hi = *(const u32x2*)(vp + 16);
                    const bf16x8 vf = __builtin_bit_cast(bf16x8, (u32x4){lo.x, lo.y, hi.x, hi.y}); O[db] = __builtin_amdgcn_mfma_f32_16x16x32_bf16(vf, pf, O[db], 0, 0, 0); }
            }
            wdone = __all(carry < -46.f) != 0;
        }
        --kt;
        if (lane == 0) flags[w] = wdone ? 1 : 0;
        __syncthreads();
        int alld = 1;
#pragma unroll
        for (int i = 0; i < 8; ++i) alld &= flags[i];
        if (alld || kt < 0) break;
    }
#pragma unroll
    for (int db = 0; db < 4; ++db) { u32x2 o; o.x = pk2(O[db][0], O[db][1]); o.y = pk2(O[db][2], O[db][3]); *(u32x2*)(Y + (size_t)qrow * D + hh * 64 + 16 * db + 4 * fq) = o; }
    __syncthreads();
}

__device__ __forceinline__ void gla_out_unit(const Ctx& c, int l, int g, int h) {
    float* L = (float*)c.ldsg; float* qs = L; float* ktT = L + 2112; float* vs = L + 4288; float* sc = L + 8640; float* Ss = L + 12800;
    const bf16_t* proj = (const bf16_t*)(c.ws + WS_BIG); bf16_t* Y = (bf16_t*)(c.ws + WS_Y); const float* bws = (const float*)(c.ws + WS_B);
    const int m0 = g * 64, tid = c.tid;
#pragma unroll
    for (int i = 0; i < 4; ++i) { const int o = tid + 512 * i, t = o >> 5, d = o & 31; const float b = bws[(size_t)(m0 + t) * 128 + h * 32 + d];
        const bf16_t* pr = proj + (size_t)(m0 + t) * PW + h * 32 + d;
        qs[t * 33 + d] = bf2f(pr[C_QB]) * 0.17677669529663687f * fexp(b); ktT[d * 68 + t] = bf2f(pr[C_KB]) * fexp(-b);
        Ss[o] = ((const float*)(c.ws + WS_ST))[(size_t)(g * 4 + h) * 2048 + o]; }
    { const int t = tid >> 3, e0 = (tid & 7) * 8; const u32x4 w = *(const u32x4*)(proj + (size_t)(m0 + t) * PW + C_VB + h * 64 + e0); float* d = vs + t * 68 + e0;
      d[0] = bflo(w.x); d[1] = bfhi(w.x); d[2] = bflo(w.y); d[3] = bfhi(w.y); d[4] = bflo(w.z); d[5] = bfhi(w.z); d[6] = bflo(w.w); d[7] = bfhi(w.w); }
    __syncthreads();
    const int t = tid >> 3, g8 = (tid & 7) * 8;
    { float a[8];
#pragma unroll
      for (int j = 0; j < 8; ++j) a[j] = 0.f;
      for (int d = 0; d < 32; ++d) { const float q = qs[t * 33 + d]; const f32x4 k0 = *(const f32x4*)(ktT + d * 68 + g8), k1 = *(const f32x4*)(ktT + d * 68 + g8 + 4);
#pragma unroll
          for (int j = 0; j < 4; ++j) { a[j] += q * k0[j]; a[4 + j] += q * k1[j]; } }
#pragma unroll
      for (int j = 0; j < 8; ++j) sc[t * 65 + g8 + j] = (g8 + j <= t) ? a[j] : 0.f; }
    __syncthreads();
    { float o[8];
#pragma unroll
      for (int j = 0; j < 8; ++j) o[j] = 0.f;
      for (int s = 0; s <= t; ++s) { const float p = sc[t * 65 + s]; const f32x4 v0 = *(const f32x4*)(vs + s * 68 + g8), v1 = *(const f32x4*)(vs + s * 68 + g8 + 4);
#pragma unroll
          for (int j = 0; j < 4; ++j) { o[j] += p * v0[j]; o[4 + j] += p * v1[j]; } }
      for (int d = 0; d < 32; ++d) { const float q = qs[t * 33 + d]; const f32x4 s0 = *(const f32x4*)(Ss + d * 64 + g8), s1 = *(const f32x4*)(Ss + d * 64 + g8 + 4);
#pragma unroll
          for (int j = 0; j < 4; ++j) { o[j] += q * s0[j]; o[4 + j] += q * s1[j]; } }
      float q2 = 0.f;
#pragma unroll
      for (int j = 0; j < 8; ++j) q2 += o[j] * o[j];
      q2 += __shfl_xor(q2, 1); q2 += __shfl_xor(q2, 2); q2 += __shfl_xor(q2, 4);
      const float r = __builtin_amdgcn_rsqf(q2 * (1.0f / 64.0f) + EPS);
      const u32x4 ow = *(const u32x4*)(proj + (size_t)(m0 + t) * PW + C_OB + h * 64 + g8);
      float ob[8] = {bflo(ow.x), bfhi(ow.x), bflo(ow.y), bfhi(ow.y), bflo(ow.z), bfhi(ow.z), bflo(ow.w), bfhi(ow.w)};
      const float* gn = c.in[15] + l * 256 + h * 64 + g8; float y[8];
#pragma unroll
      for (int j = 0; j < 8; ++j) y[j] = o[j] * r * gn[j] * (ob[j] * sigm(ob[j]));
      u32x4 w; w.x = pk2(y[0], y[1]); w.y = pk2(y[2], y[3]); w.z = pk2(y[4], y[5]); w.w = pk2(y[6], y[7]);
      *(u32x4*)(Y + (size_t)(m0 + t) * D + 512 + h * 64 + g8) = w; }
    __syncthreads();
}

__device__ __forceinline__ void grid_bar(unsigned* ctl, unsigned r) {
    asm volatile("s_waitcnt vmcnt(0)" ::: "memory");
    __syncthreads();
    if (threadIdx.x == 0) {
        const unsigned g = blockIdx.x & 7u, G = gridDim.x, nloc = (G - g + 7u) >> 3, ngrp = G < 8u ? G : 8u;
        unsigned* cnt = ctl + 64 * (16 + g); unsigned* gen = ctl + 64 * (24 + g); unsigned* top = ctl + 64 * 32;
        __builtin_amdgcn_fence(__ATOMIC_RELEASE, "agent");
        asm volatile("s_waitcnt vmcnt(0)" ::: "memory");
        const unsigned old = __hip_atomic_fetch_add(cnt, 1u, __ATOMIC_RELAXED, __HIP_MEMORY_SCOPE_AGENT);
        if (old + 1u == r * nloc) {
            __hip_atomic_fetch_add(top, 1u, __ATOMIC_RELAXED, __HIP_MEMORY_SCOPE_AGENT);
            while (__hip_atomic_load(top, __ATOMIC_RELAXED, __HIP_MEMORY_SCOPE_AGENT) < r * ngrp) __builtin_amdgcn_s_sleep(1);
            __hip_atomic_store(gen, r, __ATOMIC_RELAXED, __HIP_MEMORY_SCOPE_AGENT);
        } else {
            while (__hip_atomic_load(gen, __ATOMIC_RELAXED, __HIP_MEMORY_SCOPE_AGENT) < r) __builtin_amdgcn_s_sleep(1);
        }
        __builtin_amdgcn_fence(__ATOMIC_ACQUIRE, "agent");
        asm volatile("s_waitcnt vmcnt(0)" ::: "memory");
    }
    __syncthreads();
}

__global__ void __launch_bounds__(512, 2) fwd_mega(Args args) {
    extern __shared__ __attribute__((aligned(16))) unsigned char lds[];
    cg::grid_group grid = cg::this_grid();
    Ctx c; c.in = args.in; c.out = args.out; c.ws = args.ws; c.lds = (LAS unsigned char*)lds; c.ldsg = lds;
    c.tid = threadIdx.x; c.lane = c.tid & 63; c.wave = __builtin_amdgcn_readfirstlane(c.tid >> 6); c.G = gridDim.x; c.bx = blockIdx.x;
    for (int ph = args.ph_lo; ph < args.ph_hi; ++ph) {
        { int t_ = threadIdx.x; asm volatile("" : "+v"(t_)); c.tid = t_; c.lane = t_ & 63; c.wave = __builtin_amdgcn_readfirstlane(t_ >> 6); }
        unsigned char* ws = args.ws; float* outp = args.out; asm volatile("" : "+s"(ws), "+s"(outp)); c.ws = ws; c.out = outp;
        bf16_t* xb = (bf16_t*)(ws + WS_XB); bf16_t* big = (bf16_t*)(ws + WS_BIG); bf16_t* Yb = (bf16_t*)(ws + WS_Y); bf16_t* mg = (bf16_t*)(ws + WS_MG);
        float* scr = (float*)(ws + WS_SCR); float* ss0 = (float*)(ws + WS_SS); float* ss1 = ss0 + (size_t)M * 32; float* xw = outp + O_Y;
        if (ph == 0) prologue(c);
        else if (ph == 25) {
            const float* gf = args.in[28];
            for (int row = c.bx * 8 + c.wave; row < M; row += c.G * 8) { const float rs = rstd_of(ss0, row);
#pragma unroll
                for (int j = 0; j < 4; ++j) { float* p = xw + (size_t)row * D + c.lane * 4 + 256 * j; const f32x4 v = *(const f32x4*)p, gg = *(const f32x4*)(gf + c.lane * 4 + 256 * j); *(f32x4*)p = v * rs * gg; } }
        } else {
            const int l = (ph - 1) / 12, k = (ph - 1) % 12;
            if ((MK_SKIPMASK >> k) & 1) continue;
            const bf16_t* Wl = (const bf16_t*)(ws + WS_W) + (size_t)l * WL_END;
            if (k == 0 || k == 8) {
                pg8::Gemm g{(k == 0 && l > 0) ? mg : xb, Wl + (k == 0 ? WL_1IN : WL_2IN), D, D}; pg8::Sched S;     S.init(M, 2 * FF, c.G, c.bx, 16);
                EpiSwiglu E{big}; pg8::gemm_phase(c.lds, c.tid, g, S, E, ss0);
            } else if (k == 1 || k == 9 || k == 7 || k == 11) {
                pg8::Gemm g; pg8::Sched S; EpiRes E{xw, xb, nullptr, (const bf16_t*)scr, 1.f, 0, nullptr, nullptr}; const float* ssin = nullptr;
                if (k == 1 || k == 9) { g = pg8::Gemm{big, Wl + (k == 1 ? WL_1OUT : WL_2OUT), FF, FF}; S.init(M, D, c.G, c.bx, 44); S.quart = 1; E.alpha = 0.5f; E.ss_out = ss1; if (l == 0 && k == 1) { E.xin0 = args.in[0]; E.xin1 = args.in[1]; } }
                else if (k == 7) { g = pg8::Gemm{mg, Wl + WL_OUT, D, D}; S.init(M, D, c.G, c.bx, 16); S.quart = 1; E.ss_out = ss0; }
                else { g = pg8::Gemm{xb, Wl + WL_PG, D, D}; S.init(M, D, c.G, c.bx, 16); S.quart = 1; E.ss_out = ss0; ssin = ss1; E.mode = 1; E.xb = mg; }
                pg8::gemm_phase(c.lds, c.tid, g, S, E, ssin);
            } else if (k == 2) {
                pg8::Gemm g{xb, Wl + WL_IN, D, D}; pg8::Sched S; S.init(M, NIN, c.G, c.bx, 16); S.quart = 1;
                EpiWin E{big, outp, l}; pg8::gemm_phase(c.lds, c.tid, g, S, E, ss1);
            } else if (k == 3) {
                for (int it = next_item(c, l * 3 + 0); it < 2176 + NCH; it = next_item(c, l * 3 + 0)) { if (it < NCH) pool_unit(c, l, it); else gla_local_unit(c, l, (it - NCH) >> 2, (it - NCH) & 3); }
            } else if (k == 4) {
                for (int it = next_item(c, l * 3 + 1); it < 576 + 2176; it = next_item(c, l * 3 + 1)) { if (it < 576) scan_unit(c, l, it); else attn_unit(c, l, it - 576); }
            } else if (k == 5) {
                for (int it = next_item(c, l * 3 + 2); it < 2176; it = next_item(c, l * 3 + 2)) gla_out_unit(c, l, it >> 2, it & 3);
            } else {
                pg8::Gemm g; pg8::Sched S; EpiBranch E{big, (bf16_t*)scr, mg, 0};
                if (k == 6) { g = pg8::Gemm{Yb, Wl + WL_BR, D, D}; S.init(M, D, c.G, c.bx, 8); S.nsub = 3; S.quart = 1; }
                else { g = pg8::Gemm{(const bf16_t*)(ws + WS_PB) + (size_t)l * M * 256, Wl + WL_PP, 256, 256}; S.init(M, D, c.G, c.bx, 4); S.quart = 1; E.mode = 1; }
                pg8::gemm_phase(c.lds, c.tid, g, S, E, nullptr);
            }
        }
        if (ph + 1 < args.ph_hi) { if (ph == args.ph_lo) grid.sync(); else grid_bar((unsigned*)(args.ws + WS_CTL), (unsigned)(ph - args.ph_lo)); }
    }
}

extern "C" void kernel_launch(void* const* d_in, const int* in_sizes, int n_in, void* d_out, int out_size, void* d_ws, size_t ws_size, hipStream_t stream) {
    static int grid = 0;
    if (grid == 0) {
        if (n_in != 29 || ws_size < WS_NEED) { fprintf(stderr, "kernel_launch: unexpected n_in %d / ws %zu\n", n_in, ws_size); grid = -1; return; }
        int dev = 0, cus = 0, per_cu = 0;
        (void)hipGetDevice(&dev); (void)hipDeviceGetAttribute(&cus, hipDeviceAttributeMultiprocessorCount, dev);
        (void)hipFuncSetAttribute((const void*)fwd_mega, hipFuncAttributeMaxDynamicSharedMemorySize, LDS_BYTES);
        (void)hipOccupancyMaxActiveBlocksPerMultiprocessor(&per_cu, (const void*)fwd_mega, 512, LDS_BYTES);
        (void)hipGetLastError();
        if (per_cu < 1) per_cu = 1;
        grid = cus;
    }
    if (grid < 0) return;
    (void)hipMemsetAsync((char*)d_ws + WS_CTL, 0, 16384, stream);
    Args a{};
    for (int i = 0; i < 29; ++i) a.in[i] = (const float*)d_in[i];
    a.out = (float*)d_out; a.ws = (unsigned char*)d_ws;
#if MK_ONE_LAUNCH
    a.ph_lo = 0; a.ph_hi = NPH;
    void* kargs[] = {&a};
    hipError_t e = hipLaunchCooperativeKernel((const void*)fwd_mega, dim3(grid), dim3(512), kargs, LDS_BYTES, stream);
    if (e != hipSuccess) fprintf(stderr, "cooperative launch failed: %s (grid %d)\n", hipGetErrorString(e), grid);
#else
    for (int ph = 0; ph < NPH; ++ph) { a.ph_lo = ph; a.ph_hi = ph + 1; hipLaunchKernelGGL(fwd_mega, dim3(grid), dim3(512), LDS_BYTES, stream, a); }
#endif
}
```

```cpp
#include <hip/hip_runtime.h>
#include <hip/hip_cooperative_groups.h>
#include <cstdio>
#include <cstdint>
namespace cg = cooperative_groups;

#ifndef MK_SKIPMASK
#define MK_SKIPMASK 0
#endif
#ifndef MK_NOATTN
#define MK_NOATTN 0
#endif
#ifndef MK_NOGLAOUT
#define MK_NOGLAOUT 0
#endif
#ifndef MK_ONE_LAUNCH
#define MK_ONE_LAUNCH 1
#endif

#define LAS __attribute__((address_space(3)))
typedef unsigned short bf16_t;
typedef short bf16x8 __attribute__((ext_vector_type(8)));
typedef float f32x4 __attribute__((ext_vector_type(4)));
typedef unsigned u32x4 __attribute__((ext_vector_type(4)));
typedef unsigned u32x2 __attribute__((ext_vector_type(2)));

constexpr int M = 34816;
constexpr int MP = 32768;
constexpr int D = 1024, FF = 2816, NIN = 5888, PW = 5888  , INW = 5648;
constexpr int NCH = 544;
constexpr float EPS = 1e-6f;
constexpr size_t O_Y = 0, O_KP = 35651584, O_VP = 69206016, O_GP = 102760448, O_PP = 102825984, O_KS = 102856704, O_VS = 104953856, O_GS = 107051008, O_PS = 107575296;
constexpr int C_QA = 0, C_KA = 512, C_VA = 1024, C_QB = 1536, C_KB = 1664, C_VB = 1792, C_OB = 2048, C_UC = 2304, C_G = 2560, C_RB = 5632;

constexpr size_t WL_1IN = 0, WL_1OUT = WL_1IN + (size_t)5632 * 1024, WL_IN = WL_1OUT + (size_t)1024 * 2816, WL_BR = WL_IN + (size_t)5888 * 1024, WL_OUT = WL_BR + 1048576,
                 WL_2IN = WL_OUT + 1048576, WL_2OUT = WL_2IN + (size_t)5632 * 1024, WL_PG = WL_2OUT + (size_t)1024 * 2816, WL_PP = WL_PG + 1048576, WL_END = WL_PP + 262144;
constexpr size_t MiB = 1u << 20;
constexpr size_t WS_W = 0;
constexpr size_t WS_XB = 104 * MiB;
constexpr size_t WS_PB = 172 * MiB;
constexpr size_t WS_BIG = 208 * MiB;
constexpr size_t WS_Y = 600 * MiB;
constexpr size_t WS_MG = 668 * MiB;
constexpr size_t WS_SCR = 736 * MiB;
constexpr size_t WS_SS = 934 * MiB;
constexpr size_t WS_DS = 878 * MiB;
constexpr size_t WS_ST = 896 * MiB;
constexpr size_t WS_B = 914 * MiB;
constexpr size_t WS_DEC = 932 * MiB;
constexpr size_t WS_CTL = 933 * MiB;
constexpr size_t WS_NEED = 944 * MiB;
static_assert(2 * WL_END * 2 <= 104 * MiB, "weights fit");

__device__ __forceinline__ unsigned f2bf(float f) { unsigned u = __builtin_bit_cast(unsigned, f); return (u + 0x7fffu + ((u >> 16) & 1u)) >> 16; }
__device__ __forceinline__ unsigned pk2(float lo, float hi) { unsigned r; asm("v_cvt_pk_bf16_f32 %0, %1, %2" : "=v"(r) : "v"(lo), "v"(hi)); return r; }
__device__ __forceinline__ float bflo(unsigned u) { return __uint_as_float(u << 16); }
__device__ __forceinline__ float bfhi(unsigned u) { return __uint_as_float(u & 0xffff0000u); }
__device__ __forceinline__ float bf2f(bf16_t b) { return __uint_as_float((unsigned)b << 16); }
__device__ __forceinline__ float fexp(float x) { return __builtin_amdgcn_exp2f(x * 1.4426950408889634f); }
__device__ __forceinline__ float flog(float x) { return __builtin_amdgcn_logf(x) * 0.6931471805599453f; }
__device__ __forceinline__ float sigm(float x) { return __builtin_amdgcn_rcpf(1.0f + fexp(-x)); }
__device__ __forceinline__ float softplus(float z) { return fmaxf(z, 0.f) + flog(1.0f + fexp(-fabsf(z))); }
__device__ __forceinline__ float rstd_of(const float* ss, int row) {
    const f32x4* p = (const f32x4*)(ss + (size_t)row * 32);
    float s = 0.f;
#pragma unroll
    for (int i = 0; i < 8; ++i) { const f32x4 a = p[i]; s += (a[0] + a[1]) + (a[2] + a[3]); }
    return __builtin_amdgcn_rsqf(s * (1.0f / 1024.0f) + EPS);
}

namespace pg8 {
constexpr int BM = 256, BK = 64, HALF = 128, HTB = HALF * BK * 2, STAGE_BYTES = 8 * HTB, NXCD = 8, WGM = 8;
__host__ __device__ __forceinline__ int lds_byte(int r, int c) { const int st = (r >> 4) * 2 + (c >> 5), rr = r & 15, cc = c & 31, ob = rr * 64 + cc * 2; return st * 1024 + (ob ^ (((ob >> 9) & 1) << 5)); }
__host__ __device__ __forceinline__ void stage_rc(int b, int& R, int& C) { const int st = b / 1024, sb = b % 1024, swz = sb ^ (((sb >> 9) & 1) << 5); R = (st >> 1) * 16 + swz / 64; C = (st & 1) * 32 + (swz % 64) / 2; }
__host__ __device__ __forceinline__ int perm32(int rho) { const int n = rho >> 4, i = rho & 15; return 8 * (i >> 2) + 4 * n + (i & 3); }

struct Unit { int pm, pn, kind, k0, nt, qm; };
struct Gemm { const bf16_t* A; const bf16_t* Bt; int lda, ldb; };

struct Sched {
    int nM, nN, nwg, G, c, nsub, nt0, quart;
    __device__ __forceinline__ void init(int M_, int N_, int G_, int c_, int nt) { nM = M_ / BM; nN = N_ / BM; nwg = nM * nN; G = G_; c = c_; nsub = 1; nt0 = nt; quart = 0; }
    __device__ __forceinline__ bool next(int i, Unit& u) const {
        const int ti = i / nsub, sk = i - ti * nsub;
        long L = (long)ti * G + c; int qm = 0xF;
        const int nfull = nwg / G;
        if (quart && ti >= nfull) {
            const long li = (long)(ti - nfull) * G + c; if (li >= 4L * (nwg - nfull * G)) return false;
            L = (long)nfull * G + (li >> 2); qm = 1 << (int)(li & 3);
        } else if (L >= nwg) return false;
        u.qm = qm;
        int wgid = (int)L; { const int q = nwg / NXCD, r = nwg % NXCD, xcd = wgid % NXCD, off = wgid / NXCD; wgid = (xcd < r ? xcd * (q + 1) : r * (q + 1) + (xcd - r) * q) + off; }
        const int nig = WGM * nN, gid = wgid / nig, fm = gid * WGM, gsz = (nM - fm) < WGM ? (nM - fm) : WGM;
        u.pm = fm + ((wgid % nig) % gsz); u.pn = (wgid % nig) / gsz; u.kind = sk; u.k0 = (sk > 0) ? 256 + 256 * sk : 0; u.nt = (sk > 0) ? 4 : nt0; return true;
    }
};

#define PG8_KLOOP(C0, C1, C2, C3) \
        for (int t = 0; t < nt; t += 2) { \
            const bool last = (t == nt - 2); \
            const char* a1 = cA + (size_t)(t + 1) * kstep; \
            const char* a2 = last ? nA : cA + (size_t)(t + 2) * kstep; const char* b2 = last ? nB : cB + (size_t)(t + 2) * kstep; \
            const char* a3 = a2 + kstep; const char* b3 = b2 + kstep; \
            PG8_LDB(B0, 0, 0); PG8_LDB(B1, 0, 1); PG8_SCHED; PG8_LDA(At, 0, 0); PG8_STAGE(PG8_SA(1, 1), a1 + hstepA, voffA); \
            PG8_WAIT_V(8); PG8_WAIT_L(0); PG8_BAR; if (C0) PG8_MMA(0, 0, At, B0); if (C1) PG8_MMA(0, 1, At, B1); PG8_BAR; PG8_SCHED; \
            PG8_LDA(At, 0, 1); PG8_STAGE(PG8_SB(0, 0), b2, voffB); PG8_STAGE(PG8_SB(0, 1), b2 + hstepB, voffB); PG8_STAGE(PG8_SA(0, 0), a2, voffA); \
            PG8_WAIT_V(8); PG8_WAIT_L(0); PG8_BAR; if (C2) PG8_MMA(1, 0, At, B0); if (C3) PG8_MMA(1, 1, At, B1); PG8_BAR; PG8_SCHED; \
            PG8_LDB(B0, 1, 0); PG8_LDB(B1, 1, 1); PG8_SCHED; PG8_LDA(At, 1, 0); PG8_STAGE(PG8_SA(0, 1), a2 + hstepA, voffA); \
            PG8_WAIT_V(8); PG8_WAIT_L(0); PG8_BAR; if (C0) PG8_MMA(0, 0, At, B0); if (C1) PG8_MMA(0, 1, At, B1); PG8_BAR; PG8_SCHED; \
            PG8_LDA(At, 1, 1); PG8_STAGE(PG8_SB(1, 0), b3, voffB); PG8_STAGE(PG8_SB(1, 1), b3 + hstepB, voffB); PG8_STAGE(PG8_SA(1, 0), a3, voffA); \
            PG8_WAIT_V(8); PG8_WAIT_L(0); PG8_BAR; if (C2) PG8_MMA(1, 0, At, B0); if (C3) PG8_MMA(1, 1, At, B1); PG8_BAR; PG8_SCHED; \
        }
template <class Epi, class Sch>
__device__ __forceinline__ void gemm_phase(LAS unsigned char* lds, const int tid, const Gemm g, const Sch& S, const Epi& E, const float* ss) {
    const int wid = __builtin_amdgcn_readfirstlane(tid >> 6), lane = tid & 63, wr = wid >> 2, wc = wid & 3, fr = lane & 15, fq = lane >> 4;
    unsigned voffA[2], voffB[2];
#pragma unroll
    for (int i = 0; i < 2; ++i) { int R, C; stage_rc(tid * 16 + i * 8192, R, C); const int Rb = (R & ~31) + perm32(R & 31);
        voffA[i] = (unsigned)(R * g.lda + C) * 2u; voffB[i] = (unsigned)(Rb * g.ldb + C) * 2u; }
    const size_t kstep = (size_t)(BK * 2);
    const size_t hstepA = (size_t)HALF * g.lda * 2, hstepB = (size_t)HALF * g.ldb * 2;
    const size_t tstepA = 2 * hstepA, tstepB = 2 * hstepB;
    const unsigned ldsw = (unsigned)wid * 1024u;
    const int aoff = lds_byte(wr * 64 + fr, fq * 8), boff = lds_byte(wc * 32 + fr, fq * 8);
    LAS float* rtab = (LAS float*)(lds + STAGE_BYTES);
    f32x4 rt_a = {0.f, 0.f, 0.f, 0.f}, rt_b = rt_a, rt_c = rt_a, rt_d = rt_a;
#define PG8_RTAB_LOAD(pm_) do { if (ss) { const f32x4* p_ = (const f32x4*)(ss + ((size_t)(pm_) * 256 + (tid >> 1)) * 32 + (tid & 1) * 16); rt_a = p_[0]; rt_b = p_[1]; rt_c = p_[2]; rt_d = p_[3]; } } while (0)
#define PG8_RTAB_FIN(buf_) do { if (ss) { float s_ = (((rt_a[0] + rt_a[1]) + (rt_a[2] + rt_a[3])) + ((rt_b[0] + rt_b[1]) + (rt_b[2] + rt_b[3]))) + (((rt_c[0] + rt_c[1]) + (rt_c[2] + rt_c[3])) + ((rt_d[0] + rt_d[1]) + (rt_d[2] + rt_d[3]))); \
        s_ += __shfl_xor(s_, 1); if (!(tid & 1)) rtab[(buf_) * 256 + (tid >> 1)] = __builtin_amdgcn_rsqf(s_ * (1.0f / 1024.0f) + EPS); } } while (0)
#define PG8_SA(b, h) (((b) * 2 + (h)) * HTB)
#define PG8_SB(b, h) ((4 + (b) * 2 + (h)) * HTB)
#define PG8_STAGE(bufoff, gbase, voff) do { _Pragma("unroll") for (int _i = 0; _i < 2; ++_i) \
        __builtin_amdgcn_global_load_lds((const unsigned*)((const char*)(gbase) + (voff)[_i]), (LAS unsigned*)(lds + (bufoff) + ldsw + _i * 8192), 16, 0, 0); } while (0)
#define PG8_LDA(dst, b, h) do { _Pragma("unroll") for (int m = 0; m < 4; ++m) _Pragma("unroll") for (int k = 0; k < 2; ++k) dst[m][k] = *(const LAS bf16x8*)(lds + PG8_SA(b, h) + aoff + m * 2048 + k * 1024); } while (0)
#define PG8_LDB(dst, b, h) do { _Pragma("unroll") for (int n = 0; n < 2; ++n) _Pragma("unroll") for (int k = 0; k < 2; ++k) dst[n][k] = *(const LAS bf16x8*)(lds + PG8_SB(b, h) + boff + n * 2048 + k * 1024); } while (0)
#define PG8_MMA(ai, bj, At, Bt) do { __builtin_amdgcn_s_setprio(1); _Pragma("unroll") for (int m = 0; m < 4; ++m) _Pragma("unroll") for (int n = 0; n < 2; ++n) _Pragma("unroll") for (int k = 0; k < 2; ++k) \
        acc[ai][bj][m][n] = __builtin_amdgcn_mfma_f32_16x16x32_bf16(Bt[n][k], At[m][k], acc[ai][bj][m][n], 0, 0, 0); __builtin_amdgcn_s_setprio(0); } while (0)
#define PG8_WAIT_V(n) asm volatile("s_waitcnt vmcnt(" #n ")" ::: "memory")
#define PG8_WAIT_L(n) asm volatile("s_waitcnt lgkmcnt(" #n ")" ::: "memory")
#define PG8_BAR __builtin_amdgcn_s_barrier()
#define PG8_SCHED __builtin_amdgcn_sched_barrier(0)
    Unit cur, nxt; int ui = 0;
    if (!S.next(0, cur)) return;
    f32x4 acc[2][2][4][2];
#pragma unroll
    for (int a = 0; a < 2; ++a)
#pragma unroll
        for (int b = 0; b < 2; ++b)
#pragma unroll
            for (int m = 0; m < 4; ++m)
#pragma unroll
                for (int n = 0; n < 2; ++n) acc[a][b][m][n] = (f32x4){0.f, 0.f, 0.f, 0.f};
    bf16x8 At[4][2], B0[2][2], B1[2][2];
    const char* cA = (const char*)g.A + (size_t)cur.pm * tstepA + (size_t)cur.k0 * 2; const char* cB = (const char*)g.Bt + (size_t)cur.pn * tstepB + (size_t)cur.k0 * 2;
    PG8_RTAB_LOAD(cur.pm); PG8_RTAB_FIN(0);
    PG8_STAGE(PG8_SB(0, 0), cB, voffB); PG8_STAGE(PG8_SB(0, 1), cB + hstepB, voffB); PG8_STAGE(PG8_SA(0, 0), cA, voffA); PG8_STAGE(PG8_SA(0, 1), cA + hstepA, voffA);
    if (wr == 1) PG8_BAR;
    PG8_WAIT_V(2); PG8_BAR;
    PG8_STAGE(PG8_SB(1, 0), cB + kstep, voffB); PG8_STAGE(PG8_SA(1, 0), cA + kstep, voffA); PG8_STAGE(PG8_SB(1, 1), cB + hstepB + kstep, voffB);
    PG8_WAIT_V(6); PG8_BAR;
    for (;;) {
        const bool has_next = S.next(ui + 1, nxt);
        const char* nA = has_next ? (const char*)g.A + (size_t)nxt.pm * tstepA + (size_t)nxt.k0 * 2 : cA; const char* nB = has_next ? (const char*)g.Bt + (size_t)nxt.pn * tstepB + (size_t)nxt.k0 * 2 : cB;
        const int nt = cur.nt, qm = cur.qm;
        if (qm == 0xF) { PG8_KLOOP(true, true, true, true) } else { PG8_KLOOP((qm & 1), (qm & 2), (qm & 4), (qm & 8)) }
        if (wr == 0) PG8_BAR;
        if (has_next) PG8_RTAB_LOAD(nxt.pm);
        E(acc, cur, wr, wc, fr, fq, rtab + (ui & 1) * 256);
        if (!has_next) break;
#pragma unroll
        for (int a = 0; a < 2; ++a)
#pragma unroll
            for (int b = 0; b < 2; ++b)
#pragma unroll
                for (int m = 0; m < 4; ++m)
#pragma unroll
                    for (int n = 0; n < 2; ++n) acc[a][b][m][n] = (f32x4){0.f, 0.f, 0.f, 0.f};
        cur = nxt; cA = nA; cB = nB; ++ui;
        PG8_RTAB_FIN(ui & 1);
        if (wr == 1) PG8_BAR;
    }
    PG8_WAIT_V(0);
    PG8_BAR;
#undef PG8_SA
#undef PG8_RTAB_LOAD
#undef PG8_RTAB_FIN
#undef PG8_SB
#undef PG8_STAGE
#undef PG8_LDA
#undef PG8_LDB
#undef PG8_MMA
#undef PG8_WAIT_V
#undef PG8_WAIT_L
#undef PG8_BAR
#undef PG8_SCHED
}
}
using pg8::Unit;

#define EPI_FENCE() asm volatile("" ::: "memory")
struct EpiSwiglu {
    bf16_t* hid;
    __device__ __forceinline__ void operator()(const f32x4 (&acc)[2][2][4][2], const Unit& u, int wr, int wc, int fr, int fq, const LAS float* rt) const {
        const int row0 = u.pm * 256 + wr * 64 + fr, col = u.pn * 128 + wc * 32 + 8 * fq;
#pragma unroll
        for (int ai = 0; ai < 2; ++ai)
#pragma unroll
            for (int m = 0; m < 4; ++m) {
                const int rl = ai * 128 + m * 16; const int row = row0 + rl; const float rs = rt[wr * 64 + fr + rl];
                float h[8];
#pragma unroll
                for (int n = 0; n < 2; ++n)
#pragma unroll
                    for (int i = 0; i < 4; ++i) { const float a = acc[ai][0][m][n][i] * rs, b = acc[ai][1][m][n][i] * rs; h[4 * n + i] = a * sigm(a) * b; }
                u32x4 w; w.x = pk2(h[0], h[1]); w.y = pk2(h[2], h[3]); w.z = pk2(h[4], h[5]); w.w = pk2(h[6], h[7]);
                *(u32x4*)(hid + (size_t)row * FF + col) = w;
            }
    }
};
struct EpiWin {
    bf16_t* proj; float* out; int layer;
    __device__ __forceinline__ void operator()(const f32x4 (&acc)[2][2][4][2], const Unit& u, int wr, int wc, int fr, int fq, const LAS float* rt) const {
        const int row0 = u.pm * 256 + wr * 64 + fr, pn = u.pn;
        const bool isgate = (pn >= 10 && pn < 22), iskv = (pn >= 2 && pn < 6), ispool = (pn == 9);
#pragma unroll
        for (int ai = 0; ai < 2; ++ai)
#pragma unroll
            for (int m = 0; m < 4; ++m) {
                const int rl = ai * 128 + m * 16; const int row = row0 + rl; const float rs = rt[wr * 64 + fr + rl];
#pragma unroll
                for (int bj = 0; bj < 2; ++bj) {
                    if (!((u.qm >> (ai * 2 + bj)) & 1)) continue;
                    const int ct = bj * 128 + wc * 32 + 8 * fq;
                    f32x4 v0 = acc[ai][bj][m][0] * rs, v1 = acc[ai][bj][m][1] * rs;
                    if (isgate) {
#pragma unroll
                        for (int i = 0; i < 4; ++i) { v0[i] = sigm(v0[i]); v1[i] = sigm(v1[i]); }
                    }
                    u32x4 w; w.x = pk2(v0[0], v0[1]); w.y = pk2(v0[2], v0[3]); w.z = pk2(v1[0], v1[1]); w.w = pk2(v1[2], v1[3]);
                    *(u32x4*)(proj + (size_t)row * PW + pn * 256 + ct) = w;
                    if (iskv) {
                        const int c512 = (pn & 1) * 256 + ct; const bool isv = pn >= 4;
                        float* dst = row < MP ? out + (isv ? O_VP : O_KP) + ((size_t)layer * MP + row) * 512 + c512
                                              : out + (isv ? O_VS : O_KS) + ((size_t)layer * 2048 + (row - MP)) * 512 + c512;
                        *(f32x4*)dst = v0; *(f32x4*)(dst + 4) = v1;
                    }
                    if (ispool) {
                        if (row < MP) { const int t = row & 8191, b = row >> 13; if (t >= 8177) { float* dst = out + O_PP + ((size_t)(layer * 4 + b) * 15 + (t - 8177)) * 256 + ct; *(f32x4*)dst = v0; *(f32x4*)(dst + 4) = v1; } }
                        else { const int r = row - MP, t = r & 63, sb = r >> 6; if (t >= 49) { float* dst = out + O_PS + ((size_t)(layer * 32 + sb) * 15 + (t - 49)) * 256 + ct; *(f32x4*)dst = v0; *(f32x4*)(dst + 4) = v1; } }
                    }
                }
            }
    }
};
struct EpiRes {
    float* x; bf16_t* xb; float* ss_out; const bf16_t* scr; float alpha; int mode; const float* xin0; const float* xin1;
    __device__ __forceinline__ void operator()(const f32x4 (&acc)[2][2][4][2], const Unit& u, int wr, int wc, int fr, int fq, const LAS float* rt) const {
        const int row0 = u.pm * 256 + wr * 64 + fr, colb = u.pn * 256 + wc * 32 + 8 * fq;
#pragma unroll
        for (int ai = 0; ai < 2; ++ai) {
            if (!((u.qm >> (2 * ai)) & 3)) continue;
#pragma unroll
            for (int mp = 0; mp < 2; ++mp) {
                f32x4 xv[2][2][2]; u32x4 sv[2][2];
                const float* xr = xin0 ? (u.pm < MP / 256 ? xin0 : xin1 - (size_t)MP * D) : x;
#pragma unroll
                for (int mi = 0; mi < 2; ++mi)
#pragma unroll
                    for (int bj = 0; bj < 2; ++bj) {
                        const size_t off = (size_t)(row0 + ai * 128 + (2 * mp + mi) * 16) * D + colb + bj * 128;
                        xv[mi][bj][0] = *(const f32x4*)(xr + off); xv[mi][bj][1] = *(const f32x4*)(xr + off + 4);
                    }
#pragma unroll
                for (int mi = 0; mi < 2; ++mi) {
                    const int m = 2 * mp + mi, rl = ai * 128 + m * 16, row = row0 + rl;
                    const float rs = (mode == 1) ? rt[wr * 64 + fr + rl] : 1.f;
                    if (mode == 1) {
#pragma unroll
                        for (int bj = 0; bj < 2; ++bj) { const size_t off = (size_t)row * D + colb + bj * 128; sv[mi][bj] = *(const u32x4*)(scr + off); }
                    }
#pragma unroll
                    for (int bj = 0; bj < 2; ++bj) {
                        if (!((u.qm >> (ai * 2 + bj)) & 1)) continue;
                        const size_t off = (size_t)row * D + colb + bj * 128;
                        f32x4 v0 = acc[ai][bj][m][0], v1 = acc[ai][bj][m][1];
                        if (mode == 1) {
#pragma unroll
                            for (int i = 0; i < 4; ++i) { v0[i] = sigm(v0[i] * rs); v1[i] = sigm(v1[i] * rs); }
                            { const u32x4 p4 = sv[mi][bj]; v0[0] *= bflo(p4.x); v0[1] *= bfhi(p4.x); v0[2] *= bflo(p4.y); v0[3] *= bfhi(p4.y); v1[0] *= bflo(p4.z); v1[1] *= bfhi(p4.z); v1[2] *= bflo(p4.w); v1[3] *= bfhi(p4.w); }
                        } else { v0 = v0 * alpha; v1 = v1 * alpha; }
                        const f32x4 x0 = xv[mi][bj][0] + v0, x1 = xv[mi][bj][1] + v1;
                        *(f32x4*)(x + off) = x0; *(f32x4*)(x + off + 4) = x1;
                        u32x4 w; w.x = pk2(x0[0], x0[1]); w.y = pk2(x0[2], x0[3]); w.z = pk2(x1[0], x1[1]); w.w = pk2(x1[2], x1[3]);
                        *(u32x4*)(xb + off) = w;
                        float ssum = (x0[0] * x0[0] + x0[1] * x0[1]) + (x0[2] * x0[2] + x0[3] * x0[3]) + (x1[0] * x1[0] + x1[1] * x1[1]) + (x1[2] * x1[2] + x1[3] * x1[3]);
                        ssum += __shfl_xor(ssum, 16); ssum += __shfl_xor(ssum, 32);
                        if (fq == 0) ss_out[(size_t)row * 32 + u.pn * 8 + bj * 4 + wc] = ssum;
                    }
                }
                EPI_FENCE();
            }
        }
    }
};
struct EpiBranch {
    const bf16_t* proj; bf16_t* scr; bf16_t* merged; int mode;
    template <int BR>
    __device__ __forceinline__ void run(const f32x4 (&acc)[2][2][4][2], const Unit& u, int wr, int wc, int fr, int fq) const {
        const int row0 = u.pm * 256 + wr * 64 + fr, colb = u.pn * 256 + wc * 32 + 8 * fq;
#pragma unroll
        for (int ai = 0; ai < 2; ++ai) {
            if (!((u.qm >> (2 * ai)) & 3)) continue;
#pragma unroll
            for (int mp = 0; mp < 2; ++mp) {
                u32x4 gt[2][2], sv[2][2];
#pragma unroll
                for (int mi = 0; mi < 2; ++mi)
#pragma unroll
                    for (int bj = 0; bj < 2; ++bj) {
                        const int row = row0 + ai * 128 + (2 * mp + mi) * 16, col = colb + bj * 128; const size_t off = (size_t)row * D + col;
                        if (BR < 3) gt[mi][bj] = *(const u32x4*)(proj + (size_t)row * PW + C_G + BR * 1024 + col);
                        if (BR == 1 || BR == 2) sv[mi][bj] = *(const u32x4*)(scr + off);
                    }
#pragma unroll
                for (int mi = 0; mi < 2; ++mi)
#pragma unroll
                    for (int bj = 0; bj < 2; ++bj) {
                        if (!((u.qm >> (ai * 2 + bj)) & 1)) continue;
                        const int m = 2 * mp + mi, row = row0 + ai * 128 + m * 16, col = colb + bj * 128; const size_t off = (size_t)row * D + col;
                        f32x4 v0 = acc[ai][bj][m][0], v1 = acc[ai][bj][m][1];
                        if (BR < 3) { const u32x4 g4 = gt[mi][bj];
                            v0[0] *= bflo(g4.x); v0[1] *= bfhi(g4.x); v0[2] *= bflo(g4.y); v0[3] *= bfhi(g4.y);
                            v1[0] *= bflo(g4.z); v1[1] *= bfhi(g4.z); v1[2] *= bflo(g4.w); v1[3] *= bfhi(g4.w); }
                        if (BR == 1 || BR == 2) { const u32x4 p4 = sv[mi][bj]; v0[0] += bflo(p4.x); v0[1] += bfhi(p4.x); v0[2] += bflo(p4.y); v0[3] += bfhi(p4.y); v1[0] += bflo(p4.z); v1[1] += bfhi(p4.z); v1[2] += bflo(p4.w); v1[3] += bfhi(p4.w); }
                        { u32x4 w; w.x = pk2(v0[0], v0[1]); w.y = pk2(v0[2], v0[3]); w.z = pk2(v1[0], v1[1]); w.w = pk2(v1[2], v1[3]); *(u32x4*)((BR == 2 ? merged : scr) + off) = w; }
                    }
                EPI_FENCE();
            }
        }
    }
    __device__ __forceinline__ void operator()(const f32x4 (&acc)[2][2][4][2], const Unit& u, int wr, int wc, int fr, int fq, const LAS float* rt) const {
        if (mode == 1) run<3>(acc, u, wr, wc, fr, fq);
        else if (u.kind == 0) run<0>(acc, u, wr, wc, fr, fq);
        else if (u.kind == 1) run<1>(acc, u, wr, wc, fr, fq);
        else run<2>(acc, u, wr, wc, fr, fq);
    }
};

struct Args { const float* in[29]; float* out; unsigned char* ws; int ph_lo, ph_hi; };
constexpr int NPH = 26;
constexpr int LDS_BYTES = 147456;

struct Ctx {
    const float* const* in; float* out; unsigned char* ws; LAS unsigned char* lds; unsigned char* ldsg; int tid, lane, wave, G, bx;
};

enum { MAP_ID = 0, MAP_SWIGLU = 1, MAP_WIN = 2 };
__device__ __forceinline__ int map_col(int mode, int n) {
    if (mode == MAP_ID) return n;
    if (mode == MAP_SWIGLU) { const int p = n >> 8, j = n & 255; return j < 128 ? p * 128 + j : FF + p * 128 + (j - 128); }
    if (n < 2048) return n;
    if (n < 2304) return 2064 + (n - 2048);
    if (n < 2560) return 2320 + (n - 2304);
    if (n < 5632) return 2576 + (n - 2560);
    if (n < 5648) return 2048 + (n - 5632);
    return -1;
}
__device__ __forceinline__ void tconv(const Ctx& c, const float* src, int ldsrc, int K, bf16_t* dst, int lddst, int Nout, int mode, const float* g, int& toff) {
    float* tile = (float*)c.ldsg;
    const int ntn = Nout / 64, ntk = K / 256, nt = ntn * ntk;
    const int first = (c.bx + c.G - (toff % c.G)) % c.G; toff += nt;
    for (int it = first; it < nt; it += c.G) {
        const int tn = it % ntn, tk = it / ntn, n0 = tn * 64, k0 = tk * 256;
        const int nn = c.tid & 63, sc = map_col(mode, n0 + nn), kq = c.tid >> 6;
        float v[32];
#pragma unroll
        for (int i = 0; i < 32; ++i) { const int kk = kq + 8 * i; v[i] = (sc >= 0) ? src[(size_t)(k0 + kk) * ldsrc + sc] : 0.f; }
        if (g) {
#pragma unroll
            for (int i = 0; i < 32; ++i) v[i] *= g[k0 + kq + 8 * i];
        }
#pragma unroll
        for (int i = 0; i < 32; ++i) tile[(kq + 8 * i) * 65 + nn] = v[i];
        __syncthreads();
        { const int n2 = c.tid >> 3, kg = c.tid & 7;
#pragma unroll
          for (int j = 0; j < 4; ++j) { const float* s = tile + (kg * 8 + 64 * j) * 65 + n2;
              u32x4 o; o.x = pk2(s[0], s[65]); o.y = pk2(s[130], s[195]); o.z = pk2(s[260], s[325]); o.w = pk2(s[390], s[455]);
              *(u32x4*)(dst + (size_t)(n0 + n2) * lddst + k0 + kg * 8 + 64 * j) = o; } }
        __syncthreads();
    }
}
__device__ __forceinline__ float wave_sum(float v) {
#pragma unroll
    for (int o = 1; o < 64; o <<= 1) v += __shfl_xor(v, o);
    return v;
}
__device__ __forceinline__ void prologue(const Ctx& c) {
    bf16_t* W = (bf16_t*)(c.ws + WS_W);
    int toff = 0;
    for (int l = 0; l < 2; ++l) {
        bf16_t* Wl = W + (size_t)l * WL_END;
        tconv(c, c.in[9] + (size_t)l * D * 2 * FF, 2 * FF, D, Wl + WL_1IN, D, 2 * FF, MAP_SWIGLU, c.in[8] + l * D, toff);
        tconv(c, c.in[10] + (size_t)l * FF * D, D, FF, Wl + WL_1OUT, FF, D, MAP_ID, nullptr, toff);
        tconv(c, c.in[12] + (size_t)l * D * INW, INW, D, Wl + WL_IN, D, NIN, MAP_WIN, c.in[11] + l * D, toff);
        tconv(c, c.in[18] + (size_t)l * 512 * D, D, 512, Wl + WL_BR, D, D, MAP_ID, nullptr, toff);
        tconv(c, c.in[19] + (size_t)l * 256 * D, D, 256, Wl + WL_BR + 512, D, D, MAP_ID, nullptr, toff);
        tconv(c, c.in[21] + (size_t)l * D * D, D, D, Wl + WL_OUT, D, D, MAP_ID, nullptr, toff);
        tconv(c, c.in[23] + (size_t)l * D * 2 * FF, 2 * FF, D, Wl + WL_2IN, D, 2 * FF, MAP_SWIGLU, c.in[22] + l * D, toff);
        tconv(c, c.in[24] + (size_t)l * FF * D, D, FF, Wl + WL_2OUT, FF, D, MAP_ID, nullptr, toff);
        tconv(c, c.in[26] + (size_t)l * D * D, D, D, Wl + WL_PG, D, D, MAP_ID, c.in[25] + l * D, toff);
        tconv(c, c.in[27] + (size_t)l * 256 * D, D, 256, Wl + WL_PP, 256, D, MAP_ID, nullptr, toff);
        const float* pw = c.in[16] + (size_t)l * 4 * 64 * 64; const float* psc = c.in[17] + l * 256; const float* wc = c.in[20] + (size_t)l * 256 * D;
        for (int idx = c.bx * 512 + c.tid; idx < 256 * 1024; idx += c.G * 512) {
            const int n = idx & 1023, kc = idx >> 10, gq = kc >> 6, cc = kc & 63; float s = 0.f;
            for (int dd = 0; dd < 64; ++dd) s += pw[(gq * 64 + cc) * 64 + dd] * psc[gq * 64 + dd] * wc[(size_t)(gq * 64 + dd) * D + n];
            Wl[WL_BR + (size_t)n * D + 768 + kc] = (bf16_t)f2bf(s);
        }
    }
    bf16_t* xb = (bf16_t*)(c.ws + WS_XB); float* ss0 = (float*)(c.ws + WS_SS);
    for (int row = c.bx * 8 + c.wave; row < M; row += c.G * 8) {
        const float* src = row < MP ? c.in[0] + (size_t)row * D : c.in[1] + (size_t)(row - MP) * D;
        f32x4 v[4]; float s = 0.f;
#pragma unroll
        for (int j = 0; j < 4; ++j) { v[j] = *(const f32x4*)(src + c.lane * 4 + 256 * j); s += (v[j][0] * v[j][0] + v[j][1] * v[j][1]) + (v[j][2] * v[j][2] + v[j][3] * v[j][3]); }
        s = wave_sum(s);
#pragma unroll
        for (int j = 0; j < 4; ++j) { u32x2 w; w.x = pk2(v[j][0], v[j][1]); w.y = pk2(v[j][2], v[j][3]); *(u32x2*)(xb + (size_t)row * D + c.lane * 4 + 256 * j) = w; }
        if (c.lane < 32) ss0[(size_t)row * 32 + c.lane] = c.lane == 0 ? s : 0.f;
    }
    bf16_t* pb = (bf16_t*)(c.ws + WS_PB);
#pragma unroll 4
    for (size_t i4 = (size_t)c.bx * 512 + c.tid; i4 < (size_t)2 * M * 64; i4 += (size_t)c.G * 512) {
        const size_t e = i4 * 4; const int l = (int)(e / ((size_t)M * 256)); const size_t r = e - (size_t)l * M * 256; const int row = (int)(r >> 8), cc = (int)(r & 255);
        const float* src = row < MP ? c.in[6] + ((size_t)l * MP + row) * 256 + cc : c.in[7] + ((size_t)l * 2048 + (row - MP)) * 256 + cc;
        const f32x4 v = *(const f32x4*)src; u32x2 w; w.x = pk2(v[0], v[1]); w.y = pk2(v[2], v[3]); *(u32x2*)(pb + e) = w;
    }
}

__device__ __forceinline__ int next_item(const Ctx& c, int slot) {
    volatile int* sh = (volatile int*)(c.ldsg + 147392);
    __syncthreads();
    if (c.tid == 0) *sh = (int)__hip_atomic_fetch_add((unsigned*)(c.ws + WS_CTL) + 64 * (1 + slot), 1u, __ATOMIC_RELAXED, __HIP_MEMORY_SCOPE_AGENT);
    __syncthreads();
    return *sh;
}
__device__ __forceinline__ void gla_local_unit(const Ctx& c, int l, int g, int h) {
    float* L = (float*)c.ldsg; float* rs = L; float* wg = L + 1024; float* bg = L + 1536; float* la = L + 1600; float* kt = L + 3712; float* vs = L + 5824;
    const bf16_t* proj = (const bf16_t*)(c.ws + WS_BIG); const int m0 = g * 64, tid = c.tid;
    { const int e = tid * 2, row = e >> 4, cc = e & 15; const unsigned w = *(const unsigned*)(proj + (size_t)(m0 + row) * PW + C_RB + cc); rs[e] = bflo(w); rs[e + 1] = bfhi(w); }
    { const int j = tid >> 5, d = tid & 31; wg[tid] = c.in[13][(size_t)(l * 16 + j) * 128 + h * 32 + d]; }
    if (tid < 32) bg[tid] = c.in[14][l * 128 + h * 32 + tid];
    __syncthreads();
#pragma unroll
    for (int i = 0; i < 4; ++i) { const int o = tid + 512 * i, t = o >> 5, d = o & 31; float a = bg[d];
#pragma unroll
        for (int j = 0; j < 16; ++j) a += rs[t * 16 + j] * wg[j * 32 + d];
        la[t * 33 + d] = (fminf(a, 0.f) - flog(1.0f + fexp(-fabsf(a)))) * (1.0f / 16.0f); }
    __syncthreads();
    {
#pragma unroll
        for (int j = 0; j < 4; ++j) { const int d = c.wave * 4 + j; float v = la[c.lane * 33 + d];
#pragma unroll
            for (int o = 1; o < 64; o <<= 1) { const float n = __shfl_up(v, o); if (c.lane >= o) v += n; }
            la[c.lane * 33 + d] = v; }
    }
    __syncthreads();
    float* bws = (float*)(c.ws + WS_B);
#pragma unroll
    for (int i = 0; i < 4; ++i) { const int o = tid + 512 * i, t = o >> 5, d = o & 31; const float b = la[t * 33 + d];
        bws[(size_t)(m0 + t) * 128 + h * 32 + d] = b;
        kt[t * 33 + d] = bf2f(proj[(size_t)(m0 + t) * PW + C_KB + h * 32 + d]) * fexp(-b); }
    { const int t = tid >> 3, e0 = (tid & 7) * 8; const u32x4 w = *(const u32x4*)(proj + (size_t)(m0 + t) * PW + C_VB + h * 64 + e0); float* d = vs + t * 64 + e0;
      d[0] = bflo(w.x); d[1] = bfhi(w.x); d[2] = bflo(w.y); d[3] = bfhi(w.y); d[4] = bflo(w.z); d[5] = bfhi(w.z); d[6] = bflo(w.w); d[7] = bfhi(w.w); }
    __syncthreads();
    { const int d = tid >> 4, e0 = (tid & 15) * 4; f32x4 a = {0.f, 0.f, 0.f, 0.f};
      for (int t = 0; t < 64; ++t) { const float kk = kt[t * 33 + d]; const f32x4 v = *(const f32x4*)(vs + t * 64 + e0); a = a + v * kk; }
      *(f32x4*)((float*)(c.ws + WS_DS) + ((size_t)(g * 4 + h) * 32 + d) * 64 + e0) = a; }
    if (tid < 32) ((float*)(c.ws + WS_DEC))[(size_t)(g * 4 + h) * 32 + tid] = fexp(la[63 * 33 + tid]);
    __syncthreads();
}
__device__ __forceinline__ void pool_unit(const Ctx& c, int l, int g) {
    float* ext = (float*)c.ldsg;
    const bf16_t* proj = (const bf16_t*)(c.ws + WS_BIG); bf16_t* Y = (bf16_t*)(c.ws + WS_Y);
    const int m0 = g * 64, tid = c.tid; const bool samp = g >= 512; const int cidx = samp ? 0 : (g & 127);
#pragma unroll
    for (int it = 0; it < 5; ++it) { const int q = tid + 512 * it;
        if (q < 79 * 32) { const int j = q >> 5, c8 = (q & 31) * 8; float* d = ext + j * 256 + c8;
            if (j >= 15 || cidx > 0) { const u32x4 w = *(const u32x4*)(proj + (size_t)(m0 + j - 15) * PW + C_UC + c8);
                *(f32x4*)d = (f32x4){bflo(w.x), bfhi(w.x), bflo(w.y), bfhi(w.y)}; *(f32x4*)(d + 4) = (f32x4){bflo(w.z), bfhi(w.z), bflo(w.w), bfhi(w.w)}; }
            else if (samp) { const float* sp = c.in[5] + ((size_t)(l * 32 + (g - 512)) * 15 + j) * 256 + c8; *(f32x4*)d = *(const f32x4*)sp; *(f32x4*)(d + 4) = *(const f32x4*)(sp + 4); }
            else { *(f32x4*)d = (f32x4){0.f, 0.f, 0.f, 0.f}; *(f32x4*)(d + 4) = (f32x4){0.f, 0.f, 0.f, 0.f}; } } }
    __syncthreads();
    { const int cc = tid & 255, ts = tid >> 8, gi = cc >> 6, w = 2 << gi;
      for (int i = 0; i < 32; ++i) { const int t = ts * 32 + i; float s = 0.f;
          for (int j = 0; j < w; ++j) s += ext[(15 + t - j) * 256 + cc];
          const int pos = samp ? 2048 + t : cidx * 64 + t; const float cnt = (float)min(w, pos + 1);
          const float dv = s / cnt - ext[(15 + t) * 256 + cc];
          Y[(size_t)(m0 + t) * D + 768 + cc] = (bf16_t)f2bf(dv); } }
    __syncthreads();
}

__device__ __forceinline__ void scan_unit(const Ctx& c, int l, int su) {
    const float* dS = (const float*)(c.ws + WS_DS); const float* dec = (const float*)(c.ws + WS_DEC); float* St = (float*)(c.ws + WS_ST);
    int g0, n, h, idx; float S; float* outp;
    if (su < 64) { const int bh = su >> 2, b = bh >> 2; h = bh & 3; idx = (su & 3) * 512 + c.tid; g0 = b * 128; n = 128; S = 0.f; outp = c.out + O_GP + ((size_t)(l * 4 + b) * 4 + h) * 2048 + idx; }
    else { const int s2 = su - 64, sbh = s2 >> 2, sb = sbh >> 2; h = sbh & 3; idx = (s2 & 3) * 512 + c.tid; g0 = 512 + sb; n = 1; S = c.in[4][((size_t)(l * 32 + sb) * 4 + h) * 2048 + idx]; outp = c.out + O_GS + ((size_t)(l * 32 + sb) * 4 + h) * 2048 + idx; }
    const int d = idx >> 6;
#pragma unroll 8
    for (int cc = 0; cc < n; ++cc) { const size_t gh = (size_t)(g0 + cc) * 4 + h; const float dd = dS[gh * 2048 + idx], de = dec[gh * 32 + d]; St[gh * 2048 + idx] = S; S = de * (S + dd); }
    *outp = S;
}
__device__ __forceinline__ void attn_unit(const Ctx& c, int l, int au) {
    bf16_t* Ks = (bf16_t*)c.ldsg; bf16_t* Vt = (bf16_t*)(c.ldsg + 18432); int* flags = (int*)(c.ldsg + 35840);
    const bf16_t* proj = (const bf16_t*)(c.ws + WS_BIG); bf16_t* Y = (bf16_t*)(c.ws + WS_Y);
    int R0, n_past, qb, hp, sb = 0;
    if (au < 2048) { const int b = au >> 9, rem = au & 511; qb = rem >> 2; hp = rem & 3; R0 = b * 8192; n_past = 0; }
    else { const int a2 = au - 2048; sb = a2 >> 2; hp = a2 & 3; qb = 0; R0 = MP + sb * 64; n_past = 2048; }
    const int tid = c.tid, w = c.wave, lane = c.lane, fr = lane & 15, fq = lane >> 4, hsel = w >> 2, hh = 2 * hp + hsel, qsub = w & 3;
    const int qrow = R0 + qb * 64 + qsub * 16 + fr, qpos = n_past + qb * 64 + qsub * 16 + fr;
    bf16x8 qf[2];
#pragma unroll
    for (int ks = 0; ks < 2; ++ks) qf[ks] = *(const bf16x8*)(proj + (size_t)qrow * PW + C_QA + hh * 64 + 32 * ks + 8 * fq);
    f32x4 O[4];
#pragma unroll
    for (int i = 0; i < 4; ++i) O[i] = (f32x4){0.f, 0.f, 0.f, 0.f};
    float carry = 0.f; bool wdone = false;
    int kt = (n_past + qb * 64) >> 6;
    const int lh = tid >> 8, lj = (tid >> 2) & 63, d0 = (tid & 3) * 16, lhead = 2 * hp + lh;
    for (;;) {
        {
            const int kpos = kt * 64 + lj; unsigned kk[8], vv[8];
            if (kpos < n_past) {
                const size_t o = (((size_t)(l * 32 + sb) * 2048 + kpos) * 512) + lhead * 64 + d0; const float* kp = c.in[2] + o; const float* vp = c.in[3] + o;
#pragma unroll
                for (int i = 0; i < 4; ++i) { const f32x4 a = *(const f32x4*)(kp + 4 * i), b = *(const f32x4*)(vp + 4 * i); kk[2 * i] = pk2(a[0], a[1]); kk[2 * i + 1] = pk2(a[2], a[3]); vv[2 * i] = pk2(b[0], b[1]); vv[2 * i + 1] = pk2(b[2], b[3]); }
            } else {
                const bf16_t* rp = proj + (size_t)(R0 + kpos - n_past) * PW + lhead * 64 + d0;
                const u32x4 a0 = *(const u32x4*)(rp + C_KA), a1 = *(const u32x4*)(rp + C_KA + 8), b0 = *(const u32x4*)(rp + C_VA), b1 = *(const u32x4*)(rp + C_VA + 8);
                kk[0] = a0.x; kk[1] = a0.y; kk[2] = a0.z; kk[3] = a0.w; kk[4] = a1.x; kk[5] = a1.y; kk[6] = a1.z; kk[7] = a1.w;
                vv[0] = b0.x; vv[1] = b0.y; vv[2] = b0.z; vv[3] = b0.w; vv[4] = b1.x; vv[5] = b1.y; vv[6] = b1.z; vv[7] = b1.w;
            }
            bf16_t* kd = Ks + (lh * 64 + lj) * 72 + d0;
            *(u32x4*)kd = (u32x4){kk[0], kk[1], kk[2], kk[3]}; *(u32x4*)(kd + 8) = (u32x4){kk[4], kk[5], kk[6], kk[7]};
#pragma unroll
            for (int i = 0; i < 8; ++i) { Vt[(lh * 64 + d0 + 2 * i) * 68 + lj] = (bf16_t)(vv[i] & 0xffffu); Vt[(lh * 64 + d0 + 2 * i + 1) * 68 + lj] = (bf16_t)(vv[i] >> 16); }
        }
        __syncthreads();
        {
            f32x4 sa[4];
#pragma unroll
            for (int u = 0; u < 4; ++u) { sa[u] = (f32x4){0.f, 0.f, 0.f, 0.f};
#pragma unroll
                for (int ks = 0; ks < 2; ++ks) { const bf16x8 kf = *(const bf16x8*)(Ks + (hsel * 64 + 16 * u + fr) * 72 + 32 * ks + 8 * fq); sa[u] = __builtin_amdgcn_mfma_f32_16x16x32_bf16(kf, qf[ks], sa[u], 0, 0, 0); } }
            float lk[4][4], lw[4][4], ls[4], suf[4], T[4];
#pragma unroll
            for (int u = 0; u < 4; ++u) { ls[u] = 0.f;
#pragma unroll
                for (int i = 0; i < 4; ++i) { const float z = sa[u][i] * 0.125f; const int kpos = kt * 64 + 16 * u + 4 * fq + i; const bool valid = kpos < qpos;
                    const float sp = softplus(z); lk[u][i] = valid ? -sp : 0.f; lw[u][i] = valid ? (z - sp) : -1e30f; ls[u] += lk[u][i]; } }
#pragma unroll
            for (int u = 0; u < 4; ++u) { const float a = __shfl_xor(ls[u], 16), t1 = ls[u] + a, o = __shfl_xor(t1, 32); T[u] = t1 + o; suf[u] = ((fq & 1) ? 0.f : a) + ((fq & 2) ? 0.f : o); }
            float base = carry; float wv[4][4];
#pragma unroll
            for (int u = 3; u >= 0; --u) { float run = base + suf[u];
#pragma unroll
                for (int i = 3; i >= 0; --i) { wv[u][i] = fexp(lw[u][i] + run); run += lk[u][i]; }
                base += T[u]; }
            carry = base;
#pragma unroll
            for (int k2 = 0; k2 < 2; ++k2) {
                u32x4 pw; pw.x = pk2(wv[2 * k2][0], wv[2 * k2][1]); pw.y = pk2(wv[2 * k2][2], wv[2 * k2][3]); pw.z = pk2(wv[2 * k2 + 1][0], wv[2 * k2 + 1][1]); pw.w = pk2(wv[2 * k2 + 1][2], wv[2 * k2 + 1][3]);
                const bf16x8 pf = __builtin_bit_cast(bf16x8, pw);
#pragma unroll
                for (int db = 0; db < 4; ++db) { const bf16_t* vp = Vt + (hsel * 64 + 16 * db + fr) * 68 + 32 * k2 + 4 * fq; const u32x2 lo = *(const u32x2*)vp, hi = *(const u32x2*)(vp + 16);
                    const bf16x8 vf = __builtin_bit_cast(bf16x8, (u32x4){lo.x, lo.y, hi.x, hi.y}); O[db] = __builtin_amdgcn_mfma_f32_16x16x32_bf16(vf, pf, O[db], 0, 0, 0); }
            }
            wdone = __all(carry < -46.f) != 0;
        }
        --kt;
        if (lane == 0) flags[w] = wdone ? 1 : 0;
        __syncthreads();
        int alld = 1;
#pragma unroll
        for (int i = 0; i < 8; ++i) alld &= flags[i];
        if (alld || kt < 0) break;
    }
#pragma unroll
    for (int db = 0; db < 4; ++db) { u32x2 o; o.x = pk2(O[db][0], O[db][1]); o.y = pk2(O[db][2], O[db][3]); *(u32x2*)(Y + (size_t)qrow * D + hh * 64 + 16 * db + 4 * fq) = o; }
    __syncthreads();
}

__device__ __forceinline__ void gla_out_unit(const Ctx& c, int l, int g, int h) {
    float* L = (float*)c.ldsg; float* qs = L; float* ktT = L + 2112; float* vs = L + 4288; float* sc = L + 8640; float* Ss = L + 12800;
    const bf16_t* proj = (const bf16_t*)(c.ws + WS_BIG); bf16_t* Y = (bf16_t*)(c.ws + WS_Y); const float* bws = (const float*)(c.ws + WS_B);
    const int m0 = g * 64, tid = c.tid;
#pragma unroll
    for (int i = 0; i < 4; ++i) { const int o = tid + 512 * i, t = o >> 5, d = o & 31; const float b = bws[(size_t)(m0 + t) * 128 + h * 32 + d];
        const bf16_t* pr = proj + (size_t)(m0 + t) * PW + h * 32 + d;
        qs[t * 33 + d] = bf2f(pr[C_QB]) * 0.17677669529663687f * fexp(b); ktT[d * 68 + t] = bf2f(pr[C_KB]) * fexp(-b);
        Ss[o] = ((const float*)(c.ws + WS_ST))[(size_t)(g * 4 + h) * 2048 + o]; }
    { const int t = tid >> 3, e0 = (tid & 7) * 8; const u32x4 w = *(const u32x4*)(proj + (size_t)(m0 + t) * PW + C_VB + h * 64 + e0); float* d = vs + t * 68 + e0;
      d[0] = bflo(w.x); d[1] = bfhi(w.x); d[2] = bflo(w.y); d[3] = bfhi(w.y); d[4] = bflo(w.z); d[5] = bfhi(w.z); d[6] = bflo(w.w); d[7] = bfhi(w.w); }
    __syncthreads();
    const int t = tid >> 3, g8 = (tid & 7) * 8;
    { float a[8];
#pragma unroll
      for (int j = 0; j < 8; ++j) a[j] = 0.f;
      for (int d = 0; d < 32; ++d) { const float q = qs[t * 33 + d]; const f32x4 k0 = *(const f32x4*)(ktT + d * 68 + g8), k1 = *(const f32x4*)(ktT + d * 68 + g8 + 4);
#pragma unroll
          for (int j = 0; j < 4; ++j) { a[j] += q * k0[j]; a[4 + j] += q * k1[j]; } }
#pragma unroll
      for (int j = 0; j < 8; ++j) sc[t * 65 + g8 + j] = (g8 + j <= t) ? a[j] : 0.f; }
    __syncthreads();
    { float o[8];
#pragma unroll
      for (int j = 0; j < 8; ++j) o[j] = 0.f;
      for (int s = 0; s <= t; ++s) { const float p = sc[t * 65 + s]; const f32x4 v0 = *(const f32x4*)(vs + s * 68 + g8), v1 = *(const f32x4*)(vs + s * 68 + g8 + 4);
#pragma unroll
          for (int j = 0; j < 4; ++j) { o[j] += p * v0[j]; o[4 + j] += p * v1[j]; } }
      for (int d = 0; d < 32; ++d) { const float q = qs[t * 33 + d]; const f32x4 s0 = *(const f32x4*)(Ss + d * 64 + g8), s1 = *(const f32x4*)(Ss + d * 64 + g8 + 4);
#pragma unroll
          for (int j = 0; j < 4; ++j) { o[j] += q * s0[j]; o[4 + j] += q * s1[j]; } }
      float q2 = 0.f;
#pragma unroll
      for (int j = 0; j < 8; ++j) q2 += o[j] * o[j];
      q2 += __shfl_xor(q2, 1); q2 += __shfl_xor(q2, 2); q2 += __shfl_xor(q2, 4);
      const float r = __builtin_amdgcn_rsqf(q2 * (1.0f / 64.0f) + EPS);
      const u32x4 ow = *(const u32x4*)(proj + (size_t)(m0 + t) * PW + C_OB + h * 64 + g8);
      float ob[8] = {bflo(ow.x), bfhi(ow.x), bflo(ow.y), bfhi(ow.y), bflo(ow.z), bfhi(ow.z), bflo(ow.w), bfhi(ow.w)};
      const float* gn = c.in[15] + l * 256 + h * 64 + g8; float y[8];
#pragma unroll
      for (int j = 0; j < 8; ++j) y[j] = o[j] * r * gn[j] * (ob[j] * sigm(ob[j]));
      u32x4 w; w.x = pk2(y[0], y[1]); w.y = pk2(y[2], y[3]); w.z = pk2(y[4], y[5]); w.w = pk2(y[6], y[7]);
      *(u32x4*)(Y + (size_t)(m0 + t) * D + 512 + h * 64 + g8) = w; }
    __syncthreads();
}

__device__ __forceinline__ void grid_bar(unsigned* ctl, unsigned r) {
    asm volatile("s_waitcnt vmcnt(0)" ::: "memory");
    __syncthreads();
    if (threadIdx.x == 0) {
        const unsigned g = blockIdx.x & 7u, G = gridDim.x, nloc = (G - g + 7u) >> 3, ngrp = G < 8u ? G : 8u;
        unsigned* cnt = ctl + 64 * (16 + g); unsigned* gen = ctl + 64 * (24 + g); unsigned* top = ctl + 64 * 32;
        __builtin_amdgcn_fence(__ATOMIC_RELEASE, "agent");
        asm volatile("s_waitcnt vmcnt(0)" ::: "memory");
        const unsigned old = __hip_atomic_fetch_add(cnt, 1u, __ATOMIC_RELAXED, __HIP_MEMORY_SCOPE_AGENT);
        if (old + 1u == r * nloc) {
            __hip_atomic_fetch_add(top, 1u, __ATOMIC_RELAXED, __HIP_MEMORY_SCOPE_AGENT);
            while (__hip_atomic_load(top, __ATOMIC_RELAXED, __HIP_MEMORY_SCOPE_AGENT) < r * ngrp) __builtin_amdgcn_s_sleep(1);
            __hip_atomic_store(gen, r, __ATOMIC_RELAXED, __HIP_MEMORY_SCOPE_AGENT);
        } else {
            while (__hip_atomic_load(gen, __ATOMIC_RELAXED, __HIP_MEMORY_SCOPE_AGENT) < r) __builtin_amdgcn_s_sleep(1);
        }
        __builtin_amdgcn_fence(__ATOMIC_ACQUIRE, "agent");
        asm volatile("s_waitcnt vmcnt(0)" ::: "memory");
    }
    __syncthreads();
}

__global__ void __launch_bounds__(512, 2) fwd_mega(Args args) {
    extern __shared__ __attribute__((aligned(16))) unsigned char lds[];
    cg::grid_group grid = cg::this_grid();
    Ctx c; c.in = args.in; c.out = args.out; c.ws = args.ws; c.lds = (LAS unsigned char*)lds; c.ldsg = lds;
    c.tid = threadIdx.x; c.lane = c.tid & 63; c.wave = __builtin_amdgcn_readfirstlane(c.tid >> 6); c.G = gridDim.x; c.bx = blockIdx.x;
    for (int ph = args.ph_lo; ph < args.ph_hi; ++ph) {
        { int t_ = threadIdx.x; asm volatile("" : "+v"(t_)); c.tid = t_; c.lane = t_ & 63; c.wave = __builtin_amdgcn_readfirstlane(t_ >> 6); }
        unsigned char* ws = args.ws; float* outp = args.out; asm volatile("" : "+s"(ws), "+s"(outp)); c.ws = ws; c.out = outp;
        bf16_t* xb = (bf16_t*)(ws + WS_XB); bf16_t* big = (bf16_t*)(ws + WS_BIG); bf16_t* Yb = (bf16_t*)(ws + WS_Y); bf16_t* mg = (bf16_t*)(ws + WS_MG);
        float* scr = (float*)(ws + WS_SCR); float* ss0 = (float*)(ws + WS_SS); float* ss1 = ss0 + (size_t)M * 32; float* xw = outp + O_Y;
        if (ph == 0) prologue(c);
        else if (ph == 25) {
            const float* gf = args.in[28];
            for (int row = c.bx * 8 + c.wave; row < M; row += c.G * 8) { const float rs = rstd_of(ss0, row);
#pragma unroll
                for (int j = 0; j < 4; ++j) { float* p = xw + (size_t)row * D + c.lane * 4 + 256 * j; const f32x4 v = *(const f32x4*)p, gg = *(const f32x4*)(gf + c.lane * 4 + 256 * j); *(f32x4*)p = v * rs * gg; } }
        } else {
            const int l = (ph - 1) / 12, k = (ph - 1) % 12;
            if ((MK_SKIPMASK >> k) & 1) continue;
            const bf16_t* Wl = (const bf16_t*)(ws + WS_W) + (size_t)l * WL_END;
            if (k == 0 || k == 8) {
                pg8::Gemm g{(k == 0 && l > 0) ? mg : xb, Wl + (k == 0 ? WL_1IN : WL_2IN), D, D}; pg8::Sched S;     S.init(M, 2 * FF, c.G, c.bx, 16);
                EpiSwiglu E{big}; pg8::gemm_phase(c.lds, c.tid, g, S, E, ss0);
            } else if (k == 1 || k == 9 || k == 7 || k == 11) {
                pg8::Gemm g; pg8::Sched S; EpiRes E{xw, xb, nullptr, (const bf16_t*)scr, 1.f, 0, nullptr, nullptr}; const float* ssin = nullptr;
                if (k == 1 || k == 9) { g = pg8::Gemm{big, Wl + (k == 1 ? WL_1OUT : WL_2OUT), FF, FF}; S.init(M, D, c.G, c.bx, 44); S.quart = 1; E.alpha = 0.5f; E.ss_out = ss1; if (l == 0 && k == 1) { E.xin0 = args.in[0]; E.xin1 = args.in[1]; } }
                else if (k == 7) { g = pg8::Gemm{mg, Wl + WL_OUT, D, D}; S.init(M, D, c.G, c.bx, 16); S.quart = 1; E.ss_out = ss0; }
                else { g = pg8::Gemm{xb, Wl + WL_PG, D, D}; S.init(M, D, c.G, c.bx, 16); S.quart = 1; E.ss_out = ss0; ssin = ss1; E.mode = 1; E.xb = mg; }
                pg8::gemm_phase(c.lds, c.tid, g, S, E, ssin);
            } else if (k == 2) {
                pg8::Gemm g{xb, Wl + WL_IN, D, D}; pg8::Sched S; S.init(M, NIN, c.G, c.bx, 16); S.quart = 1;
                EpiWin E{big, outp, l}; pg8::gemm_phase(c.lds, c.tid, g, S, E, ss1);
            } else if (k == 3) {
                for (int it = next_item(c, l * 3 + 0); it < 2176 + NCH; it = next_item(c, l * 3 + 0)) { if (it < NCH) pool_unit(c, l, it); else gla_local_unit(c, l, (it - NCH) >> 2, (it - NCH) & 3); }
            } else if (k == 4) {
                for (int it = next_item(c, l * 3 + 1); it < 576 + 2176; it = next_item(c, l * 3 + 1)) { if (it < 576) scan_unit(c, l, it); else attn_unit(c, l, it - 576); }
            } else if (k == 5) {
                for (int it = next_item(c, l * 3 + 2); it < 2176; it = next_item(c, l * 3 + 2)) gla_out_unit(c, l, it >> 2, it & 3);
            } else {
                pg8::Gemm g; pg8::Sched S; EpiBranch E{big, (bf16_t*)scr, mg, 0};
                if (k == 6) { g = pg8::Gemm{Yb, Wl + WL_BR, D, D}; S.init(M, D, c.G, c.bx, 8); S.nsub = 3; S.quart = 1; }
                else { g = pg8::Gemm{(const bf16_t*)(ws + WS_PB) + (size_t)l * M * 256, Wl + WL_PP, 256, 256}; S.init(M, D, c.G, c.bx, 4); S.quart = 1; E.mode = 1; }
                pg8::gemm_phase(c.lds, c.tid, g, S, E, nullptr);
            }
        }
        if (ph + 1 < args.ph_hi) { if (args.ph_hi > 4096) grid.sync(); grid_bar((unsigned*)(args.ws + WS_CTL), (unsigned)(ph - args.ph_lo + 1)); }
    }
}

extern "C" void kernel_launch(void* const* d_in, const int* in_sizes, int n_in, void* d_out, int out_size, void* d_ws, size_t ws_size, hipStream_t stream) {
    static int grid = 0;
    if (grid == 0) {
        if (n_in != 29 || ws_size < WS_NEED) { fprintf(stderr, "kernel_launch: unexpected n_in %d / ws %zu\n", n_in, ws_size); grid = -1; return; }
        int dev = 0, cus = 0, per_cu = 0;
        (void)hipGetDevice(&dev); (void)hipDeviceGetAttribute(&cus, hipDeviceAttributeMultiprocessorCount, dev);
        (void)hipFuncSetAttribute((const void*)fwd_mega, hipFuncAttributeMaxDynamicSharedMemorySize, LDS_BYTES);
        (void)hipOccupancyMaxActiveBlocksPerMultiprocessor(&per_cu, (const void*)fwd_mega, 512, LDS_BYTES);
        (void)hipGetLastError();
        if (per_cu < 1) per_cu = 1;
        grid = cus;
    }
    if (grid < 0) return;
    (void)hipMemsetAsync((char*)d_ws + WS_CTL, 0, 16384, stream);
    Args a{};
    for (int i = 0; i < 29; ++i) a.in[i] = (const float*)d_in[i];
    a.out = (float*)d_out; a.ws = (unsigned char*)d_ws;
#if MK_ONE_LAUNCH
    a.ph_lo = 0; a.ph_hi = NPH;
    void* kargs[] = {&a};
    hipError_t e = hipLaunchCooperativeKernel((const void*)fwd_mega, dim3(grid), dim3(512), kargs, LDS_BYTES, stream);
    if (e != hipSuccess) fprintf(stderr, "cooperative launch failed: %s (grid %d)\n", hipGetErrorString(e), grid);
#else
    for (int ph = 0; ph < NPH; ++ph) { a.ph_lo = ph; a.ph_hi = ph + 1; hipLaunchKernelGGL(fwd_mega, dim3(grid), dim3(512), LDS_BYTES, stream, a); }
#endif
}
```

```cpp
#include <hip/hip_runtime.h>
#include <hip/hip_cooperative_groups.h>
#include <cstdio>
#include <cstdint>
namespace cg = cooperative_groups;

#ifndef MK_SKIPMASK
#define MK_SKIPMASK 0
#endif
#ifndef MK_NOATTN
#define MK_NOATTN 0
#endif
#ifndef MK_NOGLAOUT
#define MK_NOGLAOUT 0
#endif
#ifndef MK_ONE_LAUNCH
#define MK_ONE_LAUNCH 1
#endif

#define LAS __attribute__((address_space(3)))
typedef unsigned short bf16_t;
typedef short bf16x8 __attribute__((ext_vector_type(8)));
typedef float f32x4 __attribute__((ext_vector_type(4)));
typedef unsigned u32x4 __attribute__((ext_vector_type(4)));
typedef unsigned u32x2 __attribute__((ext_vector_type(2)));

constexpr int M = 34816;
constexpr int MP = 32768;
constexpr int D = 1024, FF = 2816, NIN = 5888, PW = 5888  , INW = 5648;
constexpr int NCH = 544;
constexpr float EPS = 1e-6f;
constexpr size_t O_Y = 0, O_KP = 35651584, O_VP = 69206016, O_GP = 102760448, O_PP = 102825984, O_KS = 102856704, O_VS = 104953856, O_GS = 107051008, O_PS = 107575296;
constexpr int C_QA = 0, C_KA = 512, C_VA = 1024, C_QB = 1536, C_KB = 1664, C_VB = 1792, C_OB = 2048, C_UC = 2304, C_G = 2560, C_RB = 5632;

constexpr size_t WL_1IN = 0, WL_1OUT = WL_1IN + (size_t)5632 * 1024, WL_IN = WL_1OUT + (size_t)1024 * 2816, WL_BR = WL_IN + (size_t)5888 * 1024, WL_OUT = WL_BR + 1048576,
                 WL_2IN = WL_OUT + 1048576, WL_2OUT = WL_2IN + (size_t)5632 * 1024, WL_PG = WL_2OUT + (size_t)1024 * 2816, WL_PP = WL_PG + 1048576, WL_END = WL_PP + 262144;
constexpr size_t MiB = 1u << 20;
constexpr size_t WS_W = 0;
constexpr size_t WS_XB = 104 * MiB;
constexpr size_t WS_PB = 172 * MiB;
constexpr size_t WS_BIG = 208 * MiB;
constexpr size_t WS_Y = 600 * MiB;
constexpr size_t WS_MG = 668 * MiB;
constexpr size_t WS_SCR = 736 * MiB;
constexpr size_t WS_SS = 934 * MiB;
constexpr size_t WS_DS = 878 * MiB;
constexpr size_t WS_ST = 896 * MiB;
constexpr size_t WS_B = 914 * MiB;
constexpr size_t WS_DEC = 932 * MiB;
constexpr size_t WS_CTL = 933 * MiB;
constexpr size_t WS_NEED = 944 * MiB;
static_assert(2 * WL_END * 2 <= 104 * MiB, "weights fit");

__device__ __forceinline__ unsigned f2bf(float f) { unsigned u = __builtin_bit_cast(unsigned, f); return (u + 0x7fffu + ((u >> 16) & 1u)) >> 16; }
__device__ __forceinline__ unsigned pk2(float lo, float hi) { unsigned r; asm("v_cvt_pk_bf16_f32 %0, %1, %2" : "=v"(r) : "v"(lo), "v"(hi)); return r; }
__device__ __forceinline__ float bflo(unsigned u) { return __uint_as_float(u << 16); }
__device__ __forceinline__ float bfhi(unsigned u) { return __uint_as_float(u & 0xffff0000u); }
__device__ __forceinline__ float bf2f(bf16_t b) { return __uint_as_float((unsigned)b << 16); }
__device__ __forceinline__ float fexp(float x) { return __builtin_amdgcn_exp2f(x * 1.4426950408889634f); }
__device__ __forceinline__ float flog(float x) { return __builtin_amdgcn_logf(x) * 0.6931471805599453f; }
__device__ __forceinline__ float sigm(float x) { return __builtin_amdgcn_rcpf(1.0f + fexp(-x)); }
__device__ __forceinline__ float softplus(float z) { return fmaxf(z, 0.f) + flog(1.0f + fexp(-fabsf(z))); }
__device__ __forceinline__ float rstd_of(const float* ss, int row) {
    const f32x4* p = (const f32x4*)(ss + (size_t)row * 32);
    float s = 0.f;
#pragma unroll
    for (int i = 0; i < 8; ++i) { const f32x4 a = p[i]; s += (a[0] + a[1]) + (a[2] + a[3]); }
    return __builtin_amdgcn_rsqf(s * (1.0f / 1024.0f) + EPS);
}

namespace pg8 {
constexpr int BM = 256, BK = 64, HALF = 128, HTB = HALF * BK * 2, STAGE_BYTES = 8 * HTB, NXCD = 8, WGM = 8;
__host__ __device__ __forceinline__ int lds_byte(int r, int c) { const int st = (r >> 4) * 2 + (c >> 5), rr = r & 15, cc = c & 31, ob = rr * 64 + cc * 2; return st * 1024 + (ob ^ (((ob >> 9) & 1) << 5)); }
__host__ __device__ __forceinline__ void stage_rc(int b, int& R, int& C) { const int st = b / 1024, sb = b % 1024, swz = sb ^ (((sb >> 9) & 1) << 5); R = (st >> 1) * 16 + swz / 64; C = (st & 1) * 32 + (swz % 64) / 2; }
__host__ __device__ __forceinline__ int perm32(int rho) { const int n = rho >> 4, i = rho & 15; return 8 * (i >> 2) + 4 * n + (i & 3); }

struct Unit { int pm, pn, kind, k0, nt, qm; };
struct Gemm { const bf16_t* A; const bf16_t* Bt; int lda, ldb; };

struct Sched {
    int nM, nN, nwg, G, c, nsub, nt0, quart;
    __device__ __forceinline__ void init(int M_, int N_, int G_, int c_, int nt) { nM = M_ / BM; nN = N_ / BM; nwg = nM * nN; G = G_; c = c_; nsub = 1; nt0 = nt; quart = 0; }
    __device__ __forceinline__ bool next(int i, Unit& u) const {
        const int ti = i / nsub, sk = i - ti * nsub;
        long L = (long)ti * G + c; int qm = 0xF;
        const int nfull = nwg / G;
        if (quart && ti >= nfull) {
            const long li = (long)(ti - nfull) * G + c; if (li >= 4L * (nwg - nfull * G)) return false;
            L = (long)nfull * G + (li >> 2); qm = 1 << (int)(li & 3);
        } else if (L >= nwg) return false;
        u.qm = qm;
        int wgid = (int)L; { const int q = nwg / NXCD, r = nwg % NXCD, xcd = wgid % NXCD, off = wgid / NXCD; wgid = (xcd < r ? xcd * (q + 1) : r * (q + 1) + (xcd - r) * q) + off; }
        const int nig = WGM * nN, gid = wgid / nig, fm = gid * WGM, gsz = (nM - fm) < WGM ? (nM - fm) : WGM;
        u.pm = fm + ((wgid % nig) % gsz); u.pn = (wgid % nig) / gsz; u.kind = sk; u.k0 = (sk > 0) ? 256 + 256 * sk : 0; u.nt = (sk > 0) ? 4 : nt0; return true;
    }
};

#define PG8_KLOOP(C0, C1, C2, C3) \
        for (int t = 0; t < nt; t += 2) { \
            const bool last = (t == nt - 2); \
            const char* a1 = cA + (size_t)(t + 1) * kstep; \
            const char* a2 = last ? nA : cA + (size_t)(t + 2) * kstep; const char* b2 = last ? nB : cB + (size_t)(t + 2) * kstep; \
            const char* a3 = a2 + kstep; const char* b3 = b2 + kstep; \
            PG8_LDB(B0, 0, 0); PG8_LDB(B1, 0, 1); PG8_SCHED; PG8_LDA(At, 0, 0); PG8_STAGE(PG8_SA(1, 1), a1 + hstepA, voffA); \
            PG8_WAIT_V(8); PG8_WAIT_L(0); PG8_BAR; if (C0) PG8_MMA(0, 0, At, B0); if (C1) PG8_MMA(0, 1, At, B1); PG8_BAR; PG8_SCHED; \
            PG8_LDA(At, 0, 1); PG8_STAGE(PG8_SB(0, 0), b2, voffB); PG8_STAGE(PG8_SB(0, 1), b2 + hstepB, voffB); PG8_STAGE(PG8_SA(0, 0), a2, voffA); \
            PG8_WAIT_V(8); PG8_WAIT_L(0); PG8_BAR; if (C2) PG8_MMA(1, 0, At, B0); if (C3) PG8_MMA(1, 1, At, B1); PG8_BAR; PG8_SCHED; \
            PG8_LDB(B0, 1, 0); PG8_LDB(B1, 1, 1); PG8_SCHED; PG8_LDA(At, 1, 0); PG8_STAGE(PG8_SA(0, 1), a2 + hstepA, voffA); \
            PG8_WAIT_V(8); PG8_WAIT_L(0); PG8_BAR; if (C0) PG8_MMA(0, 0, At, B0); if (C1) PG8_MMA(0, 1, At, B1); PG8_BAR; PG8_SCHED; \
            PG8_LDA(At, 1, 1); PG8_STAGE(PG8_SB(1, 0), b3, voffB); PG8_STAGE(PG8_SB(1, 1), b3 + hstepB, voffB); PG8_STAGE(PG8_SA(1, 0), a3, voffA); \
            PG8_WAIT_V(8); PG8_WAIT_L(0); PG8_BAR; if (C2) PG8_MMA(1, 0, At, B0); if (C3) PG8_MMA(1, 1, At, B1); PG8_BAR; PG8_SCHED; \
        }
template <class Epi, class Sch>
__device__ __forceinline__ void gemm_phase(LAS unsigned char* lds, const int tid, const Gemm g, const Sch& S, const Epi& E, const float* ss) {
    const int wid = __builtin_amdgcn_readfirstlane(tid >> 6), lane = tid & 63, wr = wid >> 2, wc = wid & 3, fr = lane & 15, fq = lane >> 4;
    unsigned voffA[2], voffB[2];
#pragma unroll
    for (int i = 0; i < 2; ++i) { int R, C; stage_rc(tid * 16 + i * 8192, R, C); const int Rb = (R & ~31) + perm32(R & 31);
        voffA[i] = (unsigned)(R * g.lda + C) * 2u; voffB[i] = (unsigned)(Rb * g.ldb + C) * 2u; }
    const size_t kstep = (size_t)(BK * 2);
    const size_t hstepA = (size_t)HALF * g.lda * 2, hstepB = (size_t)HALF * g.ldb * 2;
    const size_t tstepA = 2 * hstepA, tstepB = 2 * hstepB;
    const unsigned ldsw = (unsigned)wid * 1024u;
    const int aoff = lds_byte(wr * 64 + fr, fq * 8), boff = lds_byte(wc * 32 + fr, fq * 8);
    LAS float* rtab = (LAS float*)(lds + STAGE_BYTES);
    f32x4 rt_a = {0.f, 0.f, 0.f, 0.f}, rt_b = rt_a, rt_c = rt_a, rt_d = rt_a;
#define PG8_RTAB_LOAD(pm_) do { if (ss) { const f32x4* p_ = (const f32x4*)(ss + ((size_t)(pm_) * 256 + (tid >> 1)) * 32 + (tid & 1) * 16); rt_a = p_[0]; rt_b = p_[1]; rt_c = p_[2]; rt_d = p_[3]; } } while (0)
#define PG8_RTAB_FIN(buf_) do { if (ss) { float s_ = (((rt_a[0] + rt_a[1]) + (rt_a[2] + rt_a[3])) + ((rt_b[0] + rt_b[1]) + (rt_b[2] + rt_b[3]))) + (((rt_c[0] + rt_c[1]) + (rt_c[2] + rt_c[3])) + ((rt_d[0] + rt_d[1]) + (rt_d[2] + rt_d[3]))); \
        s_ += __shfl_xor(s_, 1); if (!(tid & 1)) rtab[(buf_) * 256 + (tid >> 1)] = __builtin_amdgcn_rsqf(s_ * (1.0f / 1024.0f) + EPS); } } while (0)
#define PG8_SA(b, h) (((b) * 2 + (h)) * HTB)
#define PG8_SB(b, h) ((4 + (b) * 2 + (h)) * HTB)
#define PG8_STAGE(bufoff, gbase, voff) do { _Pragma("unroll") for (int _i = 0; _i < 2; ++_i) \
        __builtin_amdgcn_global_load_lds((const unsigned*)((const char*)(gbase) + (voff)[_i]), (LAS unsigned*)(lds + (bufoff) + ldsw + _i * 8192), 16, 0, 0); } while (0)
#define PG8_LDA(dst, b, h) do { _Pragma("unroll") for (int m = 0; m < 4; ++m) _Pragma("unroll") for (int k = 0; k < 2; ++k) dst[m][k] = *(const LAS bf16x8*)(lds + PG8_SA(b, h) + aoff + m * 2048 + k * 1024); } while (0)
#define PG8_LDB(dst, b, h) do { _Pragma("unroll") for (int n = 0; n < 2; ++n) _Pragma("unroll") for (int k = 0; k < 2; ++k) dst[n][k] = *(const LAS bf16x8*)(lds + PG8_SB(b, h) + boff + n * 2048 + k * 1024); } while (0)
#define PG8_MMA(ai, bj, At, Bt) do { __builtin_amdgcn_s_setprio(1); _Pragma("unroll") for (int m = 0; m < 4; ++m) _Pragma("unroll") for (int n = 0; n < 2; ++n) _Pragma("unroll") for (int k = 0; k < 2; ++k) \
        acc[ai][bj][m][n] = __builtin_amdgcn_mfma_f32_16x16x32_bf16(Bt[n][k], At[m][k], acc[ai][bj][m][n], 0, 0, 0); __builtin_amdgcn_s_setprio(0); } while (0)
#define PG8_WAIT_V(n) asm volatile("s_waitcnt vmcnt(" #n ")" ::: "memory")
#define PG8_WAIT_L(n) asm volatile("s_waitcnt lgkmcnt(" #n ")" ::: "memory")
#define PG8_BAR __builtin_amdgcn_s_barrier()
#define PG8_SCHED __builtin_amdgcn_sched_barrier(0)
    Unit cur, nxt; int ui = 0;
    if (!S.next(0, cur)) return;
    f32x4 acc[2][2][4][2];
#pragma unroll
    for (int a = 0; a < 2; ++a)
#pragma unroll
        for (int b = 0; b < 2; ++b)
#pragma unroll
            for (int m = 0; m < 4; ++m)
#pragma unroll
                for (int n = 0; n < 2; ++n) acc[a][b][m][n] = (f32x4){0.f, 0.f, 0.f, 0.f};
    bf16x8 At[4][2], B0[2][2], B1[2][2];
    const char* cA = (const char*)g.A + (size_t)cur.pm * tstepA + (size_t)cur.k0 * 2; const char* cB = (const char*)g.Bt + (size_t)cur.pn * tstepB + (size_t)cur.k0 * 2;
    PG8_RTAB_LOAD(cur.pm); PG8_RTAB_FIN(0);
    PG8_STAGE(PG8_SB(0, 0), cB, voffB); PG8_STAGE(PG8_SB(0, 1), cB + hstepB, voffB); PG8_STAGE(PG8_SA(0, 0), cA, voffA); PG8_STAGE(PG8_SA(0, 1), cA + hstepA, voffA);
    if (wr == 1) PG8_BAR;
    PG8_WAIT_V(2); PG8_BAR;
    PG8_STAGE(PG8_SB(1, 0), cB + kstep, voffB); PG8_STAGE(PG8_SA(1, 0), cA + kstep, voffA); PG8_STAGE(PG8_SB(1, 1), cB + hstepB + kstep, voffB);
    PG8_WAIT_V(6); PG8_BAR;
    for (;;) {
        const bool has_next = S.next(ui + 1, nxt);
        const char* nA = has_next ? (const char*)g.A + (size_t)nxt.pm * tstepA + (size_t)nxt.k0 * 2 : cA; const char* nB = has_next ? (const char*)g.Bt + (size_t)nxt.pn * tstepB + (size_t)nxt.k0 * 2 : cB;
        const int nt = cur.nt, qm = cur.qm;
        if (qm == 0xF) { PG8_KLOOP(true, true, true, true) } else { PG8_KLOOP((qm & 1), (qm & 2), (qm & 4), (qm & 8)) }
        if (wr == 0) PG8_BAR;
        if (has_next) PG8_RTAB_LOAD(nxt.pm);
        E(acc, cur, wr, wc, fr, fq, rtab + (ui & 1) * 256);
        if (!has_next) break;
#pragma unroll
        for (int a = 0; a < 2; ++a)
#pragma unroll
            for (int b = 0; b < 2; ++b)
#pragma unroll
                for (int m = 0; m < 4; ++m)
#pragma unroll
                    for (int n = 0; n < 2; ++n) acc[a][b][m][n] = (f32x4){0.f, 0.f, 0.f, 0.f};
        cur = nxt; cA = nA; cB = nB; ++ui;
        PG8_RTAB_FIN(ui & 1);
        if (wr == 1) PG8_BAR;
    }
    PG8_WAIT_V(0);
    PG8_BAR;
#undef PG8_SA
#undef PG8_RTAB_LOAD
#undef PG8_RTAB_FIN
#undef PG8_SB
#undef PG8_STAGE
#undef PG8_LDA
#undef PG8_LDB
#undef PG8_MMA
#undef PG8_WAIT_V
#undef PG8_WAIT_L
#undef PG8_BAR
#undef PG8_SCHED
}
}
using pg8::Unit;

#define EPI_FENCE() asm volatile("" ::: "memory")
struct EpiSwiglu {
    bf16_t* hid;
    __device__ __forceinline__ void operator()(const f32x4 (&acc)[2][2][4][2], const Unit& u, int wr, int wc, int fr, int fq, const LAS float* rt) const {
        const int row0 = u.pm * 256 + wr * 64 + fr, col = u.pn * 128 + wc * 32 + 8 * fq;
#pragma unroll
        for (int ai = 0; ai < 2; ++ai)
#pragma unroll
            for (int m = 0; m < 4; ++m) {
                const int rl = ai * 128 + m * 16; const int row = row0 + rl; const float rs = rt[wr * 64 + fr + rl];
                float h[8];
#pragma unroll
                for (int n = 0; n < 2; ++n)
#pragma unroll
                    for (int i = 0; i < 4; ++i) { const float a = acc[ai][0][m][n][i] * rs, b = acc[ai][1][m][n][i] * rs; h[4 * n + i] = a * sigm(a) * b; }
                u32x4 w; w.x = pk2(h[0], h[1]); w.y = pk2(h[2], h[3]); w.z = pk2(h[4], h[5]); w.w = pk2(h[6], h[7]);
                *(u32x4*)(hid + (size_t)row * FF + col) = w;
            }
    }
};
struct EpiWin {
    bf16_t* proj; float* out; int layer;
    __device__ __forceinline__ void operator()(const f32x4 (&acc)[2][2][4][2], const Unit& u, int wr, int wc, int fr, int fq, const LAS float* rt) const {
        const int row0 = u.pm * 256 + wr * 64 + fr, pn = u.pn;
        const bool isgate = (pn >= 10 && pn < 22), iskv = (pn >= 2 && pn < 6), ispool = (pn == 9);
#pragma unroll
        for (int ai = 0; ai < 2; ++ai)
#pragma unroll
            for (int m = 0; m < 4; ++m) {
                const int rl = ai * 128 + m * 16; const int row = row0 + rl; const float rs = rt[wr * 64 + fr + rl];
#pragma unroll
                for (int bj = 0; bj < 2; ++bj) {
                    if (!((u.qm >> (ai * 2 + bj)) & 1)) continue;
                    const int ct = bj * 128 + wc * 32 + 8 * fq;
                    f32x4 v0 = acc[ai][bj][m][0] * rs, v1 = acc[ai][bj][m][1] * rs;
                    if (isgate) {
#pragma unroll
                        for (int i = 0; i < 4; ++i) { v0[i] = sigm(v0[i]); v1[i] = sigm(v1[i]); }
                    }
                    u32x4 w; w.x = pk2(v0[0], v0[1]); w.y = pk2(v0[2], v0[3]); w.z = pk2(v1[0], v1[1]); w.w = pk2(v1[2], v1[3]);
                    *(u32x4*)(proj + (size_t)row * PW + pn * 256 + ct) = w;
                    if (iskv) {
                        const int c512 = (pn & 1) * 256 + ct; const bool isv = pn >= 4;
                        float* dst = row < MP ? out + (isv ? O_VP : O_KP) + ((size_t)layer * MP + row) * 512 + c512
                                              : out + (isv ? O_VS : O_KS) + ((size_t)layer * 2048 + (row - MP)) * 512 + c512;
                        *(f32x4*)dst = v0; *(f32x4*)(dst + 4) = v1;
                    }
                    if (ispool) {
                        if (row < MP) { const int t = row & 8191, b = row >> 13; if (t >= 8177) { float* dst = out + O_PP + ((size_t)(layer * 4 + b) * 15 + (t - 8177)) * 256 + ct; *(f32x4*)dst = v0; *(f32x4*)(dst + 4) = v1; } }
                        else { const int r = row - MP, t = r & 63, sb = r >> 6; if (t >= 49) { float* dst = out + O_PS + ((size_t)(layer * 32 + sb) * 15 + (t - 49)) * 256 + ct; *(f32x4*)dst = v0; *(f32x4*)(dst + 4) = v1; } }
                    }
                }
            }
    }
};
struct EpiRes {
    const bf16_t* xsrc; bf16_t* xb; float* ss_out; const bf16_t* scr; float alpha; int mode; const float* xin0; const float* xin1;
    __device__ __forceinline__ void operator()(const f32x4 (&acc)[2][2][4][2], const Unit& u, int wr, int wc, int fr, int fq, const LAS float* rt) const {
        const int row0 = u.pm * 256 + wr * 64 + fr, colb = u.pn * 256 + wc * 32 + 8 * fq;
        const float* xr = xin0 ? (u.pm < MP / 256 ? xin0 : xin1 - (size_t)MP * D) : nullptr;
#pragma unroll
        for (int ai = 0; ai < 2; ++ai) {
            if (!((u.qm >> (2 * ai)) & 3)) continue;
#pragma unroll
            for (int mp = 0; mp < 2; ++mp) {
                f32x4 xv[2][2][2]; u32x4 sv[2][2];
#pragma unroll
                for (int mi = 0; mi < 2; ++mi)
#pragma unroll
                    for (int bj = 0; bj < 2; ++bj) {
                        const size_t off = (size_t)(row0 + ai * 128 + (2 * mp + mi) * 16) * D + colb + bj * 128;
                        if (xr) { xv[mi][bj][0] = *(const f32x4*)(xr + off); xv[mi][bj][1] = *(const f32x4*)(xr + off + 4); }
                        else xv[mi][bj][0] = __builtin_bit_cast(f32x4, *(const u32x4*)(xsrc + off));
                        if (mode == 1) sv[mi][bj] = *(const u32x4*)(scr + off);
                    }
#pragma unroll
                for (int mi = 0; mi < 2; ++mi) {
                    const int m = 2 * mp + mi, rl = ai * 128 + m * 16, row = row0 + rl;
                    const float rs = (mode == 1) ? rt[wr * 64 + fr + rl] : 1.f;
#pragma unroll
                    for (int bj = 0; bj < 2; ++bj) {
                        if (!((u.qm >> (ai * 2 + bj)) & 1)) continue;
                        const size_t off = (size_t)row * D + colb + bj * 128;
                        f32x4 v0 = acc[ai][bj][m][0], v1 = acc[ai][bj][m][1];
                        if (mode == 1) {
#pragma unroll
                            for (int i = 0; i < 4; ++i) { v0[i] = sigm(v0[i] * rs); v1[i] = sigm(v1[i] * rs); }
                            { const u32x4 p4 = sv[mi][bj]; v0[0] *= bflo(p4.x); v0[1] *= bfhi(p4.x); v0[2] *= bflo(p4.y); v0[3] *= bfhi(p4.y); v1[0] *= bflo(p4.z); v1[1] *= bfhi(p4.z); v1[2] *= bflo(p4.w); v1[3] *= bfhi(p4.w); }
                        } else { v0 = v0 * alpha; v1 = v1 * alpha; }
                        f32x4 o0, o1;
                        if (xr) { o0 = xv[mi][bj][0]; o1 = xv[mi][bj][1]; }
                        else { const u32x4 h4 = __builtin_bit_cast(u32x4, xv[mi][bj][0]); o0 = (f32x4){bflo(h4.x), bfhi(h4.x), bflo(h4.y), bfhi(h4.y)}; o1 = (f32x4){bflo(h4.z), bfhi(h4.z), bflo(h4.w), bfhi(h4.w)}; }
                        const f32x4 x0 = o0 + v0, x1 = o1 + v1;
                        u32x4 w; w.x = pk2(x0[0], x0[1]); w.y = pk2(x0[2], x0[3]); w.z = pk2(x1[0], x1[1]); w.w = pk2(x1[2], x1[3]);
                        *(u32x4*)(xb + off) = w;
                        float ssum = (x0[0] * x0[0] + x0[1] * x0[1]) + (x0[2] * x0[2] + x0[3] * x0[3]) + (x1[0] * x1[0] + x1[1] * x1[1]) + (x1[2] * x1[2] + x1[3] * x1[3]);
                        ssum += __shfl_xor(ssum, 16); ssum += __shfl_xor(ssum, 32);
                        if (fq == 0) ss_out[(size_t)row * 32 + u.pn * 8 + bj * 4 + wc] = ssum;
                    }
                }
                EPI_FENCE();
            }
        }
    }
};
struct EpiBranch {
    const bf16_t* proj; bf16_t* scr; bf16_t* merged; int mode;
    template <int BR>
    __device__ __forceinline__ void run(const f32x4 (&acc)[2][2][4][2], const Unit& u, int wr, int wc, int fr, int fq) const {
        const int row0 = u.pm * 256 + wr * 64 + fr, colb = u.pn * 256 + wc * 32 + 8 * fq;
#pragma unroll
        for (int ai = 0; ai < 2; ++ai) {
            if (!((u.qm >> (2 * ai)) & 3)) continue;
#pragma unroll
            for (int mp = 0; mp < 2; ++mp) {
                u32x4 gt[2][2], sv[2][2];
#pragma unroll
                for (int mi = 0; mi < 2; ++mi)
#pragma unroll
                    for (int bj = 0; bj < 2; ++bj) {
                        const int row = row0 + ai * 128 + (2 * mp + mi) * 16, col = colb + bj * 128; const size_t off = (size_t)row * D + col;
                        if (BR < 3) gt[mi][bj] = *(const u32x4*)(proj + (size_t)row * PW + C_G + BR * 1024 + col);
                        if (BR == 1 || BR == 2) sv[mi][bj] = *(const u32x4*)(scr + off);
                    }
#pragma unroll
                for (int mi = 0; mi < 2; ++mi)
#pragma unroll
                    for (int bj = 0; bj < 2; ++bj) {
                        if (!((u.qm >> (ai * 2 + bj)) & 1)) continue;
                        const int m = 2 * mp + mi, row = row0 + ai * 128 + m * 16, col = colb + bj * 128; const size_t off = (size_t)row * D + col;
                        f32x4 v0 = acc[ai][bj][m][0], v1 = acc[ai][bj][m][1];
                        if (BR < 3) { const u32x4 g4 = gt[mi][bj];
                            v0[0] *= bflo(g4.x); v0[1] *= bfhi(g4.x); v0[2] *= bflo(g4.y); v0[3] *= bfhi(g4.y);
                            v1[0] *= bflo(g4.z); v1[1] *= bfhi(g4.z); v1[2] *= bflo(g4.w); v1[3] *= bfhi(g4.w); }
                        if (BR == 1 || BR == 2) { const u32x4 p4 = sv[mi][bj]; v0[0] += bflo(p4.x); v0[1] += bfhi(p4.x); v0[2] += bflo(p4.y); v0[3] += bfhi(p4.y); v1[0] += bflo(p4.z); v1[1] += bfhi(p4.z); v1[2] += bflo(p4.w); v1[3] += bfhi(p4.w); }
                        { u32x4 w; w.x = pk2(v0[0], v0[1]); w.y = pk2(v0[2], v0[3]); w.z = pk2(v1[0], v1[1]); w.w = pk2(v1[2], v1[3]); *(u32x4*)((BR == 2 ? merged : scr) + off) = w; }
                    }
                EPI_FENCE();
            }
        }
    }
    __device__ __forceinline__ void operator()(const f32x4 (&acc)[2][2][4][2], const Unit& u, int wr, int wc, int fr, int fq, const LAS float* rt) const {
        if (mode == 1) run<3>(acc, u, wr, wc, fr, fq);
        else if (u.kind == 0) run<0>(acc, u, wr, wc, fr, fq);
        else if (u.kind == 1) run<1>(acc, u, wr, wc, fr, fq);
        else run<2>(acc, u, wr, wc, fr, fq);
    }
};

struct Args { const float* in[29]; float* out; unsigned char* ws; int ph_lo, ph_hi; };
constexpr int NPH = 26;
constexpr int LDS_BYTES = 147456;

struct Ctx {
    const float* const* in; float* out; unsigned char* ws; LAS unsigned char* lds; unsigned char* ldsg; int tid, lane, wave, G, bx;
};

enum { MAP_ID = 0, MAP_SWIGLU = 1, MAP_WIN = 2 };
__device__ __forceinline__ int map_col(int mode, int n) {
    if (mode == MAP_ID) return n;
    if (mode == MAP_SWIGLU) { const int p = n >> 8, j = n & 255; return j < 128 ? p * 128 + j : FF + p * 128 + (j - 128); }
    if (n < 2048) return n;
    if (n < 2304) return 2064 + (n - 2048);
    if (n < 2560) return 2320 + (n - 2304);
    if (n < 5632) return 2576 + (n - 2560);
    if (n < 5648) return 2048 + (n - 5632);
    return -1;
}
__device__ __forceinline__ void tconv(const Ctx& c, const float* src, int ldsrc, int K, bf16_t* dst, int lddst, int Nout, int mode, const float* g, int& toff) {
    float* tile = (float*)c.ldsg;
    const int ntn = Nout / 64, ntk = K / 256, nt = ntn * ntk;
    const int first = (c.bx + c.G - (toff % c.G)) % c.G; toff += nt;
    for (int it = first; it < nt; it += c.G) {
        const int tn = it % ntn, tk = it / ntn, n0 = tn * 64, k0 = tk * 256;
        const int nn = c.tid & 63, sc = map_col(mode, n0 + nn), kq = c.tid >> 6;
        float v[32];
#pragma unroll
        for (int i = 0; i < 32; ++i) { const int kk = kq + 8 * i; v[i] = (sc >= 0) ? src[(size_t)(k0 + kk) * ldsrc + sc] : 0.f; }
        if (g) {
#pragma unroll
            for (int i = 0; i < 32; ++i) v[i] *= g[k0 + kq + 8 * i];
        }
#pragma unroll
        for (int i = 0; i < 32; ++i) tile[(kq + 8 * i) * 65 + nn] = v[i];
        __syncthreads();
        { const int n2 = c.tid >> 3, kg = c.tid & 7;
#pragma unroll
          for (int j = 0; j < 4; ++j) { const float* s = tile + (kg * 8 + 64 * j) * 65 + n2;
              u32x4 o; o.x = pk2(s[0], s[65]); o.y = pk2(s[130], s[195]); o.z = pk2(s[260], s[325]); o.w = pk2(s[390], s[455]);
              *(u32x4*)(dst + (size_t)(n0 + n2) * lddst + k0 + kg * 8 + 64 * j) = o; } }
        __syncthreads();
    }
}
__device__ __forceinline__ float wave_sum(float v) {
#pragma unroll
    for (int o = 1; o < 64; o <<= 1) v += __shfl_xor(v, o);
    return v;
}
__device__ __forceinline__ void prologue(const Ctx& c) {
    bf16_t* W = (bf16_t*)(c.ws + WS_W);
    int toff = 0;
    for (int l = 0; l < 2; ++l) {
        bf16_t* Wl = W + (size_t)l * WL_END;
        tconv(c, c.in[9] + (size_t)l * D * 2 * FF, 2 * FF, D, Wl + WL_1IN, D, 2 * FF, MAP_SWIGLU, c.in[8] + l * D, toff);
        tconv(c, c.in[10] + (size_t)l * FF * D, D, FF, Wl + WL_1OUT, FF, D, MAP_ID, nullptr, toff);
        tconv(c, c.in[12] + (size_t)l * D * INW, INW, D, Wl + WL_IN, D, NIN, MAP_WIN, c.in[11] + l * D, toff);
        tconv(c, c.in[18] + (size_t)l * 512 * D, D, 512, Wl + WL_BR, D, D, MAP_ID, nullptr, toff);
        tconv(c, c.in[19] + (size_t)l * 256 * D, D, 256, Wl + WL_BR + 512, D, D, MAP_ID, nullptr, toff);
        tconv(c, c.in[21] + (size_t)l * D * D, D, D, Wl + WL_OUT, D, D, MAP_ID, nullptr, toff);
        tconv(c, c.in[23] + (size_t)l * D * 2 * FF, 2 * FF, D, Wl + WL_2IN, D, 2 * FF, MAP_SWIGLU, c.in[22] + l * D, toff);
        tconv(c, c.in[24] + (size_t)l * FF * D, D, FF, Wl + WL_2OUT, FF, D, MAP_ID, nullptr, toff);
        tconv(c, c.in[26] + (size_t)l * D * D, D, D, Wl + WL_PG, D, D, MAP_ID, c.in[25] + l * D, toff);
        tconv(c, c.in[27] + (size_t)l * 256 * D, D, 256, Wl + WL_PP, 256, D, MAP_ID, nullptr, toff);
        const float* pw = c.in[16] + (size_t)l * 4 * 64 * 64; const float* psc = c.in[17] + l * 256; const float* wc = c.in[20] + (size_t)l * 256 * D;
        for (int idx = c.bx * 512 + c.tid; idx < 256 * 1024; idx += c.G * 512) {
            const int n = idx & 1023, kc = idx >> 10, gq = kc >> 6, cc = kc & 63; float s = 0.f;
            for (int dd = 0; dd < 64; ++dd) s += pw[(gq * 64 + cc) * 64 + dd] * psc[gq * 64 + dd] * wc[(size_t)(gq * 64 + dd) * D + n];
            Wl[WL_BR + (size_t)n * D + 768 + kc] = (bf16_t)f2bf(s);
        }
    }
    bf16_t* xb = (bf16_t*)(c.ws + WS_XB); float* ss0 = (float*)(c.ws + WS_SS);
    for (int row = c.bx * 8 + c.wave; row < M; row += c.G * 8) {
        const float* src = row < MP ? c.in[0] + (size_t)row * D : c.in[1] + (size_t)(row - MP) * D;
        f32x4 v[4]; float s = 0.f;
#pragma unroll
        for (int j = 0; j < 4; ++j) { v[j] = *(const f32x4*)(src + c.lane * 4 + 256 * j); s += (v[j][0] * v[j][0] + v[j][1] * v[j][1]) + (v[j][2] * v[j][2] + v[j][3] * v[j][3]); }
        s = wave_sum(s);
#pragma unroll
        for (int j = 0; j < 4; ++j) { u32x2 w; w.x = pk2(v[j][0], v[j][1]); w.y = pk2(v[j][2], v[j][3]); *(u32x2*)(xb + (size_t)row * D + c.lane * 4 + 256 * j) = w; }
        if (c.lane < 32) ss0[(size_t)row * 32 + c.lane] = c.lane == 0 ? s : 0.f;
    }
    bf16_t* pb = (bf16_t*)(c.ws + WS_PB);
#pragma unroll 4
    for (size_t i4 = (size_t)c.bx * 512 + c.tid; i4 < (size_t)2 * M * 64; i4 += (size_t)c.G * 512) {
        const size_t e = i4 * 4; const int l = (int)(e / ((size_t)M * 256)); const size_t r = e - (size_t)l * M * 256; const int row = (int)(r >> 8), cc = (int)(r & 255);
        const float* src = row < MP ? c.in[6] + ((size_t)l * MP + row) * 256 + cc : c.in[7] + ((size_t)l * 2048 + (row - MP)) * 256 + cc;
        const f32x4 v = *(const f32x4*)src; u32x2 w; w.x = pk2(v[0], v[1]); w.y = pk2(v[2], v[3]); *(u32x2*)(pb + e) = w;
    }
}

__device__ __forceinline__ int next_item(const Ctx& c, int slot) {
    volatile int* sh = (volatile int*)(c.ldsg + 147392);
    __syncthreads();
    if (c.tid == 0) *sh = (int)__hip_atomic_fetch_add((unsigned*)(c.ws + WS_CTL) + 64 * (1 + slot), 1u, __ATOMIC_RELAXED, __HIP_MEMORY_SCOPE_AGENT);
    __syncthreads();
    return *sh;
}
__device__ __forceinline__ void gla_local_unit(const Ctx& c, int l, int g, int h) {
    float* L = (float*)c.ldsg; float* rs = L; float* wg = L + 1024; float* bg = L + 1536; float* la = L + 1600; float* kt = L + 3712; float* vs = L + 5824;
    const bf16_t* proj = (const bf16_t*)(c.ws + WS_BIG); const int m0 = g * 64, tid = c.tid;
    { const int e = tid * 2, row = e >> 4, cc = e & 15; const unsigned w = *(const unsigned*)(proj + (size_t)(m0 + row) * PW + C_RB + cc); rs[e] = bflo(w); rs[e + 1] = bfhi(w); }
    { const int j = tid >> 5, d = tid & 31; wg[tid] = c.in[13][(size_t)(l * 16 + j) * 128 + h * 32 + d]; }
    if (tid < 32) bg[tid] = c.in[14][l * 128 + h * 32 + tid];
    __syncthreads();
#pragma unroll
    for (int i = 0; i < 4; ++i) { const int o = tid + 512 * i, t = o >> 5, d = o & 31; float a = bg[d];
#pragma unroll
        for (int j = 0; j < 16; ++j) a += rs[t * 16 + j] * wg[j * 32 + d];
        la[t * 33 + d] = (fminf(a, 0.f) - flog(1.0f + fexp(-fabsf(a)))) * (1.0f / 16.0f); }
    __syncthreads();
    {
#pragma unroll
        for (int j = 0; j < 4; ++j) { const int d = c.wave * 4 + j; float v = la[c.lane * 33 + d];
#pragma unroll
            for (int o = 1; o < 64; o <<= 1) { const float n = __shfl_up(v, o); if (c.lane >= o) v += n; }
            la[c.lane * 33 + d] = v; }
    }
    __syncthreads();
    float* bws = (float*)(c.ws + WS_B);
#pragma unroll
    for (int i = 0; i < 4; ++i) { const int o = tid + 512 * i, t = o >> 5, d = o & 31; const float b = la[t * 33 + d];
        bws[(size_t)(m0 + t) * 128 + h * 32 + d] = b;
        kt[t * 33 + d] = bf2f(proj[(size_t)(m0 + t) * PW + C_KB + h * 32 + d]) * fexp(-b); }
    { const int t = tid >> 3, e0 = (tid & 7) * 8; const u32x4 w = *(const u32x4*)(proj + (size_t)(m0 + t) * PW + C_VB + h * 64 + e0); float* d = vs + t * 64 + e0;
      d[0] = bflo(w.x); d[1] = bfhi(w.x); d[2] = bflo(w.y); d[3] = bfhi(w.y); d[4] = bflo(w.z); d[5] = bfhi(w.z); d[6] = bflo(w.w); d[7] = bfhi(w.w); }
    __syncthreads();
    { const int d = tid >> 4, e0 = (tid & 15) * 4; f32x4 a = {0.f, 0.f, 0.f, 0.f};
      for (int t = 0; t < 64; ++t) { const float kk = kt[t * 33 + d]; const f32x4 v = *(const f32x4*)(vs + t * 64 + e0); a = a + v * kk; }
      *(f32x4*)((float*)(c.ws + WS_DS) + ((size_t)(g * 4 + h) * 32 + d) * 64 + e0) = a; }
    if (tid < 32) ((float*)(c.ws + WS_DEC))[(size_t)(g * 4 + h) * 32 + tid] = fexp(la[63 * 33 + tid]);
    __syncthreads();
}
__device__ __forceinline__ void pool_unit(const Ctx& c, int l, int g) {
    float* ext = (float*)c.ldsg;
    const bf16_t* proj = (const bf16_t*)(c.ws + WS_BIG); bf16_t* Y = (bf16_t*)(c.ws + WS_Y);
    const int m0 = g * 64, tid = c.tid; const bool samp = g >= 512; const int cidx = samp ? 0 : (g & 127);
#pragma unroll
    for (int it = 0; it < 5; ++it) { const int q = tid + 512 * it;
        if (q < 79 * 32) { const int j = q >> 5, c8 = (q & 31) * 8; float* d = ext + j * 256 + c8;
            if (j >= 15 || cidx > 0) { const u32x4 w = *(const u32x4*)(proj + (size_t)(m0 + j - 15) * PW + C_UC + c8);
                *(f32x4*)d = (f32x4){bflo(w.x), bfhi(w.x), bflo(w.y), bfhi(w.y)}; *(f32x4*)(d + 4) = (f32x4){bflo(w.z), bfhi(w.z), bflo(w.w), bfhi(w.w)}; }
            else if (samp) { const float* sp = c.in[5] + ((size_t)(l * 32 + (g - 512)) * 15 + j) * 256 + c8; *(f32x4*)d = *(const f32x4*)sp; *(f32x4*)(d + 4) = *(const f32x4*)(sp + 4); }
            else { *(f32x4*)d = (f32x4){0.f, 0.f, 0.f, 0.f}; *(f32x4*)(d + 4) = (f32x4){0.f, 0.f, 0.f, 0.f}; } } }
    __syncthreads();
    { const int cc = tid & 255, ts = tid >> 8, gi = cc >> 6, w = 2 << gi;
      for (int i = 0; i < 32; ++i) { const int t = ts * 32 + i; float s = 0.f;
          for (int j = 0; j < w; ++j) s += ext[(15 + t - j) * 256 + cc];
          const int pos = samp ? 2048 + t : cidx * 64 + t; const float cnt = (float)min(w, pos + 1);
          const float dv = s / cnt - ext[(15 + t) * 256 + cc];
          Y[(size_t)(m0 + t) * D + 768 + cc] = (bf16_t)f2bf(dv); } }
    __syncthreads();
}

__device__ __forceinline__ void scan_unit(const Ctx& c, int l, int su) {
    const float* dS = (const float*)(c.ws + WS_DS); const float* dec = (const float*)(c.ws + WS_DEC); float* St = (float*)(c.ws + WS_ST);
    int g0, n, h, idx; float S; float* outp;
    if (su < 64) { const int bh = su >> 2, b = bh >> 2; h = bh & 3; idx = (su & 3) * 512 + c.tid; g0 = b * 128; n = 128; S = 0.f; outp = c.out + O_GP + ((size_t)(l * 4 + b) * 4 + h) * 2048 + idx; }
    else { const int s2 = su - 64, sbh = s2 >> 2, sb = sbh >> 2; h = sbh & 3; idx = (s2 & 3) * 512 + c.tid; g0 = 512 + sb; n = 1; S = c.in[4][((size_t)(l * 32 + sb) * 4 + h) * 2048 + idx]; outp = c.out + O_GS + ((size_t)(l * 32 + sb) * 4 + h) * 2048 + idx; }
    const int d = idx >> 6;
#pragma unroll 8
    for (int cc = 0; cc < n; ++cc) { const size_t gh = (size_t)(g0 + cc) * 4 + h; const float dd = dS[gh * 2048 + idx], de = dec[gh * 32 + d]; St[gh * 2048 + idx] = S; S = de * (S + dd); }
    *outp = S;
}
__device__ __forceinline__ void attn_unit(const Ctx& c, int l, int au) {
    bf16_t* Ks = (bf16_t*)c.ldsg; bf16_t* Vt = (bf16_t*)(c.ldsg + 18432); int* flags = (int*)(c.ldsg + 35840);
    const bf16_t* proj = (const bf16_t*)(c.ws + WS_BIG); bf16_t* Y = (bf16_t*)(c.ws + WS_Y);
    int R0, n_past, qb, hp, sb = 0;
    if (au < 2048) { const int b = au >> 9, rem = au & 511; qb = rem >> 2; hp = rem & 3; R0 = b * 8192; n_past = 0; }
    else { const int a2 = au - 2048; sb = a2 >> 2; hp = a2 & 3; qb = 0; R0 = MP + sb * 64; n_past = 2048; }
    const int tid = c.tid, w = c.wave, lane = c.lane, fr = lane & 15, fq = lane >> 4, hsel = w >> 2, hh = 2 * hp + hsel, qsub = w & 3;
    const int qrow = R0 + qb * 64 + qsub * 16 + fr, qpos = n_past + qb * 64 + qsub * 16 + fr;
    bf16x8 qf[2];
#pragma unroll
    for (int ks = 0; ks < 2; ++ks) qf[ks] = *(const bf16x8*)(proj + (size_t)qrow * PW + C_QA + hh * 64 + 32 * ks + 8 * fq);
    f32x4 O[4];
#pragma unroll
    for (int i = 0; i < 4; ++i) O[i] = (f32x4){0.f, 0.f, 0.f, 0.f};
    float carry = 0.f; bool wdone = false;
    int kt = (n_past + qb * 64) >> 6;
    const int lh = tid >> 8, lj = (tid >> 2) & 63, d0 = (tid & 3) * 16, lhead = 2 * hp + lh;
    for (;;) {
        {
            const int kpos = kt * 64 + lj; unsigned kk[8], vv[8];
            if (kpos < n_past) {
                const size_t o = (((size_t)(l * 32 + sb) * 2048 + kpos) * 512) + lhead * 64 + d0; const float* kp = c.in[2] + o; const float* vp = c.in[3] + o;
#pragma unroll
                for (int i = 0; i < 4; ++i) { const f32x4 a = *(const f32x4*)(kp + 4 * i), b = *(const f32x4*)(vp + 4 * i); kk[2 * i] = pk2(a[0], a[1]); kk[2 * i + 1] = pk2(a[2], a[3]); vv[2 * i] = pk2(b[0], b[1]); vv[2 * i + 1] = pk2(b[2], b[3]); }
            } else {
                const bf16_t* rp = proj + (size_t)(R0 + kpos - n_past) * PW + lhead * 64 + d0;
                const u32x4 a0 = *(const u32x4*)(rp + C_KA), a1 = *(const u32x4*)(rp + C_KA + 8), b0 = *(const u32x4*)(rp + C_VA), b1 = *(const u32x4*)(rp + C_VA + 8);
                kk[0] = a0.x; kk[1] = a0.y; kk[2] = a0.z; kk[3] = a0.w; kk[4] = a1.x; kk[5] = a1.y; kk[6] = a1.z; kk[7] = a1.w;
                vv[0] = b0.x; vv[1] = b0.y; vv[2] = b0.z; vv[3] = b0.w; vv[4] = b1.x; vv[5] = b1.y; vv[6] = b1.z; vv[7] = b1.w;
            }
            bf16_t* kd = Ks + (lh * 64 + lj) * 72 + d0;
            *(u32x4*)kd = (u32x4){kk[0], kk[1], kk[2], kk[3]}; *(u32x4*)(kd + 8) = (u32x4){kk[4], kk[5], kk[6], kk[7]};
#pragma unroll
            for (int i = 0; i < 8; ++i) { Vt[(lh * 64 + d0 + 2 * i) * 68 + lj] = (bf16_t)(vv[i] & 0xffffu); Vt[(lh * 64 + d0 + 2 * i + 1) * 68 + lj] = (bf16_t)(vv[i] >> 16); }
        }
        __syncthreads();
        {
            f32x4 sa[4];
#pragma unroll
            for (int u = 0; u < 4; ++u) { sa[u] = (f32x4){0.f, 0.f, 0.f, 0.f};
#pragma unroll
                for (int ks = 0; ks < 2; ++ks) { const bf16x8 kf = *(const bf16x8*)(Ks + (hsel * 64 + 16 * u + fr) * 72 + 32 * ks + 8 * fq); sa[u] = __builtin_amdgcn_mfma_f32_16x16x32_bf16(kf, qf[ks], sa[u], 0, 0, 0); } }
            float lk[4][4], lw[4][4], ls[4], suf[4], T[4];
#pragma unroll
            for (int u = 0; u < 4; ++u) { ls[u] = 0.f;
#pragma unroll
                for (int i = 0; i < 4; ++i) { const float z = sa[u][i] * 0.125f; const int kpos = kt * 64 + 16 * u + 4 * fq + i; const bool valid = kpos < qpos;
                    const float sp = softplus(z); lk[u][i] = valid ? -sp : 0.f; lw[u][i] = valid ? (z - sp) : -1e30f; ls[u] += lk[u][i]; } }
#pragma unroll
            for (int u = 0; u < 4; ++u) { const float a = __shfl_xor(ls[u], 16), t1 = ls[u] + a, o = __shfl_xor(t1, 32); T[u] = t1 + o; suf[u] = ((fq & 1) ? 0.f : a) + ((fq & 2) ? 0.f : o); }
            float base = carry; float wv[4][4];
#pragma unroll
            for (int u = 3; u >= 0; --u) { float run = base + suf[u];
#pragma unroll
                for (int i = 3; i >= 0; --i) { wv[u][i] = fexp(lw[u][i] + run); run += lk[u][i]; }
                base += T[u]; }
            carry = base;
#pragma unroll
            for (int k2 = 0; k2 < 2; ++k2) {
                u32x4 pw; pw.x = pk2(wv[2 * k2][0], wv[2 * k2][1]); pw.y = pk2(wv[2 * k2][2], wv[2 * k2][3]); pw.z = pk2(wv[2 * k2 + 1][0], wv[2 * k2 + 1][1]); pw.w = pk2(wv[2 * k2 + 1][2], wv[2 * k2 + 1][3]);
                const bf16x8 pf = __builtin_bit_cast(bf16x8, pw);
#pragma unroll
                for (int db = 0; db < 4; ++db) { const bf16_t* vp = Vt + (hsel * 64 + 16 * db + fr) * 68 + 32 * k2 + 4 * fq; const u32x2 lo = *(const u32x2*)vp, hi = *(const u32x2*)(vp + 16);
                    const bf16x8 vf = __builtin_bit_cast(bf16x8, (u32x4){lo.x, lo.y, hi.x, hi.y}); O[db] = __builtin_amdgcn_mfma_f32_16x16x32_bf16(vf, pf, O[db], 0, 0, 0); }
            }
            wdone = __all(carry < -46.f) != 0;
        }
        --kt;
        if (lane == 0) flags[w] = wdone ? 1 : 0;
        __syncthreads();
        int alld = 1;
#pragma unroll
        for (int i = 0; i < 8; ++i) alld &= flags[i];
        if (alld || kt < 0) break;
    }
#pragma unroll
    for (int db = 0; db < 4; ++db) { u32x2 o; o.x = pk2(O[db][0], O[db][1]); o.y = pk2(O[db][2], O[db][3]); *(u32x2*)(Y + (size_t)qrow * D + hh * 64 + 16 * db + 4 * fq) = o; }
    __syncthreads();
}

__device__ __forceinline__ void gla_out_unit(const Ctx& c, int l, int g, int h) {
    float* L = (float*)c.ldsg; float* qs = L; float* ktT = L + 2112; float* vs = L + 4288; float* sc = L + 8640; float* Ss = L + 12800;
    const bf16_t* proj = (const bf16_t*)(c.ws + WS_BIG); bf16_t* Y = (bf16_t*)(c.ws + WS_Y); const float* bws = (const float*)(c.ws + WS_B);
    const int m0 = g * 64, tid = c.tid;
#pragma unroll
    for (int i = 0; i < 4; ++i) { const int o = tid + 512 * i, t = o >> 5, d = o & 31; const float b = bws[(size_t)(m0 + t) * 128 + h * 32 + d];
        const bf16_t* pr = proj + (size_t)(m0 + t) * PW + h * 32 + d;
        qs[t * 33 + d] = bf2f(pr[C_QB]) * 0.17677669529663687f * fexp(b); ktT[d * 68 + t] = bf2f(pr[C_KB]) * fexp(-b);
        Ss[o] = ((const float*)(c.ws + WS_ST))[(size_t)(g * 4 + h) * 2048 + o]; }
    { const int t = tid >> 3, e0 = (tid & 7) * 8; const u32x4 w = *(const u32x4*)(proj + (size_t)(m0 + t) * PW + C_VB + h * 64 + e0); float* d = vs + t * 68 + e0;
      d[0] = bflo(w.x); d[1] = bfhi(w.x); d[2] = bflo(w.y); d[3] = bfhi(w.y); d[4] = bflo(w.z); d[5] = bfhi(w.z); d[6] = bflo(w.w); d[7] = bfhi(w.w); }
    __syncthreads();
    const int t = tid >> 3, g8 = (tid & 7) * 8;
    { float a[8];
#pragma unroll
      for (int j = 0; j < 8; ++j) a[j] = 0.f;
      for (int d = 0; d < 32; ++d) { const float q = qs[t * 33 + d]; const f32x4 k0 = *(const f32x4*)(ktT + d * 68 + g8), k1 = *(const f32x4*)(ktT + d * 68 + g8 + 4);
#pragma unroll
          for (int j = 0; j < 4; ++j) { a[j] += q * k0[j]; a[4 + j] += q * k1[j]; } }
#pragma unroll
      for (int j = 0; j < 8; ++j) sc[t * 65 + g8 + j] = (g8 + j <= t) ? a[j] : 0.f; }
    __syncthreads();
    { float o[8];
#pragma unroll
      for (int j = 0; j < 8; ++j) o[j] = 0.f;
      for (int s = 0; s <= t; ++s) { const float p = sc[t * 65 + s]; const f32x4 v0 = *(const f32x4*)(vs + s * 68 + g8), v1 = *(const f32x4*)(vs + s * 68 + g8 + 4);
#pragma unroll
          for (int j = 0; j < 4; ++j) { o[j] += p * v0[j]; o[4 + j] += p * v1[j]; } }
      for (int d = 0; d < 32; ++d) { const float q = qs[t * 33 + d]; const f32x4 s0 = *(const f32x4*)(Ss + d * 64 + g8), s1 = *(const f32x4*)(Ss + d * 64 + g8 + 4);
#pragma unroll
          for (int j = 0; j < 4; ++j) { o[j] += q * s0[j]; o[4 + j] += q * s1[j]; } }
      float q2 = 0.f;
#pragma unroll
      for (int j = 0; j < 8; ++j) q2 += o[j] * o[j];
      q2 += __shfl_xor(q2, 1); q2 += __shfl_xor(q2, 2); q2 += __shfl_xor(q2, 4);
      const float r = __builtin_amdgcn_rsqf(q2 * (1.0f / 64.0f) + EPS);
      const u32x4 ow = *(const u32x4*)(proj + (size_t)(m0 + t) * PW + C_OB + h * 64 + g8);
      float ob[8] = {bflo(ow.x), bfhi(ow.x), bflo(ow.y), bfhi(ow.y), bflo(ow.z), bfhi(ow.z), bflo(ow.w), bfhi(ow.w)};
      const float* gn = c.in[15] + l * 256 + h * 64 + g8; float y[8];
#pragma unroll
      for (int j = 0; j < 8; ++j) y[j] = o[j] * r * gn[j] * (ob[j] * sigm(ob[j]));
      u32x4 w; w.x = pk2(y[0], y[1]); w.y = pk2(y[2], y[3]); w.z = pk2(y[4], y[5]); w.w = pk2(y[6], y[7]);
      *(u32x4*)(Y + (size_t)(m0 + t) * D + 512 + h * 64 + g8) = w; }
    __syncthreads();
}

__device__ __forceinline__ void grid_bar(unsigned* ctl, unsigned r) {
    asm volatile("s_waitcnt vmcnt(0)" ::: "memory");
    __syncthreads();
    if (threadIdx.x == 0) {
        const unsigned g = blockIdx.x & 7u, G = gridDim.x, nloc = (G - g + 7u) >> 3, ngrp = G < 8u ? G : 8u;
        unsigned* cnt = ctl + 64 * (16 + g); unsigned* gen = ctl + 64 * (24 + g); unsigned* top = ctl + 64 * 32;
        __builtin_amdgcn_fence(__ATOMIC_RELEASE, "agent");
        asm volatile("s_waitcnt vmcnt(0)" ::: "memory");
        const unsigned old = __hip_atomic_fetch_add(cnt, 1u, __ATOMIC_RELAXED, __HIP_MEMORY_SCOPE_AGENT);
        if (old + 1u == r * nloc) {
            __hip_atomic_fetch_add(top, 1u, __ATOMIC_RELAXED, __HIP_MEMORY_SCOPE_AGENT);
            while (__hip_atomic_load(top, __ATOMIC_RELAXED, __HIP_MEMORY_SCOPE_AGENT) < r * ngrp) __builtin_amdgcn_s_sleep(1);
            __hip_atomic_store(gen, r, __ATOMIC_RELAXED, __HIP_MEMORY_SCOPE_AGENT);
        } else {
            while (__hip_atomic_load(gen, __ATOMIC_RELAXED, __HIP_MEMORY_SCOPE_AGENT) < r) __builtin_amdgcn_s_sleep(1);
        }
        __builtin_amdgcn_fence(__ATOMIC_ACQUIRE, "agent");
        asm volatile("s_waitcnt vmcnt(0)" ::: "memory");
    }
    __syncthreads();
}

__global__ void __launch_bounds__(512, 2) fwd_mega(Args args) {
    extern __shared__ __attribute__((aligned(16))) unsigned char lds[];
    cg::grid_group grid = cg::this_grid();
    Ctx c; c.in = args.in; c.out = args.out; c.ws = args.ws; c.lds = (LAS unsigned char*)lds; c.ldsg = lds;
    c.tid = threadIdx.x; c.lane = c.tid & 63; c.wave = __builtin_amdgcn_readfirstlane(c.tid >> 6); c.G = gridDim.x; c.bx = blockIdx.x;
    for (int ph = args.ph_lo; ph < args.ph_hi; ++ph) {
        { int t_ = threadIdx.x; asm volatile("" : "+v"(t_)); c.tid = t_; c.lane = t_ & 63; c.wave = __builtin_amdgcn_readfirstlane(t_ >> 6); }
        unsigned char* ws = args.ws; float* outp = args.out; asm volatile("" : "+s"(ws), "+s"(outp)); c.ws = ws; c.out = outp;
        bf16_t* xb = (bf16_t*)(ws + WS_XB); bf16_t* big = (bf16_t*)(ws + WS_BIG); bf16_t* Yb = (bf16_t*)(ws + WS_Y); bf16_t* mg = (bf16_t*)(ws + WS_MG);
        float* scr = (float*)(ws + WS_SCR); float* ss0 = (float*)(ws + WS_SS); float* ss1 = ss0 + (size_t)M * 32; float* xw = outp + O_Y;
        if (ph == 0) prologue(c);
        else if (ph == 25) {
            const float* gf = args.in[28];
            for (int row = c.bx * 8 + c.wave; row < M; row += c.G * 8) { const float rs = rstd_of(ss0, row);
#pragma unroll
                for (int j = 0; j < 4; ++j) { const u32x2 h2 = *(const u32x2*)(mg + (size_t)row * D + c.lane * 4 + 256 * j); const f32x4 v = {bflo(h2.x), bfhi(h2.x), bflo(h2.y), bfhi(h2.y)}, gg = *(const f32x4*)(gf + c.lane * 4 + 256 * j);
                    *(f32x4*)(xw + (size_t)row * D + c.lane * 4 + 256 * j) = v * rs * gg; } }
        } else {
            const int l = (ph - 1) / 12, k = (ph - 1) % 12;
            if ((MK_SKIPMASK >> k) & 1) continue;
            const bf16_t* Wl = (const bf16_t*)(ws + WS_W) + (size_t)l * WL_END;
            if (k == 0 || k == 8) {
                pg8::Gemm g{(k == 0 && l > 0) ? mg : xb, Wl + (k == 0 ? WL_1IN : WL_2IN), D, D}; pg8::Sched S;     S.init(M, 2 * FF, c.G, c.bx, 16);
                EpiSwiglu E{big}; pg8::gemm_phase(c.lds, c.tid, g, S, E, ss0);
            } else if (k == 1 || k == 9 || k == 7 || k == 11) {
                pg8::Gemm g; pg8::Sched S; EpiRes E{xb, xb, nullptr, (const bf16_t*)scr, 1.f, 0, nullptr, nullptr}; const float* ssin = nullptr;
                if (k == 1 || k == 9) { g = pg8::Gemm{big, Wl + (k == 1 ? WL_1OUT : WL_2OUT), FF, FF}; S.init(M, D, c.G, c.bx, 44); S.quart = 1; E.alpha = 0.5f; E.ss_out = ss1; if (k == 1) { if (l == 0) { E.xin0 = args.in[0]; E.xin1 = args.in[1]; } else E.xsrc = mg; } }
                else if (k == 7) { g = pg8::Gemm{mg, Wl + WL_OUT, D, D}; S.init(M, D, c.G, c.bx, 16); S.quart = 1; E.ss_out = ss0; }
                else { g = pg8::Gemm{xb, Wl + WL_PG, D, D}; S.init(M, D, c.G, c.bx, 16); S.quart = 1; E.ss_out = ss0; ssin = ss1; E.mode = 1; E.xb = mg; }
                pg8::gemm_phase(c.lds, c.tid, g, S, E, ssin);
            } else if (k == 2) {
                pg8::Gemm g{xb, Wl + WL_IN, D, D}; pg8::Sched S; S.init(M, NIN, c.G, c.bx, 16); S.quart = 1;
                EpiWin E{big, outp, l}; pg8::gemm_phase(c.lds, c.tid, g, S, E, ss1);
            } else if (k == 3) {
                for (int it = next_item(c, l * 3 + 0); it < 2176 + NCH; it = next_item(c, l * 3 + 0)) { if (it < NCH) pool_unit(c, l, it); else gla_local_unit(c, l, (it - NCH) >> 2, (it - NCH) & 3); }
            } else if (k == 4) {
                for (int it = next_item(c, l * 3 + 1); it < 576 + 2176; it = next_item(c, l * 3 + 1)) { if (it < 576) scan_unit(c, l, it); else attn_unit(c, l, it - 576); }
            } else if (k == 5) {
                for (int it = next_item(c, l * 3 + 2); it < 2176; it = next_item(c, l * 3 + 2)) gla_out_unit(c, l, it >> 2, it & 3);
            } else {
                pg8::Gemm g; pg8::Sched S; EpiBranch E{big, (bf16_t*)scr, mg, 0};
                if (k == 6) { g = pg8::Gemm{Yb, Wl + WL_BR, D, D}; S.init(M, D, c.G, c.bx, 8); S.nsub = 3; S.quart = 1; }
                else { g = pg8::Gemm{(const bf16_t*)(ws + WS_PB) + (size_t)l * M * 256, Wl + WL_PP, 256, 256}; S.init(M, D, c.G, c.bx, 4); S.quart = 1; E.mode = 1; }
                pg8::gemm_phase(c.lds, c.tid, g, S, E, nullptr);
            }
        }
        if (ph + 1 < args.ph_hi) { if (args.ph_hi > 4096) grid.sync(); grid_bar((unsigned*)(args.ws + WS_CTL), (unsigned)(ph - args.ph_lo + 1)); }
    }
}

extern "C" void kernel_launch(void* const* d_in, const int* in_sizes, int n_in, void* d_out, int out_size, void* d_ws, size_t ws_size, hipStream_t stream) {
    static int grid = 0;
    if (grid == 0) {
        if (n_in != 29 || ws_size < WS_NEED) { fprintf(stderr, "kernel_launch: unexpected n_in %d / ws %zu\n", n_in, ws_size); grid = -1; return; }
        int dev = 0, cus = 0, per_cu = 0;
        (void)hipGetDevice(&dev); (void)hipDeviceGetAttribute(&cus, hipDeviceAttributeMultiprocessorCount, dev);
        (void)hipFuncSetAttribute((const void*)fwd_mega, hipFuncAttributeMaxDynamicSharedMemorySize, LDS_BYTES);
        (void)hipOccupancyMaxActiveBlocksPerMultiprocessor(&per_cu, (const void*)fwd_mega, 512, LDS_BYTES);
        (void)hipGetLastError();
        if (per_cu < 1) per_cu = 1;
        grid = cus;
    }
    if (grid < 0) return;
    (void)hipMemsetAsync((char*)d_ws + WS_CTL, 0, 16384, stream);
    Args a{};
    for (int i = 0; i < 29; ++i) a.in[i] = (const float*)d_in[i];
    a.out = (float*)d_out; a.ws = (unsigned char*)d_ws;
#if MK_ONE_LAUNCH
    a.ph_lo = 0; a.ph_hi = NPH;
    void* kargs[] = {&a};
    hipError_t e = hipLaunchCooperativeKernel((const void*)fwd_mega, dim3(grid), dim3(512), kargs, LDS_BYTES, stream);
    if (e != hipSuccess) fprintf(stderr, "cooperative launch failed: %s (grid %d)\n", hipGetErrorString(e), grid);
#else
    for (int ph = 0; ph < NPH; ++ph) { a.ph_lo = ph; a.ph_hi = ph + 1; hipLaunchKernelGGL(fwd_mega, dim3(grid), dim3(512), LDS_BYTES, stream, a); }
#endif
}
```

```cpp
#include <hip/hip_runtime.h>
#include <hip/hip_cooperative_groups.h>
#include <cstdio>
#include <cstdint>
namespace cg = cooperative_groups;

#ifndef MK_SKIPMASK
#define MK_SKIPMASK 0
#endif
#ifndef MK_NOATTN
#define MK_NOATTN 0
#endif
#ifndef MK_NOGLAOUT
#define MK_NOGLAOUT 0
#endif
#ifndef MK_ONE_LAUNCH
#define MK_ONE_LAUNCH 1
#endif

#define LAS __attribute__((address_space(3)))
typedef unsigned short bf16_t;
typedef short bf16x8 __attribute__((ext_vector_type(8)));
typedef float f32x4 __attribute__((ext_vector_type(4)));
typedef unsigned u32x4 __attribute__((ext_vector_type(4)));
typedef unsigned u32x2 __attribute__((ext_vector_type(2)));

constexpr int M = 34816;
constexpr int MP = 32768;
constexpr int D = 1024, FF = 2816, NIN = 5888, PW = 5888  , INW = 5648;
constexpr int NCH = 544;
constexpr float EPS = 1e-6f;
constexpr size_t O_Y = 0, O_KP = 35651584, O_VP = 69206016, O_GP = 102760448, O_PP = 102825984, O_KS = 102856704, O_VS = 104953856, O_GS = 107051008, O_PS = 107575296;
constexpr int C_QA = 0, C_KA = 512, C_VA = 1024, C_QB = 1536, C_KB = 1664, C_VB = 1792, C_OB = 2048, C_UC = 2304, C_G = 2560, C_RB = 5632;

constexpr size_t WL_1IN = 0, WL_1OUT = WL_1IN + (size_t)5632 * 1024, WL_IN = WL_1OUT + (size_t)1024 * 2816, WL_BR = WL_IN + (size_t)5888 * 1024, WL_OUT = WL_BR + 1048576,
                 WL_2IN = WL_OUT + 1048576, WL_2OUT = WL_2IN + (size_t)5632 * 1024, WL_PG = WL_2OUT + (size_t)1024 * 2816, WL_PP = WL_PG + 1048576, WL_END = WL_PP + 262144;
constexpr size_t MiB = 1u << 20;
constexpr size_t WS_W = 0;
constexpr size_t WS_XB = 104 * MiB;
constexpr size_t WS_PB = 172 * MiB;
constexpr size_t WS_BIG = 208 * MiB;
constexpr size_t WS_Y = 600 * MiB;
constexpr size_t WS_MG = 668 * MiB;
constexpr size_t WS_SCR = 736 * MiB;
constexpr size_t WS_SS = 934 * MiB;
constexpr size_t WS_DS = 878 * MiB;
constexpr size_t WS_ST = 896 * MiB;
constexpr size_t WS_B = 914 * MiB;
constexpr size_t WS_DEC = 932 * MiB;
constexpr size_t WS_CTL = 933 * MiB;
constexpr size_t WS_NEED = 944 * MiB;
static_assert(2 * WL_END * 2 <= 104 * MiB, "weights fit");

__device__ __forceinline__ unsigned f2bf(float f) { unsigned u = __builtin_bit_cast(unsigned, f); return (u + 0x7fffu + ((u >> 16) & 1u)) >> 16; }
__device__ __forceinline__ unsigned pk2(float lo, float hi) { unsigned r; asm("v_cvt_pk_bf16_f32 %0, %1, %2" : "=v"(r) : "v"(lo), "v"(hi)); return r; }
__device__ __forceinline__ float bflo(unsigned u) { return __uint_as_float(u << 16); }
__device__ __forceinline__ float bfhi(unsigned u) { return __uint_as_float(u & 0xffff0000u); }
__device__ __forceinline__ float bf2f(bf16_t b) { return __uint_as_float((unsigned)b << 16); }
__device__ __forceinline__ float fexp(float x) { return __builtin_amdgcn_exp2f(x * 1.4426950408889634f); }
__device__ __forceinline__ float flog(float x) { return __builtin_amdgcn_logf(x) * 0.6931471805599453f; }
__device__ __forceinline__ float sigm(float x) { return __builtin_amdgcn_rcpf(1.0f + fexp(-x)); }
__device__ __forceinline__ float softplus(float z) { return fmaxf(z, 0.f) + flog(1.0f + fexp(-fabsf(z))); }
__device__ __forceinline__ float rstd_of(const float* ss, int row) {
    const f32x4* p = (const f32x4*)(ss + (size_t)row * 32);
    float s = 0.f;
#pragma unroll
    for (int i = 0; i < 8; ++i) { const f32x4 a = p[i]; s += (a[0] + a[1]) + (a[2] + a[3]); }
    return __builtin_amdgcn_rsqf(s * (1.0f / 1024.0f) + EPS);
}

namespace pg8 {
constexpr int BM = 256, BK = 64, HALF = 128, HTB = HALF * BK * 2, STAGE_BYTES = 8 * HTB, NXCD = 8, WGM = 8;
__host__ __device__ __forceinline__ int lds_byte(int r, int c) { const int st = (r >> 4) * 2 + (c >> 5), rr = r & 15, cc = c & 31, ob = rr * 64 + cc * 2; return st * 1024 + (ob ^ (((ob >> 9) & 1) << 5)); }
__host__ __device__ __forceinline__ void stage_rc(int b, int& R, int& C) { const int st = b / 1024, sb = b % 1024, swz = sb ^ (((sb >> 9) & 1) << 5); R = (st >> 1) * 16 + swz / 64; C = (st & 1) * 32 + (swz % 64) / 2; }
__host__ __device__ __forceinline__ int perm32(int rho) { const int n = rho >> 4, i = rho & 15; return 8 * (i >> 2) + 4 * n + (i & 3); }

struct Unit { int pm, pn, kind, k0, nt, qm; };
struct Gemm { const bf16_t* A; const bf16_t* Bt; int lda, ldb; };

struct Sched {
    int nM, nN, nwg, G, c, nsub, nt0, quart;
    __device__ __forceinline__ void init(int M_, int N_, int G_, int c_, int nt) { nM = M_ / BM; nN = N_ / BM; nwg = nM * nN; G = G_; c = c_; nsub = 1; nt0 = nt; quart = 0; }
    __device__ __forceinline__ bool next(int i, Unit& u) const {
        const int ti = i / nsub, sk = i - ti * nsub;
        long L = (long)ti * G + c; int qm = 0xF;
        const int nfull = nwg / G;
        if (quart && ti >= nfull) {
            const long li = (long)(ti - nfull) * G + c; if (li >= 4L * (nwg - nfull * G)) return false;
            L = (long)nfull * G + (li >> 2); qm = 1 << (int)(li & 3);
        } else if (L >= nwg) return false;
        u.qm = qm;
        int wgid = (int)L; { const int q = nwg / NXCD, r = nwg % NXCD, xcd = wgid % NXCD, off = wgid / NXCD; wgid = (xcd < r ? xcd * (q + 1) : r * (q + 1) + (xcd - r) * q) + off; }
        const int nig = WGM * nN, gid = wgid / nig, fm = gid * WGM, gsz = (nM - fm) < WGM ? (nM - fm) : WGM;
        u.pm = fm + ((wgid % nig) % gsz); u.pn = (wgid % nig) / gsz; u.kind = sk; u.k0 = (sk > 0) ? 256 + 256 * sk : 0; u.nt = (sk > 0) ? 4 : nt0; return true;
    }
};

#define PG8_KLOOP(C0, C1, C2, C3) \
        for (int t = 0; t < nt; t += 2) { \
            const bool last = (t == nt - 2); \
            const char* a1 = cA + (size_t)(t + 1) * kstep; \
            const char* a2 = last ? nA : cA + (size_t)(t + 2) * kstep; const char* b2 = last ? nB : cB + (size_t)(t + 2) * kstep; \
            const char* a3 = a2 + kstep; const char* b3 = b2 + kstep; \
            PG8_LDB(B0, 0, 0); PG8_LDB(B1, 0, 1); PG8_SCHED; PG8_LDA(At, 0, 0); PG8_STAGE(PG8_SA(1, 1), a1 + hstepA, voffA); \
            PG8_WAIT_V(8); PG8_WAIT_L(0); PG8_BAR; if (C0) PG8_MMA(0, 0, At, B0); if (C1) PG8_MMA(0, 1, At, B1); PG8_BAR; PG8_SCHED; \
            PG8_LDA(At, 0, 1); PG8_STAGE(PG8_SB(0, 0), b2, voffB); PG8_STAGE(PG8_SB(0, 1), b2 + hstepB, voffB); PG8_STAGE(PG8_SA(0, 0), a2, voffA); \
            PG8_WAIT_V(8); PG8_WAIT_L(0); PG8_BAR; if (C2) PG8_MMA(1, 0, At, B0); if (C3) PG8_MMA(1, 1, At, B1); PG8_BAR; PG8_SCHED; \
            PG8_LDB(B0, 1, 0); PG8_LDB(B1, 1, 1); PG8_SCHED; PG8_LDA(At, 1, 0); PG8_STAGE(PG8_SA(0, 1), a2 + hstepA, voffA); \
            PG8_WAIT_V(8); PG8_WAIT_L(0); PG8_BAR; if (C0) PG8_MMA(0, 0, At, B0); if (C1) PG8_MMA(0, 1, At, B1); PG8_BAR; PG8_SCHED; \
            PG8_LDA(At, 1, 1); PG8_STAGE(PG8_SB(1, 0), b3, voffB); PG8_STAGE(PG8_SB(1, 1), b3 + hstepB, voffB); PG8_STAGE(PG8_SA(1, 0), a3, voffA); \
            PG8_WAIT_V(8); PG8_WAIT_L(0); PG8_BAR; if (C2) PG8_MMA(1, 0, At, B0); if (C3) PG8_MMA(1, 1, At, B1); PG8_BAR; PG8_SCHED; \
        }
template <class Epi, class Sch>
__device__ __forceinline__ void gemm_phase(LAS unsigned char* lds, const int tid, const Gemm g, const Sch& S, const Epi& E, const float* ss) {
    const int wid = __builtin_amdgcn_readfirstlane(tid >> 6), lane = tid & 63, wr = wid >> 2, wc = wid & 3, fr = lane & 15, fq = lane >> 4;
    unsigned voffA[2], voffB[2];
#pragma unroll
    for (int i = 0; i < 2; ++i) { int R, C; stage_rc(tid * 16 + i * 8192, R, C); const int Rb = (R & ~31) + perm32(R & 31);
        voffA[i] = (unsigned)(R * g.lda + C) * 2u; voffB[i] = (unsigned)(Rb * g.ldb + C) * 2u; }
    const size_t kstep = (size_t)(BK * 2);
    const size_t hstepA = (size_t)HALF * g.lda * 2, hstepB = (size_t)HALF * g.ldb * 2;
    const size_t tstepA = 2 * hstepA, tstepB = 2 * hstepB;
    const unsigned ldsw = (unsigned)wid * 1024u;
    const int aoff = lds_byte(wr * 64 + fr, fq * 8), boff = lds_byte(wc * 32 + fr, fq * 8);
    LAS float* rtab = (LAS float*)(lds + STAGE_BYTES);
    f32x4 rt_a = {0.f, 0.f, 0.f, 0.f}, rt_b = rt_a, rt_c = rt_a, rt_d = rt_a;
#define PG8_RTAB_LOAD(pm_) do { if (ss) { const f32x4* p_ = (const f32x4*)(ss + ((size_t)(pm_) * 256 + (tid >> 1)) * 32 + (tid & 1) * 16); rt_a = p_[0]; rt_b = p_[1]; rt_c = p_[2]; rt_d = p_[3]; } } while (0)
#define PG8_RTAB_FIN(buf_) do { if (ss) { float s_ = (((rt_a[0] + rt_a[1]) + (rt_a[2] + rt_a[3])) + ((rt_b[0] + rt_b[1]) + (rt_b[2] + rt_b[3]))) + (((rt_c[0] + rt_c[1]) + (rt_c[2] + rt_c[3])) + ((rt_d[0] + rt_d[1]) + (rt_d[2] + rt_d[3]))); \
        s_ += __shfl_xor(s_, 1); if (!(tid & 1)) rtab[(buf_) * 256 + (tid >> 1)] = __builtin_amdgcn_rsqf(s_ * (1.0f / 1024.0f) + EPS); } } while (0)
#define PG8_SA(b, h) (((b) * 2 + (h)) * HTB)
#define PG8_SB(b, h) ((4 + (b) * 2 + (h)) * HTB)
#define PG8_STAGE(bufoff, gbase, voff) do { _Pragma("unroll") for (int _i = 0; _i < 2; ++_i) \
        __builtin_amdgcn_global_load_lds((const unsigned*)((const char*)(gbase) + (voff)[_i]), (LAS unsigned*)(lds + (bufoff) + ldsw + _i * 8192), 16, 0, 0); } while (0)
#define PG8_LDA(dst, b, h) do { _Pragma("unroll") for (int m = 0; m < 4; ++m) _Pragma("unroll") for (int k = 0; k < 2; ++k) dst[m][k] = *(const LAS bf16x8*)(lds + PG8_SA(b, h) + aoff + m * 2048 + k * 1024); } while (0)
#define PG8_LDB(dst, b, h) do { _Pragma("unroll") for (int n = 0; n < 2; ++n) _Pragma("unroll") for (int k = 0; k < 2; ++k) dst[n][k] = *(const LAS bf16x8*)(lds + PG8_SB(b, h) + boff + n * 2048 + k * 1024); } while (0)
#define PG8_MMA(ai, bj, At, Bt) do { __builtin_amdgcn_s_setprio(1); _Pragma("unroll") for (int m = 0; m < 4; ++m) _Pragma("unroll") for (int n = 0; n < 2; ++n) _Pragma("unroll") for (int k = 0; k < 2; ++k) \
        acc[ai][bj][m][n] = __builtin_amdgcn_mfma_f32_16x16x32_bf16(Bt[n][k], At[m][k], acc[ai][bj][m][n], 0, 0, 0); __builtin_amdgcn_s_setprio(0); } while (0)
#define PG8_WAIT_V(n) asm volatile("s_waitcnt vmcnt(" #n ")" ::: "memory")
#define PG8_WAIT_L(n) asm volatile("s_waitcnt lgkmcnt(" #n ")" ::: "memory")
#define PG8_BAR __builtin_amdgcn_s_barrier()
#define PG8_SCHED __builtin_amdgcn_sched_barrier(0)
    Unit cur, nxt; int ui = 0;
    if (!S.next(0, cur)) return;
    f32x4 acc[2][2][4][2];
#pragma unroll
    for (int a = 0; a < 2; ++a)
#pragma unroll
        for (int b = 0; b < 2; ++b)
#pragma unroll
            for (int m = 0; m < 4; ++m)
#pragma unroll
                for (int n = 0; n < 2; ++n) acc[a][b][m][n] = (f32x4){0.f, 0.f, 0.f, 0.f};
    bf16x8 At[4][2], B0[2][2], B1[2][2];
    const char* cA = (const char*)g.A + (size_t)cur.pm * tstepA + (size_t)cur.k0 * 2; const char* cB = (const char*)g.Bt + (size_t)cur.pn * tstepB + (size_t)cur.k0 * 2;
    PG8_RTAB_LOAD(cur.pm); PG8_RTAB_FIN(0);
    PG8_STAGE(PG8_SB(0, 0), cB, voffB); PG8_STAGE(PG8_SB(0, 1), cB + hstepB, voffB); PG8_STAGE(PG8_SA(0, 0), cA, voffA); PG8_STAGE(PG8_SA(0, 1), cA + hstepA, voffA);
    if (wr == 1) PG8_BAR;
    PG8_WAIT_V(2); PG8_BAR;
    PG8_STAGE(PG8_SB(1, 0), cB + kstep, voffB); PG8_STAGE(PG8_SA(1, 0), cA + kstep, voffA); PG8_STAGE(PG8_SB(1, 1), cB + hstepB + kstep, voffB);
    PG8_WAIT_V(6); PG8_BAR;
    for (;;) {
        const bool has_next = S.next(ui + 1, nxt);
        const char* nA = has_next ? (const char*)g.A + (size_t)nxt.pm * tstepA + (size_t)nxt.k0 * 2 : cA; const char* nB = has_next ? (const char*)g.Bt + (size_t)nxt.pn * tstepB + (size_t)nxt.k0 * 2 : cB;
        const int nt = cur.nt, qm = cur.qm;
        if (qm == 0xF) { PG8_KLOOP(true, true, true, true) } else { PG8_KLOOP((qm & 1), (qm & 2), (qm & 4), (qm & 8)) }
        if (wr == 0) PG8_BAR;
        if (has_next) PG8_RTAB_LOAD(nxt.pm);
        E(acc, cur, wr, wc, fr, fq, rtab + (ui & 1) * 256);
        if (!has_next) break;
#pragma unroll
        for (int a = 0; a < 2; ++a)
#pragma unroll
            for (int b = 0; b < 2; ++b)
#pragma unroll
                for (int m = 0; m < 4; ++m)
#pragma unroll
                    for (int n = 0; n < 2; ++n) acc[a][b][m][n] = (f32x4){0.f, 0.f, 0.f, 0.f};
        cur = nxt; cA = nA; cB = nB; ++ui;
        PG8_RTAB_FIN(ui & 1);
        if (wr == 1) PG8_BAR;
    }
    PG8_WAIT_V(0);
    PG8_BAR;
#undef PG8_SA
#undef PG8_RTAB_LOAD
#undef PG8_RTAB_FIN
#undef PG8_SB
#undef PG8_STAGE
#undef PG8_LDA
#undef PG8_LDB
#undef PG8_MMA
#undef PG8_WAIT_V
#undef PG8_WAIT_L
#undef PG8_BAR
#undef PG8_SCHED
}
}
using pg8::Unit;

#define EPI_FENCE() asm volatile("" ::: "memory")
struct EpiSwiglu {
    bf16_t* hid;
    __device__ __forceinline__ void operator()(const f32x4 (&acc)[2][2][4][2], const Unit& u, int wr, int wc, int fr, int fq, const LAS float* rt) const {
        const int row0 = u.pm * 256 + wr * 64 + fr, col = u.pn * 128 + wc * 32 + 8 * fq;
#pragma unroll
        for (int ai = 0; ai < 2; ++ai)
#pragma unroll
            for (int m = 0; m < 4; ++m) {
                const int rl = ai * 128 + m * 16; const int row = row0 + rl; const float rs = rt[wr * 64 + fr + rl];
                float h[8];
#pragma unroll
                for (int n = 0; n < 2; ++n)
#pragma unroll
                    for (int i = 0; i < 4; ++i) { const float a = acc[ai][0][m][n][i] * rs, b = acc[ai][1][m][n][i] * rs; h[4 * n + i] = a * sigm(a) * b; }
                u32x4 w; w.x = pk2(h[0], h[1]); w.y = pk2(h[2], h[3]); w.z = pk2(h[4], h[5]); w.w = pk2(h[6], h[7]);
                *(u32x4*)(hid + (size_t)row * FF + col) = w;
            }
    }
};
struct EpiWin {
    bf16_t* proj; float* out; int layer;
    __device__ __forceinline__ void operator()(const f32x4 (&acc)[2][2][4][2], const Unit& u, int wr, int wc, int fr, int fq, const LAS float* rt) const {
        const int row0 = u.pm * 256 + wr * 64 + fr, pn = u.pn;
        const bool isgate = (pn >= 10 && pn < 22), iskv = (pn >= 2 && pn < 6), ispool = (pn == 9);
#pragma unroll
        for (int ai = 0; ai < 2; ++ai)
#pragma unroll
            for (int m = 0; m < 4; ++m) {
                const int rl = ai * 128 + m * 16; const int row = row0 + rl; const float rs = rt[wr * 64 + fr + rl];
#pragma unroll
                for (int bj = 0; bj < 2; ++bj) {
                    if (!((u.qm >> (ai * 2 + bj)) & 1)) continue;
                    const int ct = bj * 128 + wc * 32 + 8 * fq;
                    f32x4 v0 = acc[ai][bj][m][0] * rs, v1 = acc[ai][bj][m][1] * rs;
                    if (isgate) {
#pragma unroll
                        for (int i = 0; i < 4; ++i) { v0[i] = sigm(v0[i]); v1[i] = sigm(v1[i]); }
                    }
                    u32x4 w; w.x = pk2(v0[0], v0[1]); w.y = pk2(v0[2], v0[3]); w.z = pk2(v1[0], v1[1]); w.w = pk2(v1[2], v1[3]);
                    *(u32x4*)(proj + (size_t)row * PW + pn * 256 + ct) = w;
                    if (iskv) {
                        const int c512 = (pn & 1) * 256 + ct; const bool isv = pn >= 4;
                        float* dst = row < MP ? out + (isv ? O_VP : O_KP) + ((size_t)layer * MP + row) * 512 + c512
                                              : out + (isv ? O_VS : O_KS) + ((size_t)layer * 2048 + (row - MP)) * 512 + c512;
                        *(f32x4*)dst = v0; *(f32x4*)(dst + 4) = v1;
                    }
                    if (ispool) {
                        if (row < MP) { const int t = row & 8191, b = row >> 13; if (t >= 8177) { float* dst = out + O_PP + ((size_t)(layer * 4 + b) * 15 + (t - 8177)) * 256 + ct; *(f32x4*)dst = v0; *(f32x4*)(dst + 4) = v1; } }
                        else { const int r = row - MP, t = r & 63, sb = r >> 6; if (t >= 49) { float* dst = out + O_PS + ((size_t)(layer * 32 + sb) * 15 + (t - 49)) * 256 + ct; *(f32x4*)dst = v0; *(f32x4*)(dst + 4) = v1; } }
                    }
                }
            }
    }
};
struct EpiRes {
    const bf16_t* xsrc; bf16_t* xb; float* ss_out; const bf16_t* scr; float alpha; int mode; const float* xin0; const float* xin1;
    __device__ __forceinline__ void operator()(const f32x4 (&acc)[2][2][4][2], const Unit& u, int wr, int wc, int fr, int fq, const LAS float* rt) const {
        const int row0 = u.pm * 256 + wr * 64 + fr, colb = u.pn * 256 + wc * 32 + 8 * fq;
        const float* xr = xin0 ? (u.pm < MP / 256 ? xin0 : xin1 - (size_t)MP * D) : nullptr;
#pragma unroll
        for (int ai = 0; ai < 2; ++ai) {
            if (!((u.qm >> (2 * ai)) & 3)) continue;
#pragma unroll
            for (int mp = 0; mp < 2; ++mp) {
                f32x4 xv[2][2][2]; u32x4 sv[2][2];
#pragma unroll
                for (int mi = 0; mi < 2; ++mi)
#pragma unroll
                    for (int bj = 0; bj < 2; ++bj) {
                        const size_t off = (size_t)(row0 + ai * 128 + (2 * mp + mi) * 16) * D + colb + bj * 128;
                        if (xr) { xv[mi][bj][0] = *(const f32x4*)(xr + off); xv[mi][bj][1] = *(const f32x4*)(xr + off + 4); }
                        else xv[mi][bj][0] = __builtin_bit_cast(f32x4, *(const u32x4*)(xsrc + off));
                        if (mode == 1) sv[mi][bj] = *(const u32x4*)(scr + off);
                    }
#pragma unroll
                for (int mi = 0; mi < 2; ++mi) {
                    const int m = 2 * mp + mi, rl = ai * 128 + m * 16, row = row0 + rl;
                    const float rs = (mode == 1) ? rt[wr * 64 + fr + rl] : 1.f;
#pragma unroll
                    for (int bj = 0; bj < 2; ++bj) {
                        if (!((u.qm >> (ai * 2 + bj)) & 1)) continue;
                        const size_t off = (size_t)row * D + colb + bj * 128;
                        f32x4 v0 = acc[ai][bj][m][0], v1 = acc[ai][bj][m][1];
                        if (mode == 1) {
#pragma unroll
                            for (int i = 0; i < 4; ++i) { v0[i] = sigm(v0[i] * rs); v1[i] = sigm(v1[i] * rs); }
                            { const u32x4 p4 = sv[mi][bj]; v0[0] *= bflo(p4.x); v0[1] *= bfhi(p4.x); v0[2] *= bflo(p4.y); v0[3] *= bfhi(p4.y); v1[0] *= bflo(p4.z); v1[1] *= bfhi(p4.z); v1[2] *= bflo(p4.w); v1[3] *= bfhi(p4.w); }
                        } else { v0 = v0 * alpha; v1 = v1 * alpha; }
                        f32x4 o0, o1;
                        if (xr) { o0 = xv[mi][bj][0]; o1 = xv[mi][bj][1]; }
                        else { const u32x4 h4 = __builtin_bit_cast(u32x4, xv[mi][bj][0]); o0 = (f32x4){bflo(h4.x), bfhi(h4.x), bflo(h4.y), bfhi(h4.y)}; o1 = (f32x4){bflo(h4.z), bfhi(h4.z), bflo(h4.w), bfhi(h4.w)}; }
                        const f32x4 x0 = o0 + v0, x1 = o1 + v1;
                        u32x4 w; w.x = pk2(x0[0], x0[1]); w.y = pk2(x0[2], x0[3]); w.z = pk2(x1[0], x1[1]); w.w = pk2(x1[2], x1[3]);
                        *(u32x4*)(xb + off) = w;
                        float ssum = (x0[0] * x0[0] + x0[1] * x0[1]) + (x0[2] * x0[2] + x0[3] * x0[3]) + (x1[0] * x1[0] + x1[1] * x1[1]) + (x1[2] * x1[2] + x1[3] * x1[3]);
                        ssum += __shfl_xor(ssum, 16); ssum += __shfl_xor(ssum, 32);
                        if (fq == 0) ss_out[(size_t)row * 32 + u.pn * 8 + bj * 4 + wc] = ssum;
                    }
                }
                EPI_FENCE();
            }
        }
    }
};
struct EpiBranch {
    const bf16_t* proj; bf16_t* scr; bf16_t* merged; int mode;
    template <int BR>
    __device__ __forceinline__ void run(const f32x4 (&acc)[2][2][4][2], const Unit& u, int wr, int wc, int fr, int fq) const {
        const int row0 = u.pm * 256 + wr * 64 + fr, colb = u.pn * 256 + wc * 32 + 8 * fq;
#pragma unroll
        for (int ai = 0; ai < 2; ++ai) {
            if (!((u.qm >> (2 * ai)) & 3)) continue;
#pragma unroll
            for (int mp = 0; mp < 2; ++mp) {
                u32x4 gt[2][2], sv[2][2];
#pragma unroll
                for (int mi = 0; mi < 2; ++mi)
#pragma unroll
                    for (int bj = 0; bj < 2; ++bj) {
                        const int row = row0 + ai * 128 + (2 * mp + mi) * 16, col = colb + bj * 128; const size_t off = (size_t)row * D + col;
                        if (BR < 3) gt[mi][bj] = *(const u32x4*)(proj + (size_t)row * PW + C_G + BR * 1024 + col);
                        if (BR == 1 || BR == 2) sv[mi][bj] = *(const u32x4*)(scr + off);
                    }
#pragma unroll
                for (int mi = 0; mi < 2; ++mi)
#pragma unroll
                    for (int bj = 0; bj < 2; ++bj) {
                        if (!((u.qm >> (ai * 2 + bj)) & 1)) continue;
                        const int m = 2 * mp + mi, row = row0 + ai * 128 + m * 16, col = colb + bj * 128; const size_t off = (size_t)row * D + col;
                        f32x4 v0 = acc[ai][bj][m][0], v1 = acc[ai][bj][m][1];
                        if (BR < 3) { const u32x4 g4 = gt[mi][bj];
                            v0[0] *= bflo(g4.x); v0[1] *= bfhi(g4.x); v0[2] *= bflo(g4.y); v0[3] *= bfhi(g4.y);
                            v1[0] *= bflo(g4.z); v1[1] *= bfhi(g4.z); v1[2] *= bflo(g4.w); v1[3] *= bfhi(g4.w); }
                        if (BR == 1 || BR == 2) { const u32x4 p4 = sv[mi][bj]; v0[0] += bflo(p4.x); v0[1] += bfhi(p4.x); v0[2] += bflo(p4.y); v0[3] += bfhi(p4.y); v1[0] += bflo(p4.z); v1[1] += bfhi(p4.z); v1[2] += bflo(p4.w); v1[3] += bfhi(p4.w); }
                        { u32x4 w; w.x = pk2(v0[0], v0[1]); w.y = pk2(v0[2], v0[3]); w.z = pk2(v1[0], v1[1]); w.w = pk2(v1[2], v1[3]); *(u32x4*)((BR == 2 ? merged : scr) + off) = w; }
                    }
                EPI_FENCE();
            }
        }
    }
    __device__ __forceinline__ void operator()(const f32x4 (&acc)[2][2][4][2], const Unit& u, int wr, int wc, int fr, int fq, const LAS float* rt) const {
        if (mode == 1) run<3>(acc, u, wr, wc, fr, fq);
        else if (u.kind == 0) run<0>(acc, u, wr, wc, fr, fq);
        else if (u.kind == 1) run<1>(acc, u, wr, wc, fr, fq);
        else run<2>(acc, u, wr, wc, fr, fq);
    }
};

struct Args { const float* in[29]; float* out; unsigned char* ws; int ph_lo, ph_hi; };
constexpr int NPH = 26;
constexpr int LDS_BYTES = 147456;

struct Ctx {
    const float* const* in; float* out; unsigned char* ws; LAS unsigned char* lds; unsigned char* ldsg; int tid, lane, wave, G, bx;
};

enum { MAP_ID = 0, MAP_SWIGLU = 1, MAP_WIN = 2 };
__device__ __forceinline__ int map_col(int mode, int n) {
    if (mode == MAP_ID) return n;
    if (mode == MAP_SWIGLU) { const int p = n >> 8, j = n & 255; return j < 128 ? p * 128 + j : FF + p * 128 + (j - 128); }
    if (n < 2048) return n;
    if (n < 2304) return 2064 + (n - 2048);
    if (n < 2560) return 2320 + (n - 2304);
    if (n < 5632) return 2576 + (n - 2560);
    if (n < 5648) return 2048 + (n - 5632);
    return -1;
}
__device__ __forceinline__ void tconv(const Ctx& c, const float* src, int ldsrc, int K, bf16_t* dst, int lddst, int Nout, int mode, const float* g, int& toff) {
    float* tile = (float*)c.ldsg;
    const int ntn = Nout / 64, ntk = K / 256, nt = ntn * ntk;
    const int first = (c.bx + c.G - (toff % c.G)) % c.G; toff += nt;
    for (int it = first; it < nt; it += c.G) {
        const int tn = it % ntn, tk = it / ntn, n0 = tn * 64, k0 = tk * 256;
        const int nn = c.tid & 63, sc = map_col(mode, n0 + nn), kq = c.tid >> 6;
        float v[32];
#pragma unroll
        for (int i = 0; i < 32; ++i) { const int kk = kq + 8 * i; v[i] = (sc >= 0) ? src[(size_t)(k0 + kk) * ldsrc + sc] : 0.f; }
        if (g) {
#pragma unroll
            for (int i = 0; i < 32; ++i) v[i] *= g[k0 + kq + 8 * i];
        }
#pragma unroll
        for (int i = 0; i < 32; ++i) tile[(kq + 8 * i) * 65 + nn] = v[i];
        __syncthreads();
        { const int n2 = c.tid >> 3, kg = c.tid & 7;
#pragma unroll
          for (int j = 0; j < 4; ++j) { const float* s = tile + (kg * 8 + 64 * j) * 65 + n2;
              u32x4 o; o.x = pk2(s[0], s[65]); o.y = pk2(s[130], s[195]); o.z = pk2(s[260], s[325]); o.w = pk2(s[390], s[455]);
              *(u32x4*)(dst + (size_t)(n0 + n2) * lddst + k0 + kg * 8 + 64 * j) = o; } }
        __syncthreads();
    }
}
__device__ __forceinline__ float wave_sum(float v) {
#pragma unroll
    for (int o = 1; o < 64; o <<= 1) v += __shfl_xor(v, o);
    return v;
}
__device__ __forceinline__ void prologue(const Ctx& c) {
    bf16_t* W = (bf16_t*)(c.ws + WS_W);
    int toff = 0;
    for (int l = 0; l < 2; ++l) {
        bf16_t* Wl = W + (size_t)l * WL_END;
        tconv(c, c.in[9] + (size_t)l * D * 2 * FF, 2 * FF, D, Wl + WL_1IN, D, 2 * FF, MAP_SWIGLU, c.in[8] + l * D, toff);
        tconv(c, c.in[10] + (size_t)l * FF * D, D, FF, Wl + WL_1OUT, FF, D, MAP_ID, nullptr, toff);
        tconv(c, c.in[12] + (size_t)l * D * INW, INW, D, Wl + WL_IN, D, NIN, MAP_WIN, c.in[11] + l * D, toff);
        tconv(c, c.in[18] + (size_t)l * 512 * D, D, 512, Wl + WL_BR, D, D, MAP_ID, nullptr, toff);
        tconv(c, c.in[19] + (size_t)l * 256 * D, D, 256, Wl + WL_BR + 512, D, D, MAP_ID, nullptr, toff);
        tconv(c, c.in[21] + (size_t)l * D * D, D, D, Wl + WL_OUT, D, D, MAP_ID, nullptr, toff);
        tconv(c, c.in[23] + (size_t)l * D * 2 * FF, 2 * FF, D, Wl + WL_2IN, D, 2 * FF, MAP_SWIGLU, c.in[22] + l * D, toff);
        tconv(c, c.in[24] + (size_t)l * FF * D, D, FF, Wl + WL_2OUT, FF, D, MAP_ID, nullptr, toff);
        tconv(c, c.in[26] + (size_t)l * D * D, D, D, Wl + WL_PG, D, D, MAP_ID, c.in[25] + l * D, toff);
        tconv(c, c.in[27] + (size_t)l * 256 * D, D, 256, Wl + WL_PP, 256, D, MAP_ID, nullptr, toff);
        const float* pw = c.in[16] + (size_t)l * 4 * 64 * 64; const float* psc = c.in[17] + l * 256; const float* wc = c.in[20] + (size_t)l * 256 * D;
        for (int idx = c.bx * 512 + c.tid; idx < 256 * 1024; idx += c.G * 512) {
            const int n = idx & 1023, kc = idx >> 10, gq = kc >> 6, cc = kc & 63; float s = 0.f;
            for (int dd = 0; dd < 64; ++dd) s += pw[(gq * 64 + cc) * 64 + dd] * psc[gq * 64 + dd] * wc[(size_t)(gq * 64 + dd) * D + n];
            Wl[WL_BR + (size_t)n * D + 768 + kc] = (bf16_t)f2bf(s);
        }
    }
    bf16_t* xb = (bf16_t*)(c.ws + WS_XB); float* ss0 = (float*)(c.ws + WS_SS);
    for (int row = c.bx * 8 + c.wave; row < M; row += c.G * 8) {
        const float* src = row < MP ? c.in[0] + (size_t)row * D : c.in[1] + (size_t)(row - MP) * D;
        f32x4 v[4]; float s = 0.f;
#pragma unroll
        for (int j = 0; j < 4; ++j) { v[j] = *(const f32x4*)(src + c.lane * 4 + 256 * j); s += (v[j][0] * v[j][0] + v[j][1] * v[j][1]) + (v[j][2] * v[j][2] + v[j][3] * v[j][3]); }
        s = wave_sum(s);
#pragma unroll
        for (int j = 0; j < 4; ++j) { u32x2 w; w.x = pk2(v[j][0], v[j][1]); w.y = pk2(v[j][2], v[j][3]); *(u32x2*)(xb + (size_t)row * D + c.lane * 4 + 256 * j) = w; }
        if (c.lane < 32) ss0[(size_t)row * 32 + c.lane] = c.lane == 0 ? s : 0.f;
    }
    bf16_t* pb = (bf16_t*)(c.ws + WS_PB);
#pragma unroll 4
    for (size_t i4 = (size_t)c.bx * 512 + c.tid; i4 < (size_t)2 * M * 64; i4 += (size_t)c.G * 512) {
        const size_t e = i4 * 4; const int l = (int)(e / ((size_t)M * 256)); const size_t r = e - (size_t)l * M * 256; const int row = (int)(r >> 8), cc = (int)(r & 255);
        const float* src = row < MP ? c.in[6] + ((size_t)l * MP + row) * 256 + cc : c.in[7] + ((size_t)l * 2048 + (row - MP)) * 256 + cc;
        const f32x4 v = *(const f32x4*)src; u32x2 w; w.x = pk2(v[0], v[1]); w.y = pk2(v[2], v[3]); *(u32x2*)(pb + e) = w;
    }
}

__device__ __forceinline__ int next_item(const Ctx& c, int slot) {
    volatile int* sh = (volatile int*)(c.ldsg + 147392);
    __syncthreads();
    if (c.tid == 0) *sh = (int)__hip_atomic_fetch_add((unsigned*)(c.ws + WS_CTL) + 64 * (1 + slot), 1u, __ATOMIC_RELAXED, __HIP_MEMORY_SCOPE_AGENT);
    __syncthreads();
    return *sh;
}
__device__ __forceinline__ void gla_local_unit(const Ctx& c, int l, int g, int h) {
    float* L = (float*)c.ldsg; float* rs = L; float* wg = L + 1024; float* bg = L + 1536; float* la = L + 1600; float* kt = L + 3712; float* vs = L + 5824;
    const bf16_t* proj = (const bf16_t*)(c.ws + WS_BIG); const int m0 = g * 64, tid = c.tid;
    { const int e = tid * 2, row = e >> 4, cc = e & 15; const unsigned w = *(const unsigned*)(proj + (size_t)(m0 + row) * PW + C_RB + cc); rs[e] = bflo(w); rs[e + 1] = bfhi(w); }
    { const int j = tid >> 5, d = tid & 31; wg[tid] = c.in[13][(size_t)(l * 16 + j) * 128 + h * 32 + d]; }
    if (tid < 32) bg[tid] = c.in[14][l * 128 + h * 32 + tid];
    __syncthreads();
#pragma unroll
    for (int i = 0; i < 4; ++i) { const int o = tid + 512 * i, t = o >> 5, d = o & 31; float a = bg[d];
#pragma unroll
        for (int j = 0; j < 16; ++j) a += rs[t * 16 + j] * wg[j * 32 + d];
        la[t * 33 + d] = (fminf(a, 0.f) - flog(1.0f + fexp(-fabsf(a)))) * (1.0f / 16.0f); }
    __syncthreads();
    {
#pragma unroll
        for (int j = 0; j < 4; ++j) { const int d = c.wave * 4 + j; float v = la[c.lane * 33 + d];
#pragma unroll
            for (int o = 1; o < 64; o <<= 1) { const float n = __shfl_up(v, o); if (c.lane >= o) v += n; }
            la[c.lane * 33 + d] = v; }
    }
    __syncthreads();
    float* bws = (float*)(c.ws + WS_B);
#pragma unroll
    for (int i = 0; i < 4; ++i) { const int o = tid + 512 * i, t = o >> 5, d = o & 31; const float b = la[t * 33 + d];
        bws[(size_t)(m0 + t) * 128 + h * 32 + d] = b;
        kt[t * 33 + d] = bf2f(proj[(size_t)(m0 + t) * PW + C_KB + h * 32 + d]) * fexp(-b); }
    { const int t = tid >> 3, e0 = (tid & 7) * 8; const u32x4 w = *(const u32x4*)(proj + (size_t)(m0 + t) * PW + C_VB + h * 64 + e0); float* d = vs + t * 64 + e0;
      d[0] = bflo(w.x); d[1] = bfhi(w.x); d[2] = bflo(w.y); d[3] = bfhi(w.y); d[4] = bflo(w.z); d[5] = bfhi(w.z); d[6] = bflo(w.w); d[7] = bfhi(w.w); }
    __syncthreads();
    { const int d = tid >> 4, e0 = (tid & 15) * 4; f32x4 a = {0.f, 0.f, 0.f, 0.f};
      for (int t = 0; t < 64; ++t) { const float kk = kt[t * 33 + d]; const f32x4 v = *(const f32x4*)(vs + t * 64 + e0); a = a + v * kk; }
      *(f32x4*)((float*)(c.ws + WS_DS) + ((size_t)(g * 4 + h) * 32 + d) * 64 + e0) = a; }
    if (tid < 32) ((float*)(c.ws + WS_DEC))[(size_t)(g * 4 + h) * 32 + tid] = fexp(la[63 * 33 + tid]);
    __syncthreads();
}
__device__ __forceinline__ void pool_unit(const Ctx& c, int l, int g) {
    float* ext = (float*)c.ldsg;
    const bf16_t* proj = (const bf16_t*)(c.ws + WS_BIG); bf16_t* Y = (bf16_t*)(c.ws + WS_Y);
    const int m0 = g * 64, tid = c.tid; const bool samp = g >= 512; const int cidx = samp ? 0 : (g & 127);
#pragma unroll
    for (int it = 0; it < 5; ++it) { const int q = tid + 512 * it;
        if (q < 79 * 32) { const int j = q >> 5, c8 = (q & 31) * 8; float* d = ext + j * 256 + c8;
            if (j >= 15 || cidx > 0) { const u32x4 w = *(const u32x4*)(proj + (size_t)(m0 + j - 15) * PW + C_UC + c8);
                *(f32x4*)d = (f32x4){bflo(w.x), bfhi(w.x), bflo(w.y), bfhi(w.y)}; *(f32x4*)(d + 4) = (f32x4){bflo(w.z), bfhi(w.z), bflo(w.w), bfhi(w.w)}; }
            else if (samp) { const float* sp = c.in[5] + ((size_t)(l * 32 + (g - 512)) * 15 + j) * 256 + c8; *(f32x4*)d = *(const f32x4*)sp; *(f32x4*)(d + 4) = *(const f32x4*)(sp + 4); }
            else { *(f32x4*)d = (f32x4){0.f, 0.f, 0.f, 0.f}; *(f32x4*)(d + 4) = (f32x4){0.f, 0.f, 0.f, 0.f}; } } }
    __syncthreads();
    { const int cc = tid & 255, ts = tid >> 8, gi = cc >> 6, w = 2 << gi;
      for (int i = 0; i < 32; ++i) { const int t = ts * 32 + i; float s = 0.f;
          for (int j = 0; j < w; ++j) s += ext[(15 + t - j) * 256 + cc];
          const int pos = samp ? 2048 + t : cidx * 64 + t; const float cnt = (float)min(w, pos + 1);
          const float dv = s / cnt - ext[(15 + t) * 256 + cc];
          Y[(size_t)(m0 + t) * D + 768 + cc] = (bf16_t)f2bf(dv); } }
    __syncthreads();
}

__device__ __forceinline__ void scan_unit(const Ctx& c, int l, int su) {
    const float* dS = (const float*)(c.ws + WS_DS); const float* dec = (const float*)(c.ws + WS_DEC); float* St = (float*)(c.ws + WS_ST);
    int g0, n, h, idx; float S; float* outp;
    if (su < 64) { const int bh = su >> 2, b = bh >> 2; h = bh & 3; idx = (su & 3) * 512 + c.tid; g0 = b * 128; n = 128; S = 0.f; outp = c.out + O_GP + ((size_t)(l * 4 + b) * 4 + h) * 2048 + idx; }
    else { const int s2 = su - 64, sbh = s2 >> 2, sb = sbh >> 2; h = sbh & 3; idx = (s2 & 3) * 512 + c.tid; g0 = 512 + sb; n = 1; S = c.in[4][((size_t)(l * 32 + sb) * 4 + h) * 2048 + idx]; outp = c.out + O_GS + ((size_t)(l * 32 + sb) * 4 + h) * 2048 + idx; }
    const int d = idx >> 6;
#pragma unroll 8
    for (int cc = 0; cc < n; ++cc) { const size_t gh = (size_t)(g0 + cc) * 4 + h; const float dd = dS[gh * 2048 + idx], de = dec[gh * 32 + d]; St[gh * 2048 + idx] = S; S = de * (S + dd); }
    *outp = S;
}
__device__ __forceinline__ void attn_unit(const Ctx& c, int l, int au) {
    bf16_t* Ks = (bf16_t*)c.ldsg; bf16_t* Vt = (bf16_t*)(c.ldsg + 18432); int* flags = (int*)(c.ldsg + 35840);
    const bf16_t* proj = (const bf16_t*)(c.ws + WS_BIG); bf16_t* Y = (bf16_t*)(c.ws + WS_Y);
    int R0, n_past, qb, hp, sb = 0;
    if (au < 2048) { const int b = au >> 9, rem = au & 511; qb = rem >> 2; hp = rem & 3; R0 = b * 8192; n_past = 0; }
    else { const int a2 = au - 2048; sb = a2 >> 2; hp = a2 & 3; qb = 0; R0 = MP + sb * 64; n_past = 2048; }
    const int tid = c.tid, w = c.wave, lane = c.lane, fr = lane & 15, fq = lane >> 4, hsel = w >> 2, hh = 2 * hp + hsel, qsub = w & 3;
    const int qrow = R0 + qb * 64 + qsub * 16 + fr, qpos = n_past + qb * 64 + qsub * 16 + fr;
    bf16x8 qf[2];
#pragma unroll
    for (int ks = 0; ks < 2; ++ks) qf[ks] = *(const bf16x8*)(proj + (size_t)qrow * PW + C_QA + hh * 64 + 32 * ks + 8 * fq);
    f32x4 O[4];
#pragma unroll
    for (int i = 0; i < 4; ++i) O[i] = (f32x4){0.f, 0.f, 0.f, 0.f};
    float carry = 0.f; bool wdone = false;
    int kt = (n_past + qb * 64) >> 6;
    const int lh = tid >> 8, lj = (tid >> 2) & 63, d0 = (tid & 3) * 16, lhead = 2 * hp + lh;
    for (;;) {
        {
            const int kpos = kt * 64 + lj; unsigned kk[8], vv[8];
            if (kpos < n_past) {
                const size_t o = (((size_t)(l * 32 + sb) * 2048 + kpos) * 512) + lhead * 64 + d0; const float* kp = c.in[2] + o; const float* vp = c.in[3] + o;
#pragma unroll
                for (int i = 0; i < 4; ++i) { const f32x4 a = *(const f32x4*)(kp + 4 * i), b = *(const f32x4*)(vp + 4 * i); kk[2 * i] = pk2(a[0], a[1]); kk[2 * i + 1] = pk2(a[2], a[3]); vv[2 * i] = pk2(b[0], b[1]); vv[2 * i + 1] = pk2(b[2], b[3]); }
            } else {
                const bf16_t* rp = proj + (size_t)(R0 + kpos - n_past) * PW + lhead * 64 + d0;
                const u32x4 a0 = *(const u32x4*)(rp + C_KA), a1 = *(const u32x4*)(rp + C_KA + 8), b0 = *(const u32x4*)(rp + C_VA), b1 = *(const u32x4*)(rp + C_VA + 8);
                kk[0] = a0.x; kk[1] = a0.y; kk[2] = a0.z; kk[3] = a0.w; kk[4] = a1.x; kk[5] = a1.y; kk[6] = a1.z; kk[7] = a1.w;
                vv[0] = b0.x; vv[1] = b0.y; vv[2] = b0.z; vv[3] = b0.w; vv[4] = b1.x; vv[5] = b1.y; vv[6] = b1.z; vv[7] = b1.w;
            }
            bf16_t* kd = Ks + (lh * 64 + lj) * 72 + d0;
            *(u32x4*)kd = (u32x4){kk[0], kk[1], kk[2], kk[3]}; *(u32x4*)(kd + 8) = (u32x4){kk[4], kk[5], kk[6], kk[7]};
#pragma unroll
            for (int i = 0; i < 8; ++i) { Vt[(lh * 64 + d0 + 2 * i) * 68 + lj] = (bf16_t)(vv[i] & 0xffffu); Vt[(lh * 64 + d0 + 2 * i + 1) * 68 + lj] = (bf16_t)(vv[i] >> 16); }
        }
        __syncthreads();
        {
            f32x4 sa[4];
#pragma unroll
            for (int u = 0; u < 4; ++u) { sa[u] = (f32x4){0.f, 0.f, 0.f, 0.f};
#pragma unroll
                for (int ks = 0; ks < 2; ++ks) { const bf16x8 kf = *(const bf16x8*)(Ks + (hsel * 64 + 16 * u + fr) * 72 + 32 * ks + 8 * fq); sa[u] = __builtin_amdgcn_mfma_f32_16x16x32_bf16(kf, qf[ks], sa[u], 0, 0, 0); } }
            float lk[4][4], lw[4][4], ls[4], suf[4], T[4];
#pragma unroll
            for (int u = 0; u < 4; ++u) { ls[u] = 0.f;
#pragma unroll
                for (int i = 0; i < 4; ++i) { const float z = sa[u][i] * 0.125f; const int kpos = kt * 64 + 16 * u + 4 * fq + i; const bool valid = kpos < qpos;
                    const float sp = softplus(z); lk[u][i] = valid ? -sp : 0.f; lw[u][i] = valid ? (z - sp) : -1e30f; ls[u] += lk[u][i]; } }
#pragma unroll
            for (int u = 0; u < 4; ++u) { const float a = __shfl_xor(ls[u], 16), t1 = ls[u] + a, o = __shfl_xor(t1, 32); T[u] = t1 + o; suf[u] = ((fq & 1) ? 0.f : a) + ((fq & 2) ? 0.f : o); }
            float base = carry; float wv[4][4];
#pragma unroll
            for (int u = 3; u >= 0; --u) { float run = base + suf[u];
#pragma unroll
                for (int i = 3; i >= 0; --i) { wv[u][i] = fexp(lw[u][i] + run); run += lk[u][i]; }
                base += T[u]; }
            carry = base;
#pragma unroll
            for (int k2 = 0; k2 < 2; ++k2) {
                u32x4 pw; pw.x = pk2(wv[2 * k2][0], wv[2 * k2][1]); pw.y = pk2(wv[2 * k2][2], wv[2 * k2][3]); pw.z = pk2(wv[2 * k2 + 1][0], wv[2 * k2 + 1][1]); pw.w = pk2(wv[2 * k2 + 1][2], wv[2 * k2 + 1][3]);
                const bf16x8 pf = __builtin_bit_cast(bf16x8, pw);
#pragma unroll
                for (int db = 0; db < 4; ++db) { const bf16_t* vp = Vt + (hsel * 64 + 16 * db + fr) * 68 + 32 * k2 + 4 * fq; const u32x2 lo = *(const u32x2*)vp, hi = *(const u32x2*)(vp + 16);
                    const bf16x8 vf = __builtin_bit_cast(bf16x8, (u32x4){lo.x, lo.y, hi.x, hi.y}); O[db] = __builtin_amdgcn_mfma_f32_16x16x32_bf16(vf, pf, O[db], 0, 0, 0); }
            }
            wdone = __all(carry < -46.f) != 0;
        }
        --kt;
        if (lane == 0) flags[w] = wdone ? 1 : 0;
        __syncthreads();
        int alld = 1;
#pragma unroll
        for (int i = 0; i < 8; ++i) alld &= flags[i];
        if (alld || kt < 0) break;
    }
#pragma unroll
    for (int db = 0; db < 4; ++db) { u32x2 o; o.x = pk2(O[db][0], O[db][1]); o.y = pk2(O[db][2], O[db][3]); *(u32x2*)(Y + (size_t)qrow * D + hh * 64 + 16 * db + 4 * fq) = o; }
    __syncthreads();
}

__device__ __forceinline__ void gla_out_unit(const Ctx& c, int l, int g, int h) {
    bf16_t* Qs = (bf16_t*)c.ldsg; bf16_t* Ks = Qs + 2560; bf16_t* Vt = Ks + 2560; bf16_t* ST = Vt + 4608; float* red = (float*)(ST + 2560);
    const bf16_t* proj = (const bf16_t*)(c.ws + WS_BIG); bf16_t* Y = (bf16_t*)(c.ws + WS_Y); const float* bws = (const float*)(c.ws + WS_B);
    const int m0 = g * 64, tid = c.tid, w = c.wave, lane = c.lane, fr = lane & 15, fq = lane >> 4;
    {
        const int t = tid >> 3, d0 = (tid & 7) * 4, e0 = (tid & 7) * 8;
        const f32x4 b4 = *(const f32x4*)(bws + (size_t)(m0 + t) * 128 + h * 32 + d0);
        const u32x2 q2 = *(const u32x2*)(proj + (size_t)(m0 + t) * PW + C_QB + h * 32 + d0), k2 = *(const u32x2*)(proj + (size_t)(m0 + t) * PW + C_KB + h * 32 + d0);
        const u32x4 v4 = *(const u32x4*)(proj + (size_t)(m0 + t) * PW + C_VB + h * 64 + e0);
        const int sd = tid >> 4, se0 = (tid & 15) * 4;
        const f32x4 s4 = *(const f32x4*)((const float*)(c.ws + WS_ST) + (size_t)(g * 4 + h) * 2048 + sd * 64 + se0);
        const float qv[4] = {bflo(q2.x), bfhi(q2.x), bflo(q2.y), bfhi(q2.y)}, kv[4] = {bflo(k2.x), bfhi(k2.x), bflo(k2.y), bfhi(k2.y)};
        float qo[4], ko[4];
#pragma unroll
        for (int i = 0; i < 4; ++i) { qo[i] = qv[i] * 0.17677669529663687f * fexp(b4[i]); ko[i] = kv[i] * fexp(-b4[i]); }
        *(u32x2*)(Qs + t * 40 + d0) = (u32x2){pk2(qo[0], qo[1]), pk2(qo[2], qo[3])};
        *(u32x2*)(Ks + t * 40 + d0) = (u32x2){pk2(ko[0], ko[1]), pk2(ko[2], ko[3])};
        const unsigned vw[4] = {v4.x, v4.y, v4.z, v4.w};
#pragma unroll
        for (int i = 0; i < 4; ++i) { Vt[(e0 + 2 * i) * 72 + t] = (bf16_t)(vw[i] & 0xffffu); Vt[(e0 + 2 * i + 1) * 72 + t] = (bf16_t)(vw[i] >> 16); }
#pragma unroll
        for (int i = 0; i < 4; ++i) ST[(se0 + i) * 40 + sd] = (bf16_t)f2bf(s4[i]);
    }
    __syncthreads();
    const int tb = w & 3, ebase = (w >> 2) * 2, tl = 16 * tb + fr;
    const bf16x8 qf = *(const bf16x8*)(Qs + tl * 40 + 8 * fq);
    f32x4 sa[4];
#pragma unroll
    for (int u = 0; u < 4; ++u) { sa[u] = (f32x4){0.f, 0.f, 0.f, 0.f};
        if (u <= tb) { const bf16x8 kf = *(const bf16x8*)(Ks + (16 * u + fr) * 40 + 8 * fq); sa[u] = __builtin_amdgcn_mfma_f32_16x16x32_bf16(kf, qf, sa[u], 0, 0, 0);
            if (u == tb) {
#pragma unroll
                for (int i = 0; i < 4; ++i) sa[u][i] = (4 * fq + i <= fr) ? sa[u][i] : 0.f; } } }
    f32x4 O[2];
#pragma unroll
    for (int eb = 0; eb < 2; ++eb) {
        const int erow = 16 * (ebase + eb) + fr;
        const bf16x8 stf = *(const bf16x8*)(ST + erow * 40 + 8 * fq);
        O[eb] = __builtin_amdgcn_mfma_f32_16x16x32_bf16(stf, qf, (f32x4){0.f, 0.f, 0.f, 0.f}, 0, 0, 0);
#pragma unroll
        for (int k2 = 0; k2 < 2; ++k2) {
            if (2 * k2 <= tb) {
                u32x4 pw; pw.x = pk2(sa[2 * k2][0], sa[2 * k2][1]); pw.y = pk2(sa[2 * k2][2], sa[2 * k2][3]); pw.z = pk2(sa[2 * k2 + 1][0], sa[2 * k2 + 1][1]); pw.w = pk2(sa[2 * k2 + 1][2], sa[2 * k2 + 1][3]);
                const bf16_t* vp = Vt + erow * 72 + 32 * k2 + 4 * fq; const u32x2 lo = *(const u32x2*)vp, hi = *(const u32x2*)(vp + 16);
                O[eb] = __builtin_amdgcn_mfma_f32_16x16x32_bf16(__builtin_bit_cast(bf16x8, (u32x4){lo.x, lo.y, hi.x, hi.y}), __builtin_bit_cast(bf16x8, pw), O[eb], 0, 0, 0);
            }
        }
    }
    float q2s = 0.f;
#pragma unroll
    for (int eb = 0; eb < 2; ++eb)
#pragma unroll
        for (int i = 0; i < 4; ++i) q2s += O[eb][i] * O[eb][i];
    q2s += __shfl_xor(q2s, 16); q2s += __shfl_xor(q2s, 32);
    if (fq == 0) red[w * 16 + fr] = q2s;
    __syncthreads();
    const float r = __builtin_amdgcn_rsqf((red[w * 16 + fr] + red[(w ^ 4) * 16 + fr]) * (1.0f / 64.0f) + EPS);
#pragma unroll
    for (int eb = 0; eb < 2; ++eb) {
        const int ecol = h * 64 + 16 * (ebase + eb) + 4 * fq;
        const u32x2 ow = *(const u32x2*)(proj + (size_t)(m0 + tl) * PW + C_OB + ecol); const f32x4 gn = *(const f32x4*)(c.in[15] + l * 256 + ecol);
        const float ob[4] = {bflo(ow.x), bfhi(ow.x), bflo(ow.y), bfhi(ow.y)}; float y[4];
#pragma unroll
        for (int i = 0; i < 4; ++i) y[i] = O[eb][i] * r * gn[i] * (ob[i] * sigm(ob[i]));
        *(u32x2*)(Y + (size_t)(m0 + tl) * D + 512 + ecol) = (u32x2){pk2(y[0], y[1]), pk2(y[2], y[3])};
    }
    __syncthreads();
}

__device__ __forceinline__ void grid_bar(unsigned* ctl, unsigned r) {
    asm volatile("s_waitcnt vmcnt(0)" ::: "memory");
    __syncthreads();
    if (threadIdx.x == 0) {
        const unsigned g = blockIdx.x & 7u, G = gridDim.x, nloc = (G - g + 7u) >> 3, ngrp = G < 8u ? G : 8u;
        unsigned* cnt = ctl + 64 * (16 + g); unsigned* gen = ctl + 64 * (24 + g); unsigned* top = ctl + 64 * 32;
        __builtin_amdgcn_fence(__ATOMIC_RELEASE, "agent");
        asm volatile("s_waitcnt vmcnt(0)" ::: "memory");
        const unsigned old = __hip_atomic_fetch_add(cnt, 1u, __ATOMIC_RELAXED, __HIP_MEMORY_SCOPE_AGENT);
        if (old + 1u == r * nloc) {
            __hip_atomic_fetch_add(top, 1u, __ATOMIC_RELAXED, __HIP_MEMORY_SCOPE_AGENT);
            while (__hip_atomic_load(top, __ATOMIC_RELAXED, __HIP_MEMORY_SCOPE_AGENT) < r * ngrp) __builtin_amdgcn_s_sleep(1);
            __hip_atomic_store(gen, r, __ATOMIC_RELAXED, __HIP_MEMORY_SCOPE_AGENT);
        } else {
            while (__hip_atomic_load(gen, __ATOMIC_RELAXED, __HIP_MEMORY_SCOPE_AGENT) < r) __builtin_amdgcn_s_sleep(1);
        }
        __builtin_amdgcn_fence(__ATOMIC_ACQUIRE, "agent");
        asm volatile("s_waitcnt vmcnt(0)" ::: "memory");
    }
    __syncthreads();
}

__global__ void __launch_bounds__(512, 2) fwd_mega(Args args) {
    extern __shared__ __attribute__((aligned(16))) unsigned char lds[];
    cg::grid_group grid = cg::this_grid();
    Ctx c; c.in = args.in; c.out = args.out; c.ws = args.ws; c.lds = (LAS unsigned char*)lds; c.ldsg = lds;
    c.tid = threadIdx.x; c.lane = c.tid & 63; c.wave = __builtin_amdgcn_readfirstlane(c.tid >> 6); c.G = gridDim.x; c.bx = blockIdx.x;
    for (int ph = args.ph_lo; ph < args.ph_hi; ++ph) {
        { int t_ = threadIdx.x; asm volatile("" : "+v"(t_)); c.tid = t_; c.lane = t_ & 63; c.wave = __builtin_amdgcn_readfirstlane(t_ >> 6); }
        unsigned char* ws = args.ws; float* outp = args.out; asm volatile("" : "+s"(ws), "+s"(outp)); c.ws = ws; c.out = outp;
        bf16_t* xb = (bf16_t*)(ws + WS_XB); bf16_t* big = (bf16_t*)(ws + WS_BIG); bf16_t* Yb = (bf16_t*)(ws + WS_Y); bf16_t* mg = (bf16_t*)(ws + WS_MG);
        float* scr = (float*)(ws + WS_SCR); float* ss0 = (float*)(ws + WS_SS); float* ss1 = ss0 + (size_t)M * 32; float* xw = outp + O_Y;
        if (ph == 0) prologue(c);
        else if (ph == 25) {
            const float* gf = args.in[28];
            for (int row = c.bx * 8 + c.wave; row < M; row += c.G * 8) { const float rs = rstd_of(ss0, row);
#pragma unroll
                for (int j = 0; j < 4; ++j) { const u32x2 h2 = *(const u32x2*)(mg + (size_t)row * D + c.lane * 4 + 256 * j); const f32x4 v = {bflo(h2.x), bfhi(h2.x), bflo(h2.y), bfhi(h2.y)}, gg = *(const f32x4*)(gf + c.lane * 4 + 256 * j);
                    *(f32x4*)(xw + (size_t)row * D + c.lane * 4 + 256 * j) = v * rs * gg; } }
        } else {
            const int l = (ph - 1) / 12, k = (ph - 1) % 12;
            if ((MK_SKIPMASK >> k) & 1) continue;
            const bf16_t* Wl = (const bf16_t*)(ws + WS_W) + (size_t)l * WL_END;
            if (k == 0 || k == 8) {
                pg8::Gemm g{(k == 0 && l > 0) ? mg : xb, Wl + (k == 0 ? WL_1IN : WL_2IN), D, D}; pg8::Sched S;     S.init(M, 2 * FF, c.G, c.bx, 16);
                EpiSwiglu E{big}; pg8::gemm_phase(c.lds, c.tid, g, S, E, ss0);
            } else if (k == 1 || k == 9 || k == 7 || k == 11) {
                pg8::Gemm g; pg8::Sched S; EpiRes E{xb, xb, nullptr, (const bf16_t*)scr, 1.f, 0, nullptr, nullptr}; const float* ssin = nullptr;
                if (k == 1 || k == 9) { g = pg8::Gemm{big, Wl + (k == 1 ? WL_1OUT : WL_2OUT), FF, FF}; S.init(M, D, c.G, c.bx, 44); S.quart = 1; E.alpha = 0.5f; E.ss_out = ss1; if (k == 1) { if (l == 0) { E.xin0 = args.in[0]; E.xin1 = args.in[1]; } else E.xsrc = mg; } }
                else if (k == 7) { g = pg8::Gemm{mg, Wl + WL_OUT, D, D}; S.init(M, D, c.G, c.bx, 16); S.quart = 1; E.ss_out = ss0; }
                else { g = pg8::Gemm{xb, Wl + WL_PG, D, D}; S.init(M, D, c.G, c.bx, 16); S.quart = 1; E.ss_out = ss0; ssin = ss1; E.mode = 1; E.xb = mg; }
                pg8::gemm_phase(c.lds, c.tid, g, S, E, ssin);
            } else if (k == 2) {
                pg8::Gemm g{xb, Wl + WL_IN, D, D}; pg8::Sched S; S.init(M, NIN, c.G, c.bx, 16); S.quart = 1;
                EpiWin E{big, outp, l}; pg8::gemm_phase(c.lds, c.tid, g, S, E, ss1);
            } else if (k == 3) {
                for (int it = next_item(c, l * 3 + 0); it < 2176 + NCH; it = next_item(c, l * 3 + 0)) { if (it < NCH) pool_unit(c, l, it); else gla_local_unit(c, l, (it - NCH) >> 2, (it - NCH) & 3); }
            } else if (k == 4) {
                for (int it = next_item(c, l * 3 + 1); it < 576 + 2176; it = next_item(c, l * 3 + 1)) { if (it < 576) scan_unit(c, l, it); else attn_unit(c, l, it - 576); }
            } else if (k == 5) {
                for (int it = next_item(c, l * 3 + 2); it < 2176; it = next_item(c, l * 3 + 2)) gla_out_unit(c, l, it >> 2, it & 3);
            } else {
                pg8::Gemm g; pg8::Sched S; EpiBranch E{big, (bf16_t*)scr, mg, 0};
                if (k == 6) { g = pg8::Gemm{Yb, Wl + WL_BR, D, D}; S.init(M, D, c.G, c.bx, 8); S.nsub = 3; S.quart = 1; }
                else { g = pg8::Gemm{(const bf16_t*)(ws + WS_PB) + (size_t)l * M * 256, Wl + WL_PP, 256, 256}; S.init(M, D, c.G, c.bx, 4); S.quart = 1; E.mode = 1; }
                pg8::gemm_phase(c.lds, c.tid, g, S, E, nullptr);
            }
        }
        if (ph + 1 < args.ph_hi) { if (args.ph_hi > 4096) grid.sync(); grid_bar((unsigned*)(args.ws + WS_CTL), (unsigned)(ph - args.ph_lo + 1)); }
    }
}

extern "C" void kernel_launch(void* const* d_in, const int* in_sizes, int n_in, void* d_out, int out_size, void* d_ws, size_t ws_size, hipStream_t stream) {
    static int grid = 0;
    if (grid == 0) {
        if (n_in != 29 || ws_size < WS_NEED) { fprintf(stderr, "kernel_launch: unexpected n_in %d / ws %zu\n", n_in, ws_size); grid = -1; return; }
        int dev = 0, cus = 0, per_cu = 0;
        (void)hipGetDevice(&dev); (void)hipDeviceGetAttribute(&cus, hipDeviceAttributeMultiprocessorCount, dev);
        (void)hipFuncSetAttribute((const void*)fwd_mega, hipFuncAttributeMaxDynamicSharedMemorySize, LDS_BYTES);
        (void)hipOccupancyMaxActiveBlocksPerMultiprocessor(&per_cu, (const void*)fwd_mega, 512, LDS_BYTES);
        (void)hipGetLastError();
        if (per_cu < 1) per_cu = 1;
        grid = cus;
    }
    if (grid < 0) return;
    (void)hipMemsetAsync((char*)d_ws + WS_CTL, 0, 16384, stream);
    Args a{};
    for (int i = 0; i < 29; ++i) a.in[i] = (const float*)d_in[i];
    a.out = (float*)d_out; a.ws = (unsigned char*)d_ws;
#if MK_ONE_LAUNCH
    a.ph_lo = 0; a.ph_hi = NPH;
    void* kargs[] = {&a};
    hipError_t e = hipLaunchCooperativeKernel((const void*)fwd_mega, dim3(grid), dim3(512), kargs, LDS_BYTES, stream);
    if (e != hipSuccess) fprintf(stderr, "cooperative launch failed: %s (grid %d)\n", hipGetErrorString(e), grid);
#else
    for (int ph = 0; ph < NPH; ++ph) { a.ph_lo = ph; a.ph_hi = ph + 1; hipLaunchKernelGGL(fwd_mega, dim3(grid), dim3(512), LDS_BYTES, stream, a); }
#endif
}
```

```cpp
#include <hip/hip_runtime.h>
#include <hip/hip_cooperative_groups.h>
#include <cstdio>
#include <cstdint>
namespace cg = cooperative_groups;

#ifndef MK_SKIPMASK
#define MK_SKIPMASK 0
#endif
#ifndef MK_NOATTN
#define MK_NOATTN 0
#endif
#ifndef MK_NOGLAOUT
#define MK_NOGLAOUT 0
#endif
#ifndef MK_ONE_LAUNCH
#define MK_ONE_LAUNCH 1
#endif

#define LAS __attribute__((address_space(3)))
typedef unsigned short bf16_t;
typedef short bf16x8 __attribute__((ext_vector_type(8)));
typedef float f32x4 __attribute__((ext_vector_type(4)));
typedef unsigned u32x4 __attribute__((ext_vector_type(4)));
typedef unsigned u32x2 __attribute__((ext_vector_type(2)));

constexpr int M = 34816;
constexpr int MP = 32768;
constexpr int D = 1024, FF = 2816, NIN = 5888, PW = 5888  , INW = 5648;
constexpr int NCH = 544;
constexpr float EPS = 1e-6f;
constexpr size_t O_Y = 0, O_KP = 35651584, O_VP = 69206016, O_GP = 102760448, O_PP = 102825984, O_KS = 102856704, O_VS = 104953856, O_GS = 107051008, O_PS = 107575296;
constexpr int C_QA = 0, C_KA = 512, C_VA = 1024, C_QB = 1536, C_KB = 1664, C_VB = 1792, C_OB = 2048, C_UC = 2304, C_G = 2560, C_RB = 5632;

constexpr size_t WL_1IN = 0, WL_1OUT = WL_1IN + (size_t)5632 * 1024, WL_IN = WL_1OUT + (size_t)1024 * 2816, WL_BR = WL_IN + (size_t)5888 * 1024, WL_OUT = WL_BR + 1048576,
                 WL_2IN = WL_OUT + 1048576, WL_2OUT = WL_2IN + (size_t)5632 * 1024, WL_PG = WL_2OUT + (size_t)1024 * 2816, WL_PP = WL_PG + 1048576, WL_END = WL_PP + 262144;
constexpr size_t MiB = 1u << 20;
constexpr size_t WS_W = 0;
constexpr size_t WS_XB = 104 * MiB;
constexpr size_t WS_PB = 172 * MiB;
constexpr size_t WS_BIG = 208 * MiB;
constexpr size_t WS_Y = 600 * MiB;
constexpr size_t WS_MG = 668 * MiB;
constexpr size_t WS_SCR = 736 * MiB;
constexpr size_t WS_SS = 934 * MiB;
constexpr size_t WS_DS = 878 * MiB;
constexpr size_t WS_ST = 896 * MiB;
constexpr size_t WS_B = 914 * MiB;
constexpr size_t WS_DEC = 932 * MiB;
constexpr size_t WS_CTL = 933 * MiB;
constexpr size_t WS_NEED = 944 * MiB;
static_assert(2 * WL_END * 2 <= 104 * MiB, "weights fit");

__device__ __forceinline__ unsigned f2bf(float f) { unsigned u = __builtin_bit_cast(unsigned, f); return (u + 0x7fffu + ((u >> 16) & 1u)) >> 16; }
__device__ __forceinline__ unsigned pk2(float lo, float hi) { unsigned r; asm("v_cvt_pk_bf16_f32 %0, %1, %2" : "=v"(r) : "v"(lo), "v"(hi)); return r; }
__device__ __forceinline__ float bflo(unsigned u) { return __uint_as_float(u << 16); }
__device__ __forceinline__ float bfhi(unsigned u) { return __uint_as_float(u & 0xffff0000u); }
__device__ __forceinline__ float bf2f(bf16_t b) { return __uint_as_float((unsigned)b << 16); }
__device__ __forceinline__ float fexp(float x) { return __builtin_amdgcn_exp2f(x * 1.4426950408889634f); }
__device__ __forceinline__ float flog(float x) { return __builtin_amdgcn_logf(x) * 0.6931471805599453f; }
__device__ __forceinline__ float sigm(float x) { return __builtin_amdgcn_rcpf(1.0f + fexp(-x)); }
__device__ __forceinline__ float softplus(float z) { return fmaxf(z, 0.f) + flog(1.0f + fexp(-fabsf(z))); }
__device__ __forceinline__ float rstd_of(const float* ss, int row) {
    const f32x4* p = (const f32x4*)(ss + (size_t)row * 32);
    float s = 0.f;
#pragma unroll
    for (int i = 0; i < 8; ++i) { const f32x4 a = p[i]; s += (a[0] + a[1]) + (a[2] + a[3]); }
    return __builtin_amdgcn_rsqf(s * (1.0f / 1024.0f) + EPS);
}

namespace pg8 {
constexpr int BM = 256, BK = 64, HALF = 128, HTB = HALF * BK * 2, STAGE_BYTES = 8 * HTB, NXCD = 8, WGM = 8;
__host__ __device__ __forceinline__ int lds_byte(int r, int c) { const int st = (r >> 4) * 2 + (c >> 5), rr = r & 15, cc = c & 31, ob = rr * 64 + cc * 2; return st * 1024 + (ob ^ (((ob >> 9) & 1) << 5)); }
__host__ __device__ __forceinline__ void stage_rc(int b, int& R, int& C) { const int st = b / 1024, sb = b % 1024, swz = sb ^ (((sb >> 9) & 1) << 5); R = (st >> 1) * 16 + swz / 64; C = (st & 1) * 32 + (swz % 64) / 2; }
__host__ __device__ __forceinline__ int perm32(int rho) { const int n = rho >> 4, i = rho & 15; return 8 * (i >> 2) + 4 * n + (i & 3); }

struct Unit { int pm, pn, kind, k0, nt, qm; };
struct Gemm { const bf16_t* A; const bf16_t* Bt; int lda, ldb; };

struct Sched {
    int nM, nN, nwg, G, c, nsub, nt0, quart;
    __device__ __forceinline__ void init(int M_, int N_, int G_, int c_, int nt) { nM = M_ / BM; nN = N_ / BM; nwg = nM * nN; G = G_; c = c_; nsub = 1; nt0 = nt; quart = 0; }
    __device__ __forceinline__ bool next(int i, Unit& u) const {
        const int ti = i / nsub, sk = i - ti * nsub;
        long L = (long)ti * G + c; int qm = 0xF;
        const int nfull = nwg / G;
        if (quart && ti >= nfull) {
            const long li = (long)(ti - nfull) * G + c; if (li >= 4L * (nwg - nfull * G)) return false;
            L = (long)nfull * G + (li >> 2); qm = 1 << (int)(li & 3);
        } else if (L >= nwg) return false;
        u.qm = qm;
        int wgid = (int)L; { const int q = nwg / NXCD, r = nwg % NXCD, xcd = wgid % NXCD, off = wgid / NXCD; wgid = (xcd < r ? xcd * (q + 1) : r * (q + 1) + (xcd - r) * q) + off; }
        const int nig = WGM * nN, gid = wgid / nig, fm = gid * WGM, gsz = (nM - fm) < WGM ? (nM - fm) : WGM;
        u.pm = fm + ((wgid % nig) % gsz); u.pn = (wgid % nig) / gsz; u.kind = sk; u.k0 = (sk > 0) ? 256 + 256 * sk : 0; u.nt = (sk > 0) ? 4 : nt0; return true;
    }
};

#define PG8_KLOOP(C0, C1, C2, C3) \
        for (int t = 0; t < nt; t += 2) { \
            const bool last = (t == nt - 2); \
            const char* a1 = cA + (size_t)(t + 1) * kstep; \
            const char* a2 = last ? nA : cA + (size_t)(t + 2) * kstep; const char* b2 = last ? nB : cB + (size_t)(t + 2) * kstep; \
            const char* a3 = a2 + kstep; const char* b3 = b2 + kstep; \
            PG8_LDB(B0, 0, 0); PG8_LDB(B1, 0, 1); PG8_SCHED; PG8_LDA(At, 0, 0); PG8_STAGE(PG8_SA(1, 1), a1 + hstepA, voffA); \
            PG8_WAIT_V(8); PG8_WAIT_L(0); PG8_BAR; if (C0) PG8_MMA(0, 0, At, B0); if (C1) PG8_MMA(0, 1, At, B1); PG8_BAR; PG8_SCHED; \
            PG8_LDA(At, 0, 1); PG8_STAGE(PG8_SB(0, 0), b2, voffB); PG8_STAGE(PG8_SB(0, 1), b2 + hstepB, voffB); PG8_STAGE(PG8_SA(0, 0), a2, voffA); \
            PG8_WAIT_V(8); PG8_WAIT_L(0); PG8_BAR; if (C2) PG8_MMA(1, 0, At, B0); if (C3) PG8_MMA(1, 1, At, B1); PG8_BAR; PG8_SCHED; \
            PG8_LDB(B0, 1, 0); PG8_LDB(B1, 1, 1); PG8_SCHED; PG8_LDA(At, 1, 0); PG8_STAGE(PG8_SA(0, 1), a2 + hstepA, voffA); \
            PG8_WAIT_V(8); PG8_WAIT_L(0); PG8_BAR; if (C0) PG8_MMA(0, 0, At, B0); if (C1) PG8_MMA(0, 1, At, B1); PG8_BAR; PG8_SCHED; \
            PG8_LDA(At, 1, 1); PG8_STAGE(PG8_SB(1, 0), b3, voffB); PG8_STAGE(PG8_SB(1, 1), b3 + hstepB, voffB); PG8_STAGE(PG8_SA(1, 0), a3, voffA); \
            PG8_WAIT_V(8); PG8_WAIT_L(0); PG8_BAR; if (C2) PG8_MMA(1, 0, At, B0); if (C3) PG8_MMA(1, 1, At, B1); PG8_BAR; PG8_SCHED; \
        }
template <class Epi, class Sch>
__device__ __forceinline__ void gemm_phase(LAS unsigned char* lds, const int tid, const Gemm g, const Sch& S, const Epi& E, const float* ss) {
    const int wid = __builtin_amdgcn_readfirstlane(tid >> 6), lane = tid & 63, wr = wid >> 2, wc = wid & 3, fr = lane & 15, fq = lane >> 4;
    unsigned voffA[2], voffB[2];
#pragma unroll
    for (int i = 0; i < 2; ++i) { int R, C; stage_rc(tid * 16 + i * 8192, R, C); const int Rb = (R & ~31) + perm32(R & 31);
        voffA[i] = (unsigned)(R * g.lda + C) * 2u; voffB[i] = (unsigned)(Rb * g.ldb + C) * 2u; }
    const size_t kstep = (size_t)(BK * 2);
    const size_t hstepA = (size_t)HALF * g.lda * 2, hstepB = (size_t)HALF * g.ldb * 2;
    const size_t tstepA = 2 * hstepA, tstepB = 2 * hstepB;
    const unsigned ldsw = (unsigned)wid * 1024u;
    const int aoff = lds_byte(wr * 64 + fr, fq * 8), boff = lds_byte(wc * 32 + fr, fq * 8);
    LAS float* rtab = (LAS float*)(lds + STAGE_BYTES);
    f32x4 rt_a = {0.f, 0.f, 0.f, 0.f}, rt_b = rt_a, rt_c = rt_a, rt_d = rt_a;
#define PG8_RTAB_LOAD(pm_) do { if (ss) { const f32x4* p_ = (const f32x4*)(ss + ((size_t)(pm_) * 256 + (tid >> 1)) * 32 + (tid & 1) * 16); rt_a = p_[0]; rt_b = p_[1]; rt_c = p_[2]; rt_d = p_[3]; } } while (0)
#define PG8_RTAB_FIN(buf_) do { if (ss) { float s_ = (((rt_a[0] + rt_a[1]) + (rt_a[2] + rt_a[3])) + ((rt_b[0] + rt_b[1]) + (rt_b[2] + rt_b[3]))) + (((rt_c[0] + rt_c[1]) + (rt_c[2] + rt_c[3])) + ((rt_d[0] + rt_d[1]) + (rt_d[2] + rt_d[3]))); \
        s_ += __shfl_xor(s_, 1); if (!(tid & 1)) rtab[(buf_) * 256 + (tid >> 1)] = __builtin_amdgcn_rsqf(s_ * (1.0f / 1024.0f) + EPS); } } while (0)
#define PG8_SA(b, h) (((b) * 2 + (h)) * HTB)
#define PG8_SB(b, h) ((4 + (b) * 2 + (h)) * HTB)
#define PG8_STAGE(bufoff, gbase, voff) do { _Pragma("unroll") for (int _i = 0; _i < 2; ++_i) \
        __builtin_amdgcn_global_load_lds((const unsigned*)((const char*)(gbase) + (voff)[_i]), (LAS unsigned*)(lds + (bufoff) + ldsw + _i * 8192), 16, 0, 0); } while (0)
#define PG8_LDA(dst, b, h) do { _Pragma("unroll") for (int m = 0; m < 4; ++m) _Pragma("unroll") for (int k = 0; k < 2; ++k) dst[m][k] = *(const LAS bf16x8*)(lds + PG8_SA(b, h) + aoff + m * 2048 + k * 1024); } while (0)
#define PG8_LDB(dst, b, h) do { _Pragma("unroll") for (int n = 0; n < 2; ++n) _Pragma("unroll") for (int k = 0; k < 2; ++k) dst[n][k] = *(const LAS bf16x8*)(lds + PG8_SB(b, h) + boff + n * 2048 + k * 1024); } while (0)
#define PG8_MMA(ai, bj, At, Bt) do { __builtin_amdgcn_s_setprio(1); _Pragma("unroll") for (int m = 0; m < 4; ++m) _Pragma("unroll") for (int n = 0; n < 2; ++n) _Pragma("unroll") for (int k = 0; k < 2; ++k) \
        acc[ai][bj][m][n] = __builtin_amdgcn_mfma_f32_16x16x32_bf16(Bt[n][k], At[m][k], acc[ai][bj][m][n], 0, 0, 0); __builtin_amdgcn_s_setprio(0); } while (0)
#define PG8_WAIT_V(n) asm volatile("s_waitcnt vmcnt(" #n ")" ::: "memory")
#define PG8_WAIT_L(n) asm volatile("s_waitcnt lgkmcnt(" #n ")" ::: "memory")
#define PG8_BAR __builtin_amdgcn_s_barrier()
#define PG8_SCHED __builtin_amdgcn_sched_barrier(0)
    Unit cur, nxt; int ui = 0;
    if (!S.next(0, cur)) return;
    f32x4 acc[2][2][4][2];
#pragma unroll
    for (int a = 0; a < 2; ++a)
#pragma unroll
        for (int b = 0; b < 2; ++b)
#pragma unroll
            for (int m = 0; m < 4; ++m)
#pragma unroll
                for (int n = 0; n < 2; ++n) acc[a][b][m][n] = (f32x4){0.f, 0.f, 0.f, 0.f};
    bf16x8 At[4][2], B0[2][2], B1[2][2];
    const char* cA = (const char*)g.A + (size_t)cur.pm * tstepA + (size_t)cur.k0 * 2; const char* cB = (const char*)g.Bt + (size_t)cur.pn * tstepB + (size_t)cur.k0 * 2;
    PG8_RTAB_LOAD(cur.pm); PG8_RTAB_FIN(0);
    PG8_STAGE(PG8_SB(0, 0), cB, voffB); PG8_STAGE(PG8_SB(0, 1), cB + hstepB, voffB); PG8_STAGE(PG8_SA(0, 0), cA, voffA); PG8_STAGE(PG8_SA(0, 1), cA + hstepA, voffA);
    if (wr == 1) PG8_BAR;
    PG8_WAIT_V(2); PG8_BAR;
    PG8_STAGE(PG8_SB(1, 0), cB + kstep, voffB); PG8_STAGE(PG8_SA(1, 0), cA + kstep, voffA); PG8_STAGE(PG8_SB(1, 1), cB + hstepB + kstep, voffB);
    PG8_WAIT_V(6); PG8_BAR;
    for (;;) {
        const bool has_next = S.next(ui + 1, nxt);
        const char* nA = has_next ? (const char*)g.A + (size_t)nxt.pm * tstepA + (size_t)nxt.k0 * 2 : cA; const char* nB = has_next ? (const char*)g.Bt + (size_t)nxt.pn * tstepB + (size_t)nxt.k0 * 2 : cB;
        const int nt = cur.nt, qm = cur.qm;
        if (qm == 0xF) { PG8_KLOOP(true, true, true, true) } else { PG8_KLOOP((qm & 1), (qm & 2), (qm & 4), (qm & 8)) }
        if (wr == 0) PG8_BAR;
        if (has_next) PG8_RTAB_LOAD(nxt.pm);
        E(acc, cur, wr, wc, fr, fq, rtab + (ui & 1) * 256);
        if (!has_next) break;
#pragma unroll
        for (int a = 0; a < 2; ++a)
#pragma unroll
            for (int b = 0; b < 2; ++b)
#pragma unroll
                for (int m = 0; m < 4; ++m)
#pragma unroll
                    for (int n = 0; n < 2; ++n) acc[a][b][m][n] = (f32x4){0.f, 0.f, 0.f, 0.f};
        cur = nxt; cA = nA; cB = nB; ++ui;
        PG8_RTAB_FIN(ui & 1);
        if (wr == 1) PG8_BAR;
    }
    PG8_WAIT_V(0);
    PG8_BAR;
#undef PG8_SA
#undef PG8_RTAB_LOAD
#undef PG8_RTAB_FIN
#undef PG8_SB
#undef PG8_STAGE
#undef PG8_LDA
#undef PG8_LDB
#undef PG8_MMA
#undef PG8_WAIT_V
#undef PG8_WAIT_L
#undef PG8_BAR
#undef PG8_SCHED
}
}
using pg8::Unit;

#define EPI_FENCE() asm volatile("" ::: "memory")
struct EpiSwiglu {
    bf16_t* hid;
    __device__ __forceinline__ void operator()(const f32x4 (&acc)[2][2][4][2], const Unit& u, int wr, int wc, int fr, int fq, const LAS float* rt) const {
        const int row0 = u.pm * 256 + wr * 64 + fr, col = u.pn * 128 + wc * 32 + 8 * fq;
#pragma unroll
        for (int ai = 0; ai < 2; ++ai)
#pragma unroll
            for (int m = 0; m < 4; ++m) {
                const int rl = ai * 128 + m * 16; const int row = row0 + rl; const float rs = rt[wr * 64 + fr + rl];
                float h[8];
#pragma unroll
                for (int n = 0; n < 2; ++n)
#pragma unroll
                    for (int i = 0; i < 4; ++i) { const float a = acc[ai][0][m][n][i] * rs, b = acc[ai][1][m][n][i] * rs; h[4 * n + i] = a * sigm(a) * b; }
                u32x4 w; w.x = pk2(h[0], h[1]); w.y = pk2(h[2], h[3]); w.z = pk2(h[4], h[5]); w.w = pk2(h[6], h[7]);
                *(u32x4*)(hid + (size_t)row * FF + col) = w;
            }
    }
};
struct EpiWin {
    bf16_t* proj; float* out; int layer;
    __device__ __forceinline__ void operator()(const f32x4 (&acc)[2][2][4][2], const Unit& u, int wr, int wc, int fr, int fq, const LAS float* rt) const {
        const int row0 = u.pm * 256 + wr * 64 + fr, pn = u.pn;
        const bool isgate = (pn >= 10 && pn < 22), iskv = (pn >= 2 && pn < 6), ispool = (pn == 9);
#pragma unroll
        for (int ai = 0; ai < 2; ++ai)
#pragma unroll
            for (int m = 0; m < 4; ++m) {
                const int rl = ai * 128 + m * 16; const int row = row0 + rl; const float rs = rt[wr * 64 + fr + rl];
#pragma unroll
                for (int bj = 0; bj < 2; ++bj) {
                    if (!((u.qm >> (ai * 2 + bj)) & 1)) continue;
                    const int ct = bj * 128 + wc * 32 + 8 * fq;
                    f32x4 v0 = acc[ai][bj][m][0] * rs, v1 = acc[ai][bj][m][1] * rs;
                    if (isgate) {
#pragma unroll
                        for (int i = 0; i < 4; ++i) { v0[i] = sigm(v0[i]); v1[i] = sigm(v1[i]); }
                    }
                    u32x4 w; w.x = pk2(v0[0], v0[1]); w.y = pk2(v0[2], v0[3]); w.z = pk2(v1[0], v1[1]); w.w = pk2(v1[2], v1[3]);
                    *(u32x4*)(proj + (size_t)row * PW + pn * 256 + ct) = w;
                    if (iskv) {
                        const int c512 = (pn & 1) * 256 + ct; const bool isv = pn >= 4;
                        float* dst = row < MP ? out + (isv ? O_VP : O_KP) + ((size_t)layer * MP + row) * 512 + c512
                                              : out + (isv ? O_VS : O_KS) + ((size_t)layer * 2048 + (row - MP)) * 512 + c512;
                        *(f32x4*)dst = v0; *(f32x4*)(dst + 4) = v1;
                    }
                    if (ispool) {
                        if (row < MP) { const int t = row & 8191, b = row >> 13; if (t >= 8177) { float* dst = out + O_PP + ((size_t)(layer * 4 + b) * 15 + (t - 8177)) * 256 + ct; *(f32x4*)dst = v0; *(f32x4*)(dst + 4) = v1; } }
                        else { const int r = row - MP, t = r & 63, sb = r >> 6; if (t >= 49) { float* dst = out + O_PS + ((size_t)(layer * 32 + sb) * 15 + (t - 49)) * 256 + ct; *(f32x4*)dst = v0; *(f32x4*)(dst + 4) = v1; } }
                    }
                }
            }
    }
};
struct EpiRes {
    const bf16_t* xsrc; bf16_t* xb; float* ss_out; const bf16_t* scr; float alpha; int mode; const float* xin0; const float* xin1;
    __device__ __forceinline__ void operator()(const f32x4 (&acc)[2][2][4][2], const Unit& u, int wr, int wc, int fr, int fq, const LAS float* rt) const {
        const int row0 = u.pm * 256 + wr * 64 + fr, colb = u.pn * 256 + wc * 32 + 8 * fq;
        const float* xr = xin0 ? (u.pm < MP / 256 ? xin0 : xin1 - (size_t)MP * D) : nullptr;
#pragma unroll
        for (int ai = 0; ai < 2; ++ai) {
            if (!((u.qm >> (2 * ai)) & 3)) continue;
#pragma unroll
            for (int mp = 0; mp < 2; ++mp) {
                f32x4 xv[2][2][2]; u32x4 sv[2][2];
#pragma unroll
                for (int mi = 0; mi < 2; ++mi)
#pragma unroll
                    for (int bj = 0; bj < 2; ++bj) {
                        const size_t off = (size_t)(row0 + ai * 128 + (2 * mp + mi) * 16) * D + colb + bj * 128;
                        if (xr) { xv[mi][bj][0] = *(const f32x4*)(xr + off); xv[mi][bj][1] = *(const f32x4*)(xr + off + 4); }
                        else xv[mi][bj][0] = __builtin_bit_cast(f32x4, *(const u32x4*)(xsrc + off));
                        if (mode == 1) sv[mi][bj] = *(const u32x4*)(scr + off);
                    }
#pragma unroll
                for (int mi = 0; mi < 2; ++mi) {
                    const int m = 2 * mp + mi, rl = ai * 128 + m * 16, row = row0 + rl;
                    const float rs = (mode == 1) ? rt[wr * 64 + fr + rl] : 1.f;
#pragma unroll
                    for (int bj = 0; bj < 2; ++bj) {
                        if (!((u.qm >> (ai * 2 + bj)) & 1)) continue;
                        const size_t off = (size_t)row * D + colb + bj * 128;
                        f32x4 v0 = acc[ai][bj][m][0], v1 = acc[ai][bj][m][1];
                        if (mode == 1) {
#pragma unroll
                            for (int i = 0; i < 4; ++i) { v0[i] = sigm(v0[i] * rs); v1[i] = sigm(v1[i] * rs); }
                            { const u32x4 p4 = sv[mi][bj]; v0[0] *= bflo(p4.x); v0[1] *= bfhi(p4.x); v0[2] *= bflo(p4.y); v0[3] *= bfhi(p4.y); v1[0] *= bflo(p4.z); v1[1] *= bfhi(p4.z); v1[2] *= bflo(p4.w); v1[3] *= bfhi(p4.w); }
                        } else { v0 = v0 * alpha; v1 = v1 * alpha; }
                        f32x4 o0, o1;
                        if (xr) { o0 = xv[mi][bj][0]; o1 = xv[mi][bj][1]; }
                        else { const u32x4 h4 = __builtin_bit_cast(u32x4, xv[mi][bj][0]); o0 = (f32x4){bflo(h4.x), bfhi(h4.x), bflo(h4.y), bfhi(h4.y)}; o1 = (f32x4){bflo(h4.z), bfhi(h4.z), bflo(h4.w), bfhi(h4.w)}; }
                        const f32x4 x0 = o0 + v0, x1 = o1 + v1;
                        u32x4 w; w.x = pk2(x0[0], x0[1]); w.y = pk2(x0[2], x0[3]); w.z = pk2(x1[0], x1[1]); w.w = pk2(x1[2], x1[3]);
                        *(u32x4*)(xb + off) = w;
                        float ssum = (x0[0] * x0[0] + x0[1] * x0[1]) + (x0[2] * x0[2] + x0[3] * x0[3]) + (x1[0] * x1[0] + x1[1] * x1[1]) + (x1[2] * x1[2] + x1[3] * x1[3]);
                        ssum += __shfl_xor(ssum, 16); ssum += __shfl_xor(ssum, 32);
                        if (fq == 0) ss_out[(size_t)row * 32 + u.pn * 8 + bj * 4 + wc] = ssum;
                    }
                }
                EPI_FENCE();
            }
        }
    }
};
struct EpiBranch {
    const bf16_t* proj; bf16_t* scr; bf16_t* merged; int mode;
    template <int BR>
    __device__ __forceinline__ void run(const f32x4 (&acc)[2][2][4][2], const Unit& u, int wr, int wc, int fr, int fq) const {
        const int row0 = u.pm * 256 + wr * 64 + fr, colb = u.pn * 256 + wc * 32 + 8 * fq;
#pragma unroll
        for (int ai = 0; ai < 2; ++ai) {
            if (!((u.qm >> (2 * ai)) & 3)) continue;
#pragma unroll
            for (int mp = 0; mp < 2; ++mp) {
                u32x4 gt[2][2], sv[2][2];
#pragma unroll
                for (int mi = 0; mi < 2; ++mi)
#pragma unroll
                    for (int bj = 0; bj < 2; ++bj) {
                        const int row = row0 + ai * 128 + (2 * mp + mi) * 16, col = colb + bj * 128; const size_t off = (size_t)row * D + col;
                        if (BR < 3) gt[mi][bj] = *(const u32x4*)(proj + (size_t)row * PW + C_G + BR * 1024 + col);
                        if (BR == 1 || BR == 2) sv[mi][bj] = *(const u32x4*)(scr + off);
                    }
#pragma unroll
                for (int mi = 0; mi < 2; ++mi)
#pragma unroll
                    for (int bj = 0; bj < 2; ++bj) {
                        if (!((u.qm >> (ai * 2 + bj)) & 1)) continue;
                        const int m = 2 * mp + mi, row = row0 + ai * 128 + m * 16, col = colb + bj * 128; const size_t off = (size_t)row * D + col;
                        f32x4 v0 = acc[ai][bj][m][0], v1 = acc[ai][bj][m][1];
                        if (BR < 3) { const u32x4 g4 = gt[mi][bj];
                            v0[0] *= bflo(g4.x); v0[1] *= bfhi(g4.x); v0[2] *= bflo(g4.y); v0[3] *= bfhi(g4.y);
                            v1[0] *= bflo(g4.z); v1[1] *= bfhi(g4.z); v1[2] *= bflo(g4.w); v1[3] *= bfhi(g4.w); }
                        if (BR == 1 || BR == 2) { const u32x4 p4 = sv[mi][bj]; v0[0] += bflo(p4.x); v0[1] += bfhi(p4.x); v0[2] += bflo(p4.y); v0[3] += bfhi(p4.y); v1[0] += bflo(p4.z); v1[1] += bfhi(p4.z); v1[2] += bflo(p4.w); v1[3] += bfhi(p4.w); }
                        { u32x4 w; w.x = pk2(v0[0], v0[1]); w.y = pk2(v0[2], v0[3]); w.z = pk2(v1[0], v1[1]); w.w = pk2(v1[2], v1[3]); *(u32x4*)((BR == 2 ? merged : scr) + off) = w; }
                    }
                EPI_FENCE();
            }
        }
    }
    __device__ __forceinline__ void operator()(const f32x4 (&acc)[2][2][4][2], const Unit& u, int wr, int wc, int fr, int fq, const LAS float* rt) const {
        if (mode == 1) run<3>(acc, u, wr, wc, fr, fq);
        else if (u.kind == 0) run<0>(acc, u, wr, wc, fr, fq);
        else if (u.kind == 1) run<1>(acc, u, wr, wc, fr, fq);
        else run<2>(acc, u, wr, wc, fr, fq);
    }
};

struct Args { const float* in[29]; float* out; unsigned char* ws; int ph_lo, ph_hi; };
constexpr int NPH = 26;
constexpr int LDS_BYTES = 147456;

struct Ctx {
    const float* const* in; float* out; unsigned char* ws; LAS unsigned char* lds; unsigned char* ldsg; int tid, lane, wave, G, bx;
};

enum { MAP_ID = 0, MAP_SWIGLU = 1, MAP_WIN = 2 };
__device__ __forceinline__ int map_col(int mode, int n) {
    if (mode == MAP_ID) return n;
    if (mode == MAP_SWIGLU) { const int p = n >> 8, j = n & 255; return j < 128 ? p * 128 + j : FF + p * 128 + (j - 128); }
    if (n < 2048) return n;
    if (n < 2304) return 2064 + (n - 2048);
    if (n < 2560) return 2320 + (n - 2304);
    if (n < 5632) return 2576 + (n - 2560);
    if (n < 5648) return 2048 + (n - 5632);
    return -1;
}
__device__ __forceinline__ void tconv(const Ctx& c, const float* src, int ldsrc, int K, bf16_t* dst, int lddst, int Nout, int mode, const float* g, int& toff) {
    float* tile = (float*)c.ldsg;
    const int ntn = Nout / 64, ntk = K / 256, nt = ntn * ntk;
    const int first = (c.bx + c.G - (toff % c.G)) % c.G; toff += nt;
    for (int it = first; it < nt; it += c.G) {
        const int tn = it % ntn, tk = it / ntn, n0 = tn * 64, k0 = tk * 256;
        const int nn = c.tid & 63, sc = map_col(mode, n0 + nn), kq = c.tid >> 6;
        float v[32];
#pragma unroll
        for (int i = 0; i < 32; ++i) { const int kk = kq + 8 * i; v[i] = (sc >= 0) ? src[(size_t)(k0 + kk) * ldsrc + sc] : 0.f; }
        if (g) {
#pragma unroll
            for (int i = 0; i < 32; ++i) v[i] *= g[k0 + kq + 8 * i];
        }
#pragma unroll
        for (int i = 0; i < 32; ++i) tile[(kq + 8 * i) * 65 + nn] = v[i];
        __syncthreads();
        { const int n2 = c.tid >> 3, kg = c.tid & 7;
#pragma unroll
          for (int j = 0; j < 4; ++j) { const float* s = tile + (kg * 8 + 64 * j) * 65 + n2;
              u32x4 o; o.x = pk2(s[0], s[65]); o.y = pk2(s[130], s[195]); o.z = pk2(s[260], s[325]); o.w = pk2(s[390], s[455]);
              *(u32x4*)(dst + (size_t)(n0 + n2) * lddst + k0 + kg * 8 + 64 * j) = o; } }
        __syncthreads();
    }
}
__device__ __forceinline__ float wave_sum(float v) {
#pragma unroll
    for (int o = 1; o < 64; o <<= 1) v += __shfl_xor(v, o);
    return v;
}
__device__ __forceinline__ void prologue(const Ctx& c) {
    bf16_t* W = (bf16_t*)(c.ws + WS_W);
    int toff = 0;
    for (int l = 0; l < 2; ++l) {
        bf16_t* Wl = W + (size_t)l * WL_END;
        tconv(c, c.in[9] + (size_t)l * D * 2 * FF, 2 * FF, D, Wl + WL_1IN, D, 2 * FF, MAP_SWIGLU, c.in[8] + l * D, toff);
        tconv(c, c.in[10] + (size_t)l * FF * D, D, FF, Wl + WL_1OUT, FF, D, MAP_ID, nullptr, toff);
        tconv(c, c.in[12] + (size_t)l * D * INW, INW, D, Wl + WL_IN, D, NIN, MAP_WIN, c.in[11] + l * D, toff);
        tconv(c, c.in[18] + (size_t)l * 512 * D, D, 512, Wl + WL_BR, D, D, MAP_ID, nullptr, toff);
        tconv(c, c.in[19] + (size_t)l * 256 * D, D, 256, Wl + WL_BR + 512, D, D, MAP_ID, nullptr, toff);
        tconv(c, c.in[21] + (size_t)l * D * D, D, D, Wl + WL_OUT, D, D, MAP_ID, nullptr, toff);
        tconv(c, c.in[23] + (size_t)l * D * 2 * FF, 2 * FF, D, Wl + WL_2IN, D, 2 * FF, MAP_SWIGLU, c.in[22] + l * D, toff);
        tconv(c, c.in[24] + (size_t)l * FF * D, D, FF, Wl + WL_2OUT, FF, D, MAP_ID, nullptr, toff);
        tconv(c, c.in[26] + (size_t)l * D * D, D, D, Wl + WL_PG, D, D, MAP_ID, c.in[25] + l * D, toff);
        tconv(c, c.in[27] + (size_t)l * 256 * D, D, 256, Wl + WL_PP, 256, D, MAP_ID, nullptr, toff);
        const float* pw = c.in[16] + (size_t)l * 4 * 64 * 64; const float* psc = c.in[17] + l * 256; const float* wc = c.in[20] + (size_t)l * 256 * D;
        for (int idx = c.bx * 512 + c.tid; idx < 256 * 1024; idx += c.G * 512) {
            const int n = idx & 1023, kc = idx >> 10, gq = kc >> 6, cc = kc & 63; float s = 0.f;
            for (int dd = 0; dd < 64; ++dd) s += pw[(gq * 64 + cc) * 64 + dd] * psc[gq * 64 + dd] * wc[(size_t)(gq * 64 + dd) * D + n];
            Wl[WL_BR + (size_t)n * D + 768 + kc] = (bf16_t)f2bf(s);
        }
    }
    bf16_t* xb = (bf16_t*)(c.ws + WS_XB); float* ss0 = (float*)(c.ws + WS_SS);
    for (int row = c.bx * 8 + c.wave; row < M; row += c.G * 8) {
        const float* src = row < MP ? c.in[0] + (size_t)row * D : c.in[1] + (size_t)(row - MP) * D;
        f32x4 v[4]; float s = 0.f;
#pragma unroll
        for (int j = 0; j < 4; ++j) { v[j] = *(const f32x4*)(src + c.lane * 4 + 256 * j); s += (v[j][0] * v[j][0] + v[j][1] * v[j][1]) + (v[j][2] * v[j][2] + v[j][3] * v[j][3]); }
        s = wave_sum(s);
#pragma unroll
        for (int j = 0; j < 4; ++j) { u32x2 w; w.x = pk2(v[j][0], v[j][1]); w.y = pk2(v[j][2], v[j][3]); *(u32x2*)(xb + (size_t)row * D + c.lane * 4 + 256 * j) = w; }
        if (c.lane < 32) ss0[(size_t)row * 32 + c.lane] = c.lane == 0 ? s : 0.f;
    }
    bf16_t* pb = (bf16_t*)(c.ws + WS_PB);
#pragma unroll 4
    for (size_t i4 = (size_t)c.bx * 512 + c.tid; i4 < (size_t)2 * M * 64; i4 += (size_t)c.G * 512) {
        const size_t e = i4 * 4; const int l = (int)(e / ((size_t)M * 256)); const size_t r = e - (size_t)l * M * 256; const int row = (int)(r >> 8), cc = (int)(r & 255);
        const float* src = row < MP ? c.in[6] + ((size_t)l * MP + row) * 256 + cc : c.in[7] + ((size_t)l * 2048 + (row - MP)) * 256 + cc;
        const f32x4 v = *(const f32x4*)src; u32x2 w; w.x = pk2(v[0], v[1]); w.y = pk2(v[2], v[3]); *(u32x2*)(pb + e) = w;
    }
}

__device__ __forceinline__ int next_item(const Ctx& c, int slot) {
    volatile int* sh = (volatile int*)(c.ldsg + 147392);
    __syncthreads();
    if (c.tid == 0) *sh = (int)__hip_atomic_fetch_add((unsigned*)(c.ws + WS_CTL) + 64 * (1 + slot), 1u, __ATOMIC_RELAXED, __HIP_MEMORY_SCOPE_AGENT);
    __syncthreads();
    return *sh;
}
__device__ __forceinline__ void gla_local_unit(const Ctx& c, int l, int g, int h) {
    float* L = (float*)c.ldsg; float* rs = L; float* wg = L + 1024; float* bg = L + 1536; float* la = L + 1600;
    bf16_t* KtT = (bf16_t*)(c.ldsg + 14848); bf16_t* Vt = KtT + 2304;
    const bf16_t* proj = (const bf16_t*)(c.ws + WS_BIG); const int m0 = g * 64, tid = c.tid;
    { const int e = tid * 2, row = e >> 4, cc = e & 15; const unsigned w = *(const unsigned*)(proj + (size_t)(m0 + row) * PW + C_RB + cc); rs[e] = bflo(w); rs[e + 1] = bfhi(w); }
    { const int j = tid >> 5, d = tid & 31; wg[tid] = c.in[13][(size_t)(l * 16 + j) * 128 + h * 32 + d]; }
    if (tid < 32) bg[tid] = c.in[14][l * 128 + h * 32 + tid];
    bf16_t kraw[4];
#pragma unroll
    for (int i = 0; i < 4; ++i) { const int o = tid + 512 * i, t = o >> 5, d = o & 31; kraw[i] = proj[(size_t)(m0 + t) * PW + C_KB + h * 32 + d]; }
    const u32x4 vraw = *(const u32x4*)(proj + (size_t)(m0 + (tid >> 3)) * PW + C_VB + h * 64 + (tid & 7) * 8);
    __syncthreads();
#pragma unroll
    for (int i = 0; i < 4; ++i) { const int o = tid + 512 * i, t = o >> 5, d = o & 31; float a = bg[d];
#pragma unroll
        for (int j = 0; j < 16; ++j) a += rs[t * 16 + j] * wg[j * 32 + d];
        la[t * 33 + d] = (fminf(a, 0.f) - flog(1.0f + fexp(-fabsf(a)))) * (1.0f / 16.0f); }
    __syncthreads();
    {
#pragma unroll
        for (int j = 0; j < 4; ++j) { const int d = c.wave * 4 + j; float v = la[c.lane * 33 + d];
#pragma unroll
            for (int o = 1; o < 64; o <<= 1) { const float n = __shfl_up(v, o); if (c.lane >= o) v += n; }
            la[c.lane * 33 + d] = v; }
    }
    __syncthreads();
    float* bws = (float*)(c.ws + WS_B);
#pragma unroll
    for (int i = 0; i < 4; ++i) { const int o = tid + 512 * i, t = o >> 5, d = o & 31; const float b = la[t * 33 + d];
        bws[(size_t)(m0 + t) * 128 + h * 32 + d] = b;
        KtT[d * 72 + t] = (bf16_t)f2bf(bf2f(kraw[i]) * fexp(-b)); }
    { const int t = tid >> 3, e0 = (tid & 7) * 8; const unsigned vw[4] = {vraw.x, vraw.y, vraw.z, vraw.w};
#pragma unroll
      for (int i = 0; i < 4; ++i) { Vt[(e0 + 2 * i) * 72 + t] = (bf16_t)(vw[i] & 0xffffu); Vt[(e0 + 2 * i + 1) * 72 + t] = (bf16_t)(vw[i] >> 16); } }
    if (tid < 32) ((float*)(c.ws + WS_DEC))[(size_t)(g * 4 + h) * 32 + tid] = fexp(la[63 * 33 + tid]);
    __syncthreads();
    { const int w = c.wave, lane = c.lane, fr = lane & 15, fq = lane >> 4, db = w >> 2, eb = w & 3;
      f32x4 acc = {0.f, 0.f, 0.f, 0.f};
#pragma unroll
      for (int k2 = 0; k2 < 2; ++k2) { const bf16x8 kf = *(const bf16x8*)(KtT + (16 * db + fr) * 72 + 32 * k2 + 8 * fq), vf = *(const bf16x8*)(Vt + (16 * eb + fr) * 72 + 32 * k2 + 8 * fq);
          acc = __builtin_amdgcn_mfma_f32_16x16x32_bf16(kf, vf, acc, 0, 0, 0); }
      float* dst = (float*)(c.ws + WS_DS) + (size_t)(g * 4 + h) * 2048 + (16 * db + 4 * fq) * 64 + 16 * eb + fr;
#pragma unroll
      for (int i = 0; i < 4; ++i) dst[i * 64] = acc[i]; }
    __syncthreads();
}
__device__ __forceinline__ void pool_unit(const Ctx& c, int l, int g) {
    float* ext = (float*)c.ldsg;
    const bf16_t* proj = (const bf16_t*)(c.ws + WS_BIG); bf16_t* Y = (bf16_t*)(c.ws + WS_Y);
    const int m0 = g * 64, tid = c.tid; const bool samp = g >= 512; const int cidx = samp ? 0 : (g & 127);
#pragma unroll
    for (int it = 0; it < 5; ++it) { const int q = tid + 512 * it;
        if (q < 79 * 32) { const int j = q >> 5, c8 = (q & 31) * 8; float* d = ext + j * 256 + c8;
            if (j >= 15 || cidx > 0) { const u32x4 w = *(const u32x4*)(proj + (size_t)(m0 + j - 15) * PW + C_UC + c8);
                *(f32x4*)d = (f32x4){bflo(w.x), bfhi(w.x), bflo(w.y), bfhi(w.y)}; *(f32x4*)(d + 4) = (f32x4){bflo(w.z), bfhi(w.z), bflo(w.w), bfhi(w.w)}; }
            else if (samp) { const float* sp = c.in[5] + ((size_t)(l * 32 + (g - 512)) * 15 + j) * 256 + c8; *(f32x4*)d = *(const f32x4*)sp; *(f32x4*)(d + 4) = *(const f32x4*)(sp + 4); }
            else { *(f32x4*)d = (f32x4){0.f, 0.f, 0.f, 0.f}; *(f32x4*)(d + 4) = (f32x4){0.f, 0.f, 0.f, 0.f}; } } }
    __syncthreads();
    { const int cc = tid & 255, ts = tid >> 8, gi = cc >> 6, w = 2 << gi;
      float s = 0.f;
      for (int j = 1; j < w; ++j) s += ext[(15 + ts * 32 - j) * 256 + cc];
      for (int i = 0; i < 32; ++i) { const int t = ts * 32 + i; s += ext[(15 + t) * 256 + cc];
          const int pos = samp ? 2048 + t : cidx * 64 + t; const float cnt = (float)min(w, pos + 1);
          const float dv = s / cnt - ext[(15 + t) * 256 + cc];
          Y[(size_t)(m0 + t) * D + 768 + cc] = (bf16_t)f2bf(dv); s -= ext[(15 + t - w + 1) * 256 + cc]; } }
    __syncthreads();
}

__device__ __forceinline__ void scan_unit(const Ctx& c, int l, int su) {
    const float* dS = (const float*)(c.ws + WS_DS); const float* dec = (const float*)(c.ws + WS_DEC); float* St = (float*)(c.ws + WS_ST);
    int g0, n, h, idx; float S; float* outp;
    if (su < 64) { const int bh = su >> 2, b = bh >> 2; h = bh & 3; idx = (su & 3) * 512 + c.tid; g0 = b * 128; n = 128; S = 0.f; outp = c.out + O_GP + ((size_t)(l * 4 + b) * 4 + h) * 2048 + idx; }
    else { const int s2 = su - 64, sbh = s2 >> 2, sb = sbh >> 2; h = sbh & 3; idx = (s2 & 3) * 512 + c.tid; g0 = 512 + sb; n = 1; S = c.in[4][((size_t)(l * 32 + sb) * 4 + h) * 2048 + idx]; outp = c.out + O_GS + ((size_t)(l * 32 + sb) * 4 + h) * 2048 + idx; }
    const int d = idx >> 6;
#pragma unroll 8
    for (int cc = 0; cc < n; ++cc) { const size_t gh = (size_t)(g0 + cc) * 4 + h; const float dd = dS[gh * 2048 + idx], de = dec[gh * 32 + d]; St[gh * 2048 + idx] = S; S = de * (S + dd); }
    *outp = S;
}
__device__ __forceinline__ void attn_unit(const Ctx& c, int l, int au) {
    bf16_t* Ks = (bf16_t*)c.ldsg; bf16_t* Vt = (bf16_t*)(c.ldsg + 18432); int* flags = (int*)(c.ldsg + 35840);
    const bf16_t* proj = (const bf16_t*)(c.ws + WS_BIG); bf16_t* Y = (bf16_t*)(c.ws + WS_Y);
    int R0, n_past, qb, hp, sb = 0;
    if (au < 2048) { const int b = au >> 9, rem = au & 511; qb = rem >> 2; hp = rem & 3; R0 = b * 8192; n_past = 0; }
    else { const int a2 = au - 2048; sb = a2 >> 2; hp = a2 & 3; qb = 0; R0 = MP + sb * 64; n_past = 2048; }
    const int tid = c.tid, w = c.wave, lane = c.lane, fr = lane & 15, fq = lane >> 4, hsel = w >> 2, hh = 2 * hp + hsel, qsub = w & 3;
    const int qrow = R0 + qb * 64 + qsub * 16 + fr, qpos = n_past + qb * 64 + qsub * 16 + fr;
    bf16x8 qf[2];
#pragma unroll
    for (int ks = 0; ks < 2; ++ks) qf[ks] = *(const bf16x8*)(proj + (size_t)qrow * PW + C_QA + hh * 64 + 32 * ks + 8 * fq);
    f32x4 O[4];
#pragma unroll
    for (int i = 0; i < 4; ++i) O[i] = (f32x4){0.f, 0.f, 0.f, 0.f};
    float carry = 0.f; bool wdone = false;
    int kt = (n_past + qb * 64) >> 6;
    const int lh = tid >> 8, lj = (tid >> 2) & 63, d0 = (tid & 3) * 16, lhead = 2 * hp + lh;
    for (;;) {
        {
            const int kpos = kt * 64 + lj; unsigned kk[8], vv[8];
            if (kpos < n_past) {
                const size_t o = (((size_t)(l * 32 + sb) * 2048 + kpos) * 512) + lhead * 64 + d0; const float* kp = c.in[2] + o; const float* vp = c.in[3] + o;
#pragma unroll
                for (int i = 0; i < 4; ++i) { const f32x4 a = *(const f32x4*)(kp + 4 * i), b = *(const f32x4*)(vp + 4 * i); kk[2 * i] = pk2(a[0], a[1]); kk[2 * i + 1] = pk2(a[2], a[3]); vv[2 * i] = pk2(b[0], b[1]); vv[2 * i + 1] = pk2(b[2], b[3]); }
            } else {
                const bf16_t* rp = proj + (size_t)(R0 + kpos - n_past) * PW + lhead * 64 + d0;
                const u32x4 a0 = *(const u32x4*)(rp + C_KA), a1 = *(const u32x4*)(rp + C_KA + 8), b0 = *(const u32x4*)(rp + C_VA), b1 = *(const u32x4*)(rp + C_VA + 8);
                kk[0] = a0.x; kk[1] = a0.y; kk[2] = a0.z; kk[3] = a0.w; kk[4] = a1.x; kk[5] = a1.y; kk[6] = a1.z; kk[7] = a1.w;
                vv[0] = b0.x; vv[1] = b0.y; vv[2] = b0.z; vv[3] = b0.w; vv[4] = b1.x; vv[5] = b1.y; vv[6] = b1.z; vv[7] = b1.w;
            }
            bf16_t* kd = Ks + (lh * 64 + lj) * 72 + d0;
            *(u32x4*)kd = (u32x4){kk[0], kk[1], kk[2], kk[3]}; *(u32x4*)(kd + 8) = (u32x4){kk[4], kk[5], kk[6], kk[7]};
#pragma unroll
            for (int i = 0; i < 8; ++i) { Vt[(lh * 64 + d0 + 2 * i) * 68 + lj] = (bf16_t)(vv[i] & 0xffffu); Vt[(lh * 64 + d0 + 2 * i + 1) * 68 + lj] = (bf16_t)(vv[i] >> 16); }
        }
        __syncthreads();
        {
            f32x4 sa[4];
#pragma unroll
            for (int u = 0; u < 4; ++u) { sa[u] = (f32x4){0.f, 0.f, 0.f, 0.f};
#pragma unroll
                for (int ks = 0; ks < 2; ++ks) { const bf16x8 kf = *(const bf16x8*)(Ks + (hsel * 64 + 16 * u + fr) * 72 + 32 * ks + 8 * fq); sa[u] = __builtin_amdgcn_mfma_f32_16x16x32_bf16(kf, qf[ks], sa[u], 0, 0, 0); } }
            float lk[4][4], lw[4][4], ls[4], suf[4], T[4];
#pragma unroll
            for (int u = 0; u < 4; ++u) { ls[u] = 0.f;
#pragma unroll
                for (int i = 0; i < 4; ++i) { const float z = sa[u][i] * 0.125f; const int kpos = kt * 64 + 16 * u + 4 * fq + i; const bool valid = kpos < qpos;
                    const float sp = softplus(z); lk[u][i] = valid ? -sp : 0.f; lw[u][i] = valid ? (z - sp) : -1e30f; ls[u] += lk[u][i]; } }
#pragma unroll
            for (int u = 0; u < 4; ++u) { const float a = __shfl_xor(ls[u], 16), t1 = ls[u] + a, o = __shfl_xor(t1, 32); T[u] = t1 + o; suf[u] = ((fq & 1) ? 0.f : a) + ((fq & 2) ? 0.f : o); }
            float base = carry; float wv[4][4];
#pragma unroll
            for (int u = 3; u >= 0; --u) { float run = base + suf[u];
#pragma unroll
                for (int i = 3; i >= 0; --i) { wv[u][i] = fexp(lw[u][i] + run); run += lk[u][i]; }
                base += T[u]; }
            carry = base;
#pragma unroll
            for (int k2 = 0; k2 < 2; ++k2) {
                u32x4 pw; pw.x = pk2(wv[2 * k2][0], wv[2 * k2][1]); pw.y = pk2(wv[2 * k2][2], wv[2 * k2][3]); pw.z = pk2(wv[2 * k2 + 1][0], wv[2 * k2 + 1][1]); pw.w = pk2(wv[2 * k2 + 1][2], wv[2 * k2 + 1][3]);
                const bf16x8 pf = __builtin_bit_cast(bf16x8, pw);
#pragma unroll
                for (int db = 0; db < 4; ++db) { const bf16_t* vp = Vt + (hsel * 64 + 16 * db + fr) * 68 + 32 * k2 + 4 * fq; const u32x2 lo = *(const u32x2*)vp, hi = *(const u32x2*)(vp + 16);
                    const bf16x8 vf = __builtin_bit_cast(bf16x8, (u32x4){lo.x, lo.y, hi.x, hi.y}); O[db] = __builtin_amdgcn_mfma_f32_16x16x32_bf16(vf, pf, O[db], 0, 0, 0); }
            }
            wdone = __all(carry < -46.f) != 0;
        }
        --kt;
        if (lane == 0) flags[w] = wdone ? 1 : 0;
        __syncthreads();
        int alld = 1;
#pragma unroll
        for (int i = 0; i < 8; ++i) alld &= flags[i];
        if (alld || kt < 0) break;
    }
#pragma unroll
    for (int db = 0; db < 4; ++db) { u32x2 o; o.x = pk2(O[db][0], O[db][1]); o.y = pk2(O[db][2], O[db][3]); *(u32x2*)(Y + (size_t)qrow * D + hh * 64 + 16 * db + 4 * fq) = o; }
    __syncthreads();
}

__device__ __forceinline__ void gla_out_unit(const Ctx& c, int l, int g, int h) {
    bf16_t* Qs = (bf16_t*)c.ldsg; bf16_t* Ks = Qs + 2560; bf16_t* Vt = Ks + 2560; bf16_t* ST = Vt + 4608; float* red = (float*)(ST + 2560);
    const bf16_t* proj = (const bf16_t*)(c.ws + WS_BIG); bf16_t* Y = (bf16_t*)(c.ws + WS_Y); const float* bws = (const float*)(c.ws + WS_B);
    const int m0 = g * 64, tid = c.tid, w = c.wave, lane = c.lane, fr = lane & 15, fq = lane >> 4;
    {
        const int t = tid >> 3, d0 = (tid & 7) * 4, e0 = (tid & 7) * 8;
        const f32x4 b4 = *(const f32x4*)(bws + (size_t)(m0 + t) * 128 + h * 32 + d0);
        const u32x2 q2 = *(const u32x2*)(proj + (size_t)(m0 + t) * PW + C_QB + h * 32 + d0), k2 = *(const u32x2*)(proj + (size_t)(m0 + t) * PW + C_KB + h * 32 + d0);
        const u32x4 v4 = *(const u32x4*)(proj + (size_t)(m0 + t) * PW + C_VB + h * 64 + e0);
        const int sd = tid >> 4, se0 = (tid & 15) * 4;
        const f32x4 s4 = *(const f32x4*)((const float*)(c.ws + WS_ST) + (size_t)(g * 4 + h) * 2048 + sd * 64 + se0);
        const float qv[4] = {bflo(q2.x), bfhi(q2.x), bflo(q2.y), bfhi(q2.y)}, kv[4] = {bflo(k2.x), bfhi(k2.x), bflo(k2.y), bfhi(k2.y)};
        float qo[4], ko[4];
#pragma unroll
        for (int i = 0; i < 4; ++i) { qo[i] = qv[i] * 0.17677669529663687f * fexp(b4[i]); ko[i] = kv[i] * fexp(-b4[i]); }
        *(u32x2*)(Qs + t * 40 + d0) = (u32x2){pk2(qo[0], qo[1]), pk2(qo[2], qo[3])};
        *(u32x2*)(Ks + t * 40 + d0) = (u32x2){pk2(ko[0], ko[1]), pk2(ko[2], ko[3])};
        const unsigned vw[4] = {v4.x, v4.y, v4.z, v4.w};
#pragma unroll
        for (int i = 0; i < 4; ++i) { Vt[(e0 + 2 * i) * 72 + t] = (bf16_t)(vw[i] & 0xffffu); Vt[(e0 + 2 * i + 1) * 72 + t] = (bf16_t)(vw[i] >> 16); }
#pragma unroll
        for (int i = 0; i < 4; ++i) ST[(se0 + i) * 40 + sd] = (bf16_t)f2bf(s4[i]);
    }
    __syncthreads();
    const int tb = w & 3, ebase = (w >> 2) * 2, tl = 16 * tb + fr;
    const bf16x8 qf = *(const bf16x8*)(Qs + tl * 40 + 8 * fq);
    f32x4 sa[4];
#pragma unroll
    for (int u = 0; u < 4; ++u) { sa[u] = (f32x4){0.f, 0.f, 0.f, 0.f};
        if (u <= tb) { const bf16x8 kf = *(const bf16x8*)(Ks + (16 * u + fr) * 40 + 8 * fq); sa[u] = __builtin_amdgcn_mfma_f32_16x16x32_bf16(kf, qf, sa[u], 0, 0, 0);
            if (u == tb) {
#pragma unroll
                for (int i = 0; i < 4; ++i) sa[u][i] = (4 * fq + i <= fr) ? sa[u][i] : 0.f; } } }
    f32x4 O[2];
#pragma unroll
    for (int eb = 0; eb < 2; ++eb) {
        const int erow = 16 * (ebase + eb) + fr;
        const bf16x8 stf = *(const bf16x8*)(ST + erow * 40 + 8 * fq);
        O[eb] = __builtin_amdgcn_mfma_f32_16x16x32_bf16(stf, qf, (f32x4){0.f, 0.f, 0.f, 0.f}, 0, 0, 0);
#pragma unroll
        for (int k2 = 0; k2 < 2; ++k2) {
            if (2 * k2 <= tb) {
                u32x4 pw; pw.x = pk2(sa[2 * k2][0], sa[2 * k2][1]); pw.y = pk2(sa[2 * k2][2], sa[2 * k2][3]); pw.z = pk2(sa[2 * k2 + 1][0], sa[2 * k2 + 1][1]); pw.w = pk2(sa[2 * k2 + 1][2], sa[2 * k2 + 1][3]);
                const bf16_t* vp = Vt + erow * 72 + 32 * k2 + 4 * fq; const u32x2 lo = *(const u32x2*)vp, hi = *(const u32x2*)(vp + 16);
                O[eb] = __builtin_amdgcn_mfma_f32_16x16x32_bf16(__builtin_bit_cast(bf16x8, (u32x4){lo.x, lo.y, hi.x, hi.y}), __builtin_bit_cast(bf16x8, pw), O[eb], 0, 0, 0);
            }
        }
    }
    float q2s = 0.f;
#pragma unroll
    for (int eb = 0; eb < 2; ++eb)
#pragma unroll
        for (int i = 0; i < 4; ++i) q2s += O[eb][i] * O[eb][i];
    q2s += __shfl_xor(q2s, 16); q2s += __shfl_xor(q2s, 32);
    if (fq == 0) red[w * 16 + fr] = q2s;
    __syncthreads();
    const float r = __builtin_amdgcn_rsqf((red[w * 16 + fr] + red[(w ^ 4) * 16 + fr]) * (1.0f / 64.0f) + EPS);
#pragma unroll
    for (int eb = 0; eb < 2; ++eb) {
        const int ecol = h * 64 + 16 * (ebase + eb) + 4 * fq;
        const u32x2 ow = *(const u32x2*)(proj + (size_t)(m0 + tl) * PW + C_OB + ecol); const f32x4 gn = *(const f32x4*)(c.in[15] + l * 256 + ecol);
        const float ob[4] = {bflo(ow.x), bfhi(ow.x), bflo(ow.y), bfhi(ow.y)}; float y[4];
#pragma unroll
        for (int i = 0; i < 4; ++i) y[i] = O[eb][i] * r * gn[i] * (ob[i] * sigm(ob[i]));
        *(u32x2*)(Y + (size_t)(m0 + tl) * D + 512 + ecol) = (u32x2){pk2(y[0], y[1]), pk2(y[2], y[3])};
    }
    __syncthreads();
}

__device__ __forceinline__ void grid_bar(unsigned* ctl, unsigned r) {
    asm volatile("s_waitcnt vmcnt(0)" ::: "memory");
    __syncthreads();
    if (threadIdx.x == 0) {
        const unsigned g = blockIdx.x & 7u, G = gridDim.x, nloc = (G - g + 7u) >> 3, ngrp = G < 8u ? G : 8u;
        unsigned* cnt = ctl + 64 * (16 + g); unsigned* gen = ctl + 64 * (24 + g); unsigned* top = ctl + 64 * 32;
        __builtin_amdgcn_fence(__ATOMIC_RELEASE, "agent");
        asm volatile("s_waitcnt vmcnt(0)" ::: "memory");
        const unsigned old = __hip_atomic_fetch_add(cnt, 1u, __ATOMIC_RELAXED, __HIP_MEMORY_SCOPE_AGENT);
        if (old + 1u == r * nloc) {
            __hip_atomic_fetch_add(top, 1u, __ATOMIC_RELAXED, __HIP_MEMORY_SCOPE_AGENT);
            while (__hip_atomic_load(top, __ATOMIC_RELAXED, __HIP_MEMORY_SCOPE_AGENT) < r * ngrp) __builtin_amdgcn_s_sleep(1);
            __hip_atomic_store(gen, r, __ATOMIC_RELAXED, __HIP_MEMORY_SCOPE_AGENT);
        } else {
            while (__hip_atomic_load(gen, __ATOMIC_RELAXED, __HIP_MEMORY_SCOPE_AGENT) < r) __builtin_amdgcn_s_sleep(1);
        }
        __builtin_amdgcn_fence(__ATOMIC_ACQUIRE, "agent");
        asm volatile("s_waitcnt vmcnt(0)" ::: "memory");
    }
    __syncthreads();
}

__global__ void __launch_bounds__(512, 2) fwd_mega(Args args) {
    extern __shared__ __attribute__((aligned(16))) unsigned char lds[];
    cg::grid_group grid = cg::this_grid();
    Ctx c; c.in = args.in; c.out = args.out; c.ws = args.ws; c.lds = (LAS unsigned char*)lds; c.ldsg = lds;
    c.tid = threadIdx.x; c.lane = c.tid & 63; c.wave = __builtin_amdgcn_readfirstlane(c.tid >> 6); c.G = gridDim.x; c.bx = blockIdx.x;
    for (int ph = args.ph_lo; ph < args.ph_hi; ++ph) {
        { int t_ = threadIdx.x; asm volatile("" : "+v"(t_)); c.tid = t_; c.lane = t_ & 63; c.wave = __builtin_amdgcn_readfirstlane(t_ >> 6); }
        unsigned char* ws = args.ws; float* outp = args.out; asm volatile("" : "+s"(ws), "+s"(outp)); c.ws = ws; c.out = outp;
        bf16_t* xb = (bf16_t*)(ws + WS_XB); bf16_t* big = (bf16_t*)(ws + WS_BIG); bf16_t* Yb = (bf16_t*)(ws + WS_Y); bf16_t* mg = (bf16_t*)(ws + WS_MG);
        float* scr = (float*)(ws + WS_SCR); float* ss0 = (float*)(ws + WS_SS); float* ss1 = ss0 + (size_t)M * 32; float* xw = outp + O_Y;
        if (ph == 0) prologue(c);
        else if (ph == 25) {
            const float* gf = args.in[28];
            for (int row = c.bx * 8 + c.wave; row < M; row += c.G * 8) { const float rs = rstd_of(ss0, row);
#pragma unroll
                for (int j = 0; j < 4; ++j) { const u32x2 h2 = *(const u32x2*)(mg + (size_t)row * D + c.lane * 4 + 256 * j); const f32x4 v = {bflo(h2.x), bfhi(h2.x), bflo(h2.y), bfhi(h2.y)}, gg = *(const f32x4*)(gf + c.lane * 4 + 256 * j);
                    *(f32x4*)(xw + (size_t)row * D + c.lane * 4 + 256 * j) = v * rs * gg; } }
        } else {
            const int l = (ph - 1) / 12, k = (ph - 1) % 12;
            if ((MK_SKIPMASK >> k) & 1) continue;
            const bf16_t* Wl = (const bf16_t*)(ws + WS_W) + (size_t)l * WL_END;
            if (k == 0 || k == 8) {
                pg8::Gemm g{(k == 0 && l > 0) ? mg : xb, Wl + (k == 0 ? WL_1IN : WL_2IN), D, D}; pg8::Sched S;     S.init(M, 2 * FF, c.G, c.bx, 16);
                EpiSwiglu E{big}; pg8::gemm_phase(c.lds, c.tid, g, S, E, ss0);
            } else if (k == 1 || k == 9 || k == 7 || k == 11) {
                pg8::Gemm g; pg8::Sched S; EpiRes E{xb, xb, nullptr, (const bf16_t*)scr, 1.f, 0, nullptr, nullptr}; const float* ssin = nullptr;
                if (k == 1 || k == 9) { g = pg8::Gemm{big, Wl + (k == 1 ? WL_1OUT : WL_2OUT), FF, FF}; S.init(M, D, c.G, c.bx, 44); S.quart = 1; E.alpha = 0.5f; E.ss_out = ss1; if (k == 1) { if (l == 0) { E.xin0 = args.in[0]; E.xin1 = args.in[1]; } else E.xsrc = mg; } }
                else if (k == 7) { g = pg8::Gemm{mg, Wl + WL_OUT, D, D}; S.init(M, D, c.G, c.bx, 16); S.quart = 1; E.ss_out = ss0; }
                else { g = pg8::Gemm{xb, Wl + WL_PG, D, D}; S.init(M, D, c.G, c.bx, 16); S.quart = 1; E.ss_out = ss0; ssin = ss1; E.mode = 1; E.xb = mg; }
                pg8::gemm_phase(c.lds, c.tid, g, S, E, ssin);
            } else if (k == 2) {
                pg8::Gemm g{xb, Wl + WL_IN, D, D}; pg8::Sched S; S.init(M, NIN, c.G, c.bx, 16); S.quart = 1;
                EpiWin E{big, outp, l}; pg8::gemm_phase(c.lds, c.tid, g, S, E, ss1);
            } else if (k == 3) {
                for (int it = next_item(c, l * 3 + 0); it < 2176 + NCH; it = next_item(c, l * 3 + 0)) { if (it < NCH) pool_unit(c, l, it); else gla_local_unit(c, l, (it - NCH) >> 2, (it - NCH) & 3); }
            } else if (k == 4) {
                for (int it = next_item(c, l * 3 + 1); it < 576 + 2176; it = next_item(c, l * 3 + 1)) { if (it < 576) scan_unit(c, l, it); else attn_unit(c, l, it - 576); }
            } else if (k == 5) {
                for (int it = next_item(c, l * 3 + 2); it < 2176; it = next_item(c, l * 3 + 2)) gla_out_unit(c, l, it >> 2, it & 3);
            } else {
                pg8::Gemm g; pg8::Sched S; EpiBranch E{big, (bf16_t*)scr, mg, 0};
                if (k == 6) { g = pg8::Gemm{Yb, Wl + WL_BR, D, D}; S.init(M, D, c.G, c.bx, 8); S.nsub = 3; S.quart = 1; }
                else { g = pg8::Gemm{(const bf16_t*)(ws + WS_PB) + (size_t)l * M * 256, Wl + WL_PP, 256, 256}; S.init(M, D, c.G, c.bx, 4); S.quart = 1; E.mode = 1; }
                pg8::gemm_phase(c.lds, c.tid, g, S, E, nullptr);
            }
        }
        if (ph + 1 < args.ph_hi) { if (args.ph_hi > 4096) grid.sync(); grid_bar((unsigned*)(args.ws + WS_CTL), (unsigned)(ph - args.ph_lo + 1)); }
    }
}

extern "C" void kernel_launch(void* const* d_in, const int* in_sizes, int n_in, void* d_out, int out_size, void* d_ws, size_t ws_size, hipStream_t stream) {
    static int grid = 0;
    if (grid == 0) {
        if (n_in != 29 || ws_size < WS_NEED) { fprintf(stderr, "kernel_launch: unexpected n_in %d / ws %zu\n", n_in, ws_size); grid = -1; return; }
        int dev = 0, cus = 0, per_cu = 0;
        (void)hipGetDevice(&dev); (void)hipDeviceGetAttribute(&cus, hipDeviceAttributeMultiprocessorCount, dev);
        (void)hipFuncSetAttribute((const void*)fwd_mega, hipFuncAttributeMaxDynamicSharedMemorySize, LDS_BYTES);
        (void)hipOccupancyMaxActiveBlocksPerMultiprocessor(&per_cu, (const void*)fwd_mega, 512, LDS_BYTES);
        (void)hipGetLastError();
        if (per_cu < 1) per_cu = 1;
        grid = cus;
    }
    if (grid < 0) return;
    (void)hipMemsetAsync((char*)d_ws + WS_CTL, 0, 16384, stream);
    Args a{};
    for (int i = 0; i < 29; ++i) a.in[i] = (const float*)d_in[i];
    a.out = (float*)d_out; a.ws = (unsigned char*)d_ws;
#if MK_ONE_LAUNCH
    a.ph_lo = 0; a.ph_hi = NPH;
    void* kargs[] = {&a};
    hipError_t e = hipLaunchCooperativeKernel((const void*)fwd_mega, dim3(grid), dim3(512), kargs, LDS_BYTES, stream);
    if (e != hipSuccess) fprintf(stderr, "cooperative launch failed: %s (grid %d)\n", hipGetErrorString(e), grid);
#else
    for (int ph = 0; ph < NPH; ++ph) { a.ph_lo = ph; a.ph_hi = ph + 1; hipLaunchKernelGGL(fwd_mega, dim3(grid), dim3(512), LDS_BYTES, stream, a); }
#endif
}
```

```cpp
#include <hip/hip_runtime.h>
#include <hip/hip_cooperative_groups.h>
#include <cstdio>
#include <cstdint>
namespace cg = cooperative_groups;

#ifndef MK_SKIPMASK
#define MK_SKIPMASK 0
#endif
#ifndef MK_NOATTN
#define MK_NOATTN 0
#endif
#ifndef MK_NOGLAOUT
#define MK_NOGLAOUT 0
#endif
#ifndef MK_ONE_LAUNCH
#define MK_ONE_LAUNCH 1
#endif

#define LAS __attribute__((address_space(3)))
typedef unsigned short bf16_t;
typedef short bf16x8 __attribute__((ext_vector_type(8)));
typedef float f32x4 __attribute__((ext_vector_type(4)));
typedef unsigned u32x4 __attribute__((ext_vector_type(4)));
typedef unsigned u32x2 __attribute__((ext_vector_type(2)));

constexpr int M = 34816;
constexpr int MP = 32768;
constexpr int D = 1024, FF = 2816, NIN = 5888, PW = 5888  , INW = 5648;
constexpr int NCH = 544;
constexpr float EPS = 1e-6f;
constexpr size_t O_Y = 0, O_KP = 35651584, O_VP = 69206016, O_GP = 102760448, O_PP = 102825984, O_KS = 102856704, O_VS = 104953856, O_GS = 107051008, O_PS = 107575296;
constexpr int C_QA = 0, C_KA = 512, C_VA = 1024, C_QB = 1536, C_KB = 1664, C_VB = 1792, C_OB = 2048, C_UC = 2304, C_G = 2560, C_RB = 5632;

constexpr size_t WL_1IN = 0, WL_1OUT = WL_1IN + (size_t)5632 * 1024, WL_IN = WL_1OUT + (size_t)1024 * 2816, WL_BR = WL_IN + (size_t)5888 * 1024, WL_OUT = WL_BR + 1048576,
                 WL_2IN = WL_OUT + 1048576, WL_2OUT = WL_2IN + (size_t)5632 * 1024, WL_PG = WL_2OUT + (size_t)1024 * 2816, WL_PP = WL_PG + 1048576, WL_END = WL_PP + 262144;
constexpr size_t MiB = 1u << 20;
constexpr size_t WS_W = 0;
constexpr size_t WS_XB = 104 * MiB;
constexpr size_t WS_PB = 172 * MiB;
constexpr size_t WS_BIG = 208 * MiB;
constexpr size_t WS_Y = 600 * MiB;
constexpr size_t WS_MG = 668 * MiB;
constexpr size_t WS_SCR = 736 * MiB;
constexpr size_t WS_SS = 934 * MiB;
constexpr size_t WS_DS = 878 * MiB;
constexpr size_t WS_ST = 896 * MiB;
constexpr size_t WS_B = 914 * MiB;
constexpr size_t WS_DEC = 932 * MiB;
constexpr size_t WS_CTL = 933 * MiB;
constexpr size_t WS_NEED = 944 * MiB;
static_assert(2 * WL_END * 2 <= 104 * MiB, "weights fit");

__device__ __forceinline__ unsigned f2bf(float f) { unsigned u = __builtin_bit_cast(unsigned, f); return (u + 0x7fffu + ((u >> 16) & 1u)) >> 16; }
__device__ __forceinline__ unsigned pk2(float lo, float hi) { unsigned r; asm("v_cvt_pk_bf16_f32 %0, %1, %2" : "=v"(r) : "v"(lo), "v"(hi)); return r; }
__device__ __forceinline__ float bflo(unsigned u) { return __uint_as_float(u << 16); }
__device__ __forceinline__ float bfhi(unsigned u) { return __uint_as_float(u & 0xffff0000u); }
__device__ __forceinline__ float bf2f(bf16_t b) { return __uint_as_float((unsigned)b << 16); }
__device__ __forceinline__ float fexp(float x) { return __builtin_amdgcn_exp2f(x * 1.4426950408889634f); }
__device__ __forceinline__ float flog(float x) { return __builtin_amdgcn_logf(x) * 0.6931471805599453f; }
__device__ __forceinline__ float sigm(float x) { return __builtin_amdgcn_rcpf(1.0f + fexp(-x)); }
__device__ __forceinline__ float softplus(float z) { return fmaxf(z, 0.f) + flog(1.0f + fexp(-fabsf(z))); }
__device__ __forceinline__ float rstd_of(const float* ss, int row) {
    const f32x4* p = (const f32x4*)(ss + (size_t)row * 32);
    float s = 0.f;
#pragma unroll
    for (int i = 0; i < 8; ++i) { const f32x4 a = p[i]; s += (a[0] + a[1]) + (a[2] + a[3]); }
    return __builtin_amdgcn_rsqf(s * (1.0f / 1024.0f) + EPS);
}

namespace pg8 {
constexpr int BM = 256, BK = 64, HALF = 128, HTB = HALF * BK * 2, STAGE_BYTES = 8 * HTB, NXCD = 8, WGM = 8;
__host__ __device__ __forceinline__ int lds_byte(int r, int c) { const int st = (r >> 4) * 2 + (c >> 5), rr = r & 15, cc = c & 31, ob = rr * 64 + cc * 2; return st * 1024 + (ob ^ (((ob >> 9) & 1) << 5)); }
__host__ __device__ __forceinline__ void stage_rc(int b, int& R, int& C) { const int st = b / 1024, sb = b % 1024, swz = sb ^ (((sb >> 9) & 1) << 5); R = (st >> 1) * 16 + swz / 64; C = (st & 1) * 32 + (swz % 64) / 2; }
__host__ __device__ __forceinline__ int perm32(int rho) { const int n = rho >> 4, i = rho & 15; return 8 * (i >> 2) + 4 * n + (i & 3); }

struct Unit { int pm, pn, kind, k0, nt, qm; };
struct Gemm { const bf16_t* A; const bf16_t* Bt; int lda, ldb; };

struct Sched {
    int nM, nN, nwg, G, c, nsub, nt0, quart;
    __device__ __forceinline__ void init(int M_, int N_, int G_, int c_, int nt) { nM = M_ / BM; nN = N_ / BM; nwg = nM * nN; G = G_; c = c_; nsub = 1; nt0 = nt; quart = 0; }
    __device__ __forceinline__ bool next(int i, Unit& u) const {
        const int ti = i / nsub, sk = i - ti * nsub;
        long L = (long)ti * G + c; int qm = 0xF;
        const int nfull = nwg / G;
        if (quart && ti >= nfull) {
            const long li = (long)(ti - nfull) * G + c; if (li >= 4L * (nwg - nfull * G)) return false;
            L = (long)nfull * G + (li >> 2); qm = 1 << (int)(li & 3);
        } else if (L >= nwg) return false;
        u.qm = qm;
        int wgid = (int)L; { const int q = nwg / NXCD, r = nwg % NXCD, xcd = wgid % NXCD, off = wgid / NXCD; wgid = (xcd < r ? xcd * (q + 1) : r * (q + 1) + (xcd - r) * q) + off; }
        const int nig = WGM * nN, gid = wgid / nig, fm = gid * WGM, gsz = (nM - fm) < WGM ? (nM - fm) : WGM;
        u.pm = fm + ((wgid % nig) % gsz); u.pn = (wgid % nig) / gsz; u.kind = sk; u.k0 = (sk > 0) ? 256 + 256 * sk : 0; u.nt = (sk > 0) ? 4 : nt0; return true;
    }
};

#define PG8_KLOOP(C0, C1, C2, C3) \
        for (int t = 0; t < nt; t += 2) { \
            const bool last = (t == nt - 2); \
            const char* a1 = cA + (size_t)(t + 1) * kstep; \
            const char* a2 = last ? nA : cA + (size_t)(t + 2) * kstep; const char* b2 = last ? nB : cB + (size_t)(t + 2) * kstep; \
            const char* a3 = a2 + kstep; const char* b3 = b2 + kstep; \
            PG8_LDB(B0, 0, 0); PG8_LDB(B1, 0, 1); PG8_SCHED; PG8_LDA(At, 0, 0); PG8_STAGE(PG8_SA(1, 1), a1 + hstepA, voffA); \
            PG8_WAIT_V(8); PG8_WAIT_L(0); PG8_BAR; if (C0) PG8_MMA(0, 0, At, B0); if (C1) PG8_MMA(0, 1, At, B1); PG8_BAR; PG8_SCHED; \
            PG8_LDA(At, 0, 1); PG8_STAGE(PG8_SB(0, 0), b2, voffB); PG8_STAGE(PG8_SB(0, 1), b2 + hstepB, voffB); PG8_STAGE(PG8_SA(0, 0), a2, voffA); \
            PG8_WAIT_V(8); PG8_WAIT_L(0); PG8_BAR; if (C2) PG8_MMA(1, 0, At, B0); if (C3) PG8_MMA(1, 1, At, B1); PG8_BAR; PG8_SCHED; \
            PG8_LDB(B0, 1, 0); PG8_LDB(B1, 1, 1); PG8_SCHED; PG8_LDA(At, 1, 0); PG8_STAGE(PG8_SA(0, 1), a2 + hstepA, voffA); \
            PG8_WAIT_V(8); PG8_WAIT_L(0); PG8_BAR; if (C0) PG8_MMA(0, 0, At, B0); if (C1) PG8_MMA(0, 1, At, B1); PG8_BAR; PG8_SCHED; \
            PG8_LDA(At, 1, 1); PG8_STAGE(PG8_SB(1, 0), b3, voffB); PG8_STAGE(PG8_SB(1, 1), b3 + hstepB, voffB); PG8_STAGE(PG8_SA(1, 0), a3, voffA); \
            PG8_WAIT_V(8); PG8_WAIT_L(0); PG8_BAR; if (C2) PG8_MMA(1, 0, At, B0); if (C3) PG8_MMA(1, 1, At, B1); PG8_BAR; PG8_SCHED; \
        }
template <class Epi, class Sch>
__device__ __forceinline__ void gemm_phase(LAS unsigned char* lds, const int tid, const Gemm g, const Sch& S, const Epi& E, const float* ss) {
    const int wid = __builtin_amdgcn_readfirstlane(tid >> 6), lane = tid & 63, wr = wid >> 2, wc = wid & 3, fr = lane & 15, fq = lane >> 4;
    unsigned voffA[2], voffB[2];
#pragma unroll
    for (int i = 0; i < 2; ++i) { int R, C; stage_rc(tid * 16 + i * 8192, R, C); const int Rb = (R & ~31) + perm32(R & 31);
        voffA[i] = (unsigned)(R * g.lda + C) * 2u; voffB[i] = (unsigned)(Rb * g.ldb + C) * 2u; }
    const size_t kstep = (size_t)(BK * 2);
    const size_t hstepA = (size_t)HALF * g.lda * 2, hstepB = (size_t)HALF * g.ldb * 2;
    const size_t tstepA = 2 * hstepA, tstepB = 2 * hstepB;
    const unsigned ldsw = (unsigned)wid * 1024u;
    const int aoff = lds_byte(wr * 64 + fr, fq * 8), boff = lds_byte(wc * 32 + fr, fq * 8);
    LAS float* rtab = (LAS float*)(lds + STAGE_BYTES);
    f32x4 rt_a = {0.f, 0.f, 0.f, 0.f}, rt_b = rt_a, rt_c = rt_a, rt_d = rt_a;
#define PG8_RTAB_LOAD(pm_) do { if (ss) { const f32x4* p_ = (const f32x4*)(ss + ((size_t)(pm_) * 256 + (tid >> 1)) * 32 + (tid & 1) * 16); rt_a = p_[0]; rt_b = p_[1]; rt_c = p_[2]; rt_d = p_[3]; } } while (0)
#define PG8_RTAB_FIN(buf_) do { if (ss) { float s_ = (((rt_a[0] + rt_a[1]) + (rt_a[2] + rt_a[3])) + ((rt_b[0] + rt_b[1]) + (rt_b[2] + rt_b[3]))) + (((rt_c[0] + rt_c[1]) + (rt_c[2] + rt_c[3])) + ((rt_d[0] + rt_d[1]) + (rt_d[2] + rt_d[3]))); \
        s_ += __shfl_xor(s_, 1); if (!(tid & 1)) rtab[(buf_) * 256 + (tid >> 1)] = __builtin_amdgcn_rsqf(s_ * (1.0f / 1024.0f) + EPS); } } while (0)
#define PG8_SA(b, h) (((b) * 2 + (h)) * HTB)
#define PG8_SB(b, h) ((4 + (b) * 2 + (h)) * HTB)
#define PG8_STAGE(bufoff, gbase, voff) do { _Pragma("unroll") for (int _i = 0; _i < 2; ++_i) \
        __builtin_amdgcn_global_load_lds((const unsigned*)((const char*)(gbase) + (voff)[_i]), (LAS unsigned*)(lds + (bufoff) + ldsw + _i * 8192), 16, 0, 0); } while (0)
#define PG8_LDA(dst, b, h) do { _Pragma("unroll") for (int m = 0; m < 4; ++m) _Pragma("unroll") for (int k = 0; k < 2; ++k) dst[m][k] = *(const LAS bf16x8*)(lds + PG8_SA(b, h) + aoff + m * 2048 + k * 1024); } while (0)
#define PG8_LDB(dst, b, h) do { _Pragma("unroll") for (int n = 0; n < 2; ++n) _Pragma("unroll") for (int k = 0; k < 2; ++k) dst[n][k] = *(const LAS bf16x8*)(lds + PG8_SB(b, h) + boff + n * 2048 + k * 1024); } while (0)
#define PG8_MMA(ai, bj, At, Bt) do { __builtin_amdgcn_s_setprio(1); _Pragma("unroll") for (int m = 0; m < 4; ++m) _Pragma("unroll") for (int n = 0; n < 2; ++n) _Pragma("unroll") for (int k = 0; k < 2; ++k) \
        acc[ai][bj][m][n] = __builtin_amdgcn_mfma_f32_16x16x32_bf16(Bt[n][k], At[m][k], acc[ai][bj][m][n], 0, 0, 0); __builtin_amdgcn_s_setprio(0); } while (0)
#define PG8_WAIT_V(n) asm volatile("s_waitcnt vmcnt(" #n ")" ::: "memory")
#define PG8_WAIT_L(n) asm volatile("s_waitcnt lgkmcnt(" #n ")" ::: "memory")
#define PG8_BAR __builtin_amdgcn_s_barrier()
#define PG8_SCHED __builtin_amdgcn_sched_barrier(0)
    Unit cur, nxt; int ui = 0;
    if (!S.next(0, cur)) return;
    f32x4 acc[2][2][4][2];
#pragma unroll
    for (int a = 0; a < 2; ++a)
#pragma unroll
        for (int b = 0; b < 2; ++b)
#pragma unroll
            for (int m = 0; m < 4; ++m)
#pragma unroll
                for (int n = 0; n < 2; ++n) acc[a][b][m][n] = (f32x4){0.f, 0.f, 0.f, 0.f};
    bf16x8 At[4][2], B0[2][2], B1[2][2];
    const char* cA = (const char*)g.A + (size_t)cur.pm * tstepA + (size_t)cur.k0 * 2; const char* cB = (const char*)g.Bt + (size_t)cur.pn * tstepB + (size_t)cur.k0 * 2;
    PG8_RTAB_LOAD(cur.pm); PG8_RTAB_FIN(0);
    PG8_STAGE(PG8_SB(0, 0), cB, voffB); PG8_STAGE(PG8_SB(0, 1), cB + hstepB, voffB); PG8_STAGE(PG8_SA(0, 0), cA, voffA); PG8_STAGE(PG8_SA(0, 1), cA + hstepA, voffA);
    if (wr == 1) PG8_BAR;
    PG8_WAIT_V(2); PG8_BAR;
    PG8_STAGE(PG8_SB(1, 0), cB + kstep, voffB); PG8_STAGE(PG8_SA(1, 0), cA + kstep, voffA); PG8_STAGE(PG8_SB(1, 1), cB + hstepB + kstep, voffB);
    PG8_WAIT_V(6); PG8_BAR;
    for (;;) {
        const bool has_next = S.next(ui + 1, nxt);
        const char* nA = has_next ? (const char*)g.A + (size_t)nxt.pm * tstepA + (size_t)nxt.k0 * 2 : cA; const char* nB = has_next ? (const char*)g.Bt + (size_t)nxt.pn * tstepB + (size_t)nxt.k0 * 2 : cB;
        const int nt = cur.nt, qm = cur.qm;
        if (qm == 0xF) { PG8_KLOOP(true, true, true, true) } else { PG8_KLOOP((qm & 1), (qm & 2), (qm & 4), (qm & 8)) }
        if (wr == 0) PG8_BAR;
        if (has_next) PG8_RTAB_LOAD(nxt.pm);
        E(acc, cur, wr, wc, fr, fq, rtab + (ui & 1) * 256);
        if (!has_next) break;
#pragma unroll
        for (int a = 0; a < 2; ++a)
#pragma unroll
            for (int b = 0; b < 2; ++b)
#pragma unroll
                for (int m = 0; m < 4; ++m)
#pragma unroll
                    for (int n = 0; n < 2; ++n) acc[a][b][m][n] = (f32x4){0.f, 0.f, 0.f, 0.f};
        cur = nxt; cA = nA; cB = nB; ++ui;
        PG8_RTAB_FIN(ui & 1);
        if (wr == 1) PG8_BAR;
    }
    PG8_WAIT_V(0);
    PG8_BAR;
#undef PG8_SA
#undef PG8_RTAB_LOAD
#undef PG8_RTAB_FIN
#undef PG8_SB
#undef PG8_STAGE
#undef PG8_LDA
#undef PG8_LDB
#undef PG8_MMA
#undef PG8_WAIT_V
#undef PG8_WAIT_L
#undef PG8_BAR
#undef PG8_SCHED
}
}
using pg8::Unit;

#define EPI_FENCE() asm volatile("" ::: "memory")
struct EpiSwiglu {
    bf16_t* hid;
    __device__ __forceinline__ void operator()(const f32x4 (&acc)[2][2][4][2], const Unit& u, int wr, int wc, int fr, int fq, const LAS float* rt) const {
        const int row0 = u.pm * 256 + wr * 64 + fr, col = u.pn * 128 + wc * 32 + 8 * fq;
#pragma unroll
        for (int ai = 0; ai < 2; ++ai)
#pragma unroll
            for (int m = 0; m < 4; ++m) {
                const int rl = ai * 128 + m * 16; const int row = row0 + rl; const float rs = rt[wr * 64 + fr + rl];
                float h[8];
#pragma unroll
                for (int n = 0; n < 2; ++n)
#pragma unroll
                    for (int i = 0; i < 4; ++i) { const float a = acc[ai][0][m][n][i] * rs, b = acc[ai][1][m][n][i] * rs; h[4 * n + i] = a * sigm(a) * b; }
                u32x4 w; w.x = pk2(h[0], h[1]); w.y = pk2(h[2], h[3]); w.z = pk2(h[4], h[5]); w.w = pk2(h[6], h[7]);
                *(u32x4*)(hid + (size_t)row * FF + col) = w;
            }
    }
};
struct EpiWin {
    bf16_t* proj; float* out; int layer;
    __device__ __forceinline__ void operator()(const f32x4 (&acc)[2][2][4][2], const Unit& u, int wr, int wc, int fr, int fq, const LAS float* rt) const {
        const int row0 = u.pm * 256 + wr * 64 + fr, pn = u.pn;
        const bool isgate = (pn >= 10 && pn < 22), iskv = (pn >= 2 && pn < 6), ispool = (pn == 9);
#pragma unroll
        for (int ai = 0; ai < 2; ++ai)
#pragma unroll
            for (int m = 0; m < 4; ++m) {
                const int rl = ai * 128 + m * 16; const int row = row0 + rl; const float rs = rt[wr * 64 + fr + rl];
#pragma unroll
                for (int bj = 0; bj < 2; ++bj) {
                    if (!((u.qm >> (ai * 2 + bj)) & 1)) continue;
                    const int ct = bj * 128 + wc * 32 + 8 * fq;
                    f32x4 v0 = acc[ai][bj][m][0] * rs, v1 = acc[ai][bj][m][1] * rs;
                    if (isgate) {
#pragma unroll
                        for (int i = 0; i < 4; ++i) { v0[i] = sigm(v0[i]); v1[i] = sigm(v1[i]); }
                    }
                    u32x4 w; w.x = pk2(v0[0], v0[1]); w.y = pk2(v0[2], v0[3]); w.z = pk2(v1[0], v1[1]); w.w = pk2(v1[2], v1[3]);
                    *(u32x4*)(proj + (size_t)row * PW + pn * 256 + ct) = w;
                    if (iskv) {
                        const int c512 = (pn & 1) * 256 + ct; const bool isv = pn >= 4;
                        float* dst = row < MP ? out + (isv ? O_VP : O_KP) + ((size_t)layer * MP + row) * 512 + c512
                                              : out + (isv ? O_VS : O_KS) + ((size_t)layer * 2048 + (row - MP)) * 512 + c512;
                        *(f32x4*)dst = v0; *(f32x4*)(dst + 4) = v1;
                    }
                    if (ispool) {
                        if (row < MP) { const int t = row & 8191, b = row >> 13; if (t >= 8177) { float* dst = out + O_PP + ((size_t)(layer * 4 + b) * 15 + (t - 8177)) * 256 + ct; *(f32x4*)dst = v0; *(f32x4*)(dst + 4) = v1; } }
                        else { const int r = row - MP, t = r & 63, sb = r >> 6; if (t >= 49) { float* dst = out + O_PS + ((size_t)(layer * 32 + sb) * 15 + (t - 49)) * 256 + ct; *(f32x4*)dst = v0; *(f32x4*)(dst + 4) = v1; } }
                    }
                }
            }
    }
};
struct EpiRes {
    const bf16_t* xsrc; bf16_t* xb; float* ss_out; const bf16_t* scr; float alpha; int mode; const float* xin0; const float* xin1;
    __device__ __forceinline__ void operator()(const f32x4 (&acc)[2][2][4][2], const Unit& u, int wr, int wc, int fr, int fq, const LAS float* rt) const {
        const int row0 = u.pm * 256 + wr * 64 + fr, colb = u.pn * 256 + wc * 32 + 8 * fq;
        const float* xr = xin0 ? (u.pm < MP / 256 ? xin0 : xin1 - (size_t)MP * D) : nullptr;
#pragma unroll
        for (int ai = 0; ai < 2; ++ai) {
            if (!((u.qm >> (2 * ai)) & 3)) continue;
#pragma unroll
            for (int mp = 0; mp < 2; ++mp) {
                f32x4 xv[2][2][2]; u32x4 sv[2][2];
#pragma unroll
                for (int mi = 0; mi < 2; ++mi)
#pragma unroll
                    for (int bj = 0; bj < 2; ++bj) {
                        const size_t off = (size_t)(row0 + ai * 128 + (2 * mp + mi) * 16) * D + colb + bj * 128;
                        if (xr) { xv[mi][bj][0] = *(const f32x4*)(xr + off); xv[mi][bj][1] = *(const f32x4*)(xr + off + 4); }
                        else xv[mi][bj][0] = __builtin_bit_cast(f32x4, *(const u32x4*)(xsrc + off));
                        if (mode == 1) sv[mi][bj] = *(const u32x4*)(scr + off);
                    }
#pragma unroll
                for (int mi = 0; mi < 2; ++mi) {
                    const int m = 2 * mp + mi, rl = ai * 128 + m * 16, row = row0 + rl;
                    const float rs = (mode == 1) ? rt[wr * 64 + fr + rl] : 1.f;
#pragma unroll
                    for (int bj = 0; bj < 2; ++bj) {
                        if (!((u.qm >> (ai * 2 + bj)) & 1)) continue;
                        const size_t off = (size_t)row * D + colb + bj * 128;
                        f32x4 v0 = acc[ai][bj][m][0], v1 = acc[ai][bj][m][1];
                        if (mode == 1) {
#pragma unroll
                            for (int i = 0; i < 4; ++i) { v0[i] = sigm(v0[i] * rs); v1[i] = sigm(v1[i] * rs); }
                            { const u32x4 p4 = sv[mi][bj]; v0[0] *= bflo(p4.x); v0[1] *= bfhi(p4.x); v0[2] *= bflo(p4.y); v0[3] *= bfhi(p4.y); v1[0] *= bflo(p4.z); v1[1] *= bfhi(p4.z); v1[2] *= bflo(p4.w); v1[3] *= bfhi(p4.w); }
                        } else { v0 = v0 * alpha; v1 = v1 * alpha; }
                        f32x4 o0, o1;
                        if (xr) { o0 = xv[mi][bj][0]; o1 = xv[mi][bj][1]; }
                        else { const u32x4 h4 = __builtin_bit_cast(u32x4, xv[mi][bj][0]); o0 = (f32x4){bflo(h4.x), bfhi(h4.x), bflo(h4.y), bfhi(h4.y)}; o1 = (f32x4){bflo(h4.z), bfhi(h4.z), bflo(h4.w), bfhi(h4.w)}; }
                        const f32x4 x0 = o0 + v0, x1 = o1 + v1;
                        u32x4 w; w.x = pk2(x0[0], x0[1]); w.y = pk2(x0[2], x0[3]); w.z = pk2(x1[0], x1[1]); w.w = pk2(x1[2], x1[3]);
                        *(u32x4*)(xb + off) = w;
                        float ssum = (x0[0] * x0[0] + x0[1] * x0[1]) + (x0[2] * x0[2] + x0[3] * x0[3]) + (x1[0] * x1[0] + x1[1] * x1[1]) + (x1[2] * x1[2] + x1[3] * x1[3]);
                        ssum += __shfl_xor(ssum, 16); ssum += __shfl_xor(ssum, 32);
                        if (fq == 0) ss_out[(size_t)row * 32 + u.pn * 8 + bj * 4 + wc] = ssum;
                    }
                }
                EPI_FENCE();
            }
        }
    }
};
struct EpiBranch {
    const bf16_t* proj; bf16_t* scr; bf16_t* merged; int mode;
    template <int BR>
    __device__ __forceinline__ void run(const f32x4 (&acc)[2][2][4][2], const Unit& u, int wr, int wc, int fr, int fq) const {
        const int row0 = u.pm * 256 + wr * 64 + fr, colb = u.pn * 256 + wc * 32 + 8 * fq;
#pragma unroll
        for (int ai = 0; ai < 2; ++ai) {
            if (!((u.qm >> (2 * ai)) & 3)) continue;
#pragma unroll
            for (int mp = 0; mp < 2; ++mp) {
                u32x4 gt[2][2], sv[2][2];
#pragma unroll
                for (int mi = 0; mi < 2; ++mi)
#pragma unroll
                    for (int bj = 0; bj < 2; ++bj) {
                        const int row = row0 + ai * 128 + (2 * mp + mi) * 16, col = colb + bj * 128; const size_t off = (size_t)row * D + col;
                        if (BR < 3) gt[mi][bj] = *(const u32x4*)(proj + (size_t)row * PW + C_G + BR * 1024 + col);
                        if (BR == 1 || BR == 2) sv[mi][bj] = *(const u32x4*)(scr + off);
                    }
#pragma unroll
                for (int mi = 0; mi < 2; ++mi)
#pragma unroll
                    for (int bj = 0; bj < 2; ++bj) {
                        if (!((u.qm >> (ai * 2 + bj)) & 1)) continue;
                        const int m = 2 * mp + mi, row = row0 + ai * 128 + m * 16, col = colb + bj * 128; const size_t off = (size_t)row * D + col;
                        f32x4 v0 = acc[ai][bj][m][0], v1 = acc[ai][bj][m][1];
                        if (BR < 3) { const u32x4 g4 = gt[mi][bj];
                            v0[0] *= bflo(g4.x); v0[1] *= bfhi(g4.x); v0[2] *= bflo(g4.y); v0[3] *= bfhi(g4.y);
                            v1[0] *= bflo(g4.z); v1[1] *= bfhi(g4.z); v1[2] *= bflo(g4.w); v1[3] *= bfhi(g4.w); }
                        if (BR == 1 || BR == 2) { const u32x4 p4 = sv[mi][bj]; v0[0] += bflo(p4.x); v0[1] += bfhi(p4.x); v0[2] += bflo(p4.y); v0[3] += bfhi(p4.y); v1[0] += bflo(p4.z); v1[1] += bfhi(p4.z); v1[2] += bflo(p4.w); v1[3] += bfhi(p4.w); }
                        { u32x4 w; w.x = pk2(v0[0], v0[1]); w.y = pk2(v0[2], v0[3]); w.z = pk2(v1[0], v1[1]); w.w = pk2(v1[2], v1[3]); *(u32x4*)((BR == 2 ? merged : scr) + off) = w; }
                    }
                EPI_FENCE();
            }
        }
    }
    __device__ __forceinline__ void operator()(const f32x4 (&acc)[2][2][4][2], const Unit& u, int wr, int wc, int fr, int fq, const LAS float* rt) const {
        if (mode == 1) run<3>(acc, u, wr, wc, fr, fq);
        else if (u.kind == 0) run<0>(acc, u, wr, wc, fr, fq);
        else if (u.kind == 1) run<1>(acc, u, wr, wc, fr, fq);
        else run<2>(acc, u, wr, wc, fr, fq);
    }
};

struct Args { const float* in[29]; float* out; unsigned char* ws; int ph_lo, ph_hi; };
constexpr int NPH = 26;
constexpr int LDS_BYTES = 147456;

struct Ctx {
    const float* const* in; float* out; unsigned char* ws; LAS unsigned char* lds; unsigned char* ldsg; int tid, lane, wave, G, bx;
};

enum { MAP_ID = 0, MAP_SWIGLU = 1, MAP_WIN = 2 };
__device__ __forceinline__ int map_col(int mode, int n) {
    if (mode == MAP_ID) return n;
    if (mode == MAP_SWIGLU) { const int p = n >> 8, j = n & 255; return j < 128 ? p * 128 + j : FF + p * 128 + (j - 128); }
    if (n < 2048) return n;
    if (n < 2304) return 2064 + (n - 2048);
    if (n < 2560) return 2320 + (n - 2304);
    if (n < 5632) return 2576 + (n - 2560);
    if (n < 5648) return 2048 + (n - 5632);
    return -1;
}
__device__ __forceinline__ void tconv(const Ctx& c, const float* src, int ldsrc, int K, bf16_t* dst, int lddst, int Nout, int mode, const float* g, int& toff) {
    float* tile = (float*)c.ldsg;
    const int ntn = Nout / 64, ntk = K / 256, nt = ntn * ntk;
    const int first = (c.bx + c.G - (toff % c.G)) % c.G; toff += nt;
    for (int it = first; it < nt; it += c.G) {
        const int tn = it % ntn, tk = it / ntn, n0 = tn * 64, k0 = tk * 256;
        const int nn = c.tid & 63, sc = map_col(mode, n0 + nn), kq = c.tid >> 6;
        float v[32];
#pragma unroll
        for (int i = 0; i < 32; ++i) { const int kk = kq + 8 * i; v[i] = (sc >= 0) ? src[(size_t)(k0 + kk) * ldsrc + sc] : 0.f; }
        if (g) {
#pragma unroll
            for (int i = 0; i < 32; ++i) v[i] *= g[k0 + kq + 8 * i];
        }
#pragma unroll
        for (int i = 0; i < 32; ++i) tile[(kq + 8 * i) * 65 + nn] = v[i];
        __syncthreads();
        { const int n2 = c.tid >> 3, kg = c.tid & 7;
#pragma unroll
          for (int j = 0; j < 4; ++j) { const float* s = tile + (kg * 8 + 64 * j) * 65 + n2;
              u32x4 o; o.x = pk2(s[0], s[65]); o.y = pk2(s[130], s[195]); o.z = pk2(s[260], s[325]); o.w = pk2(s[390], s[455]);
              *(u32x4*)(dst + (size_t)(n0 + n2) * lddst + k0 + kg * 8 + 64 * j) = o; } }
        __syncthreads();
    }
}
__device__ __forceinline__ float wave_sum(float v) {
#pragma unroll
    for (int o = 1; o < 64; o <<= 1) v += __shfl_xor(v, o);
    return v;
}
__device__ __forceinline__ void prologue(const Ctx& c) {
    bf16_t* W = (bf16_t*)(c.ws + WS_W);
    int toff = 0;
    for (int l = 0; l < 2; ++l) {
        bf16_t* Wl = W + (size_t)l * WL_END;
        tconv(c, c.in[9] + (size_t)l * D * 2 * FF, 2 * FF, D, Wl + WL_1IN, D, 2 * FF, MAP_SWIGLU, c.in[8] + l * D, toff);
        tconv(c, c.in[10] + (size_t)l * FF * D, D, FF, Wl + WL_1OUT, FF, D, MAP_ID, nullptr, toff);
        tconv(c, c.in[12] + (size_t)l * D * INW, INW, D, Wl + WL_IN, D, NIN, MAP_WIN, c.in[11] + l * D, toff);
        tconv(c, c.in[18] + (size_t)l * 512 * D, D, 512, Wl + WL_BR, D, D, MAP_ID, nullptr, toff);
        tconv(c, c.in[19] + (size_t)l * 256 * D, D, 256, Wl + WL_BR + 512, D, D, MAP_ID, nullptr, toff);
        tconv(c, c.in[21] + (size_t)l * D * D, D, D, Wl + WL_OUT, D, D, MAP_ID, nullptr, toff);
        tconv(c, c.in[23] + (size_t)l * D * 2 * FF, 2 * FF, D, Wl + WL_2IN, D, 2 * FF, MAP_SWIGLU, c.in[22] + l * D, toff);
        tconv(c, c.in[24] + (size_t)l * FF * D, D, FF, Wl + WL_2OUT, FF, D, MAP_ID, nullptr, toff);
        tconv(c, c.in[26] + (size_t)l * D * D, D, D, Wl + WL_PG, D, D, MAP_ID, c.in[25] + l * D, toff);
        tconv(c, c.in[27] + (size_t)l * 256 * D, D, 256, Wl + WL_PP, 256, D, MAP_ID, nullptr, toff);
        const float* pw = c.in[16] + (size_t)l * 4 * 64 * 64; const float* psc = c.in[17] + l * 256; const float* wc = c.in[20] + (size_t)l * 256 * D;
        for (int idx = c.bx * 512 + c.tid; idx < 256 * 1024; idx += c.G * 512) {
            const int n = idx & 1023, kc = idx >> 10, gq = kc >> 6, cc = kc & 63; float s = 0.f;
#pragma unroll 8
            for (int dd = 0; dd < 64; ++dd) s += pw[(gq * 64 + cc) * 64 + dd] * psc[gq * 64 + dd] * wc[(size_t)(gq * 64 + dd) * D + n];
            Wl[WL_BR + (size_t)n * D + 768 + kc] = (bf16_t)f2bf(s);
        }
    }
    bf16_t* xb = (bf16_t*)(c.ws + WS_XB); float* ss0 = (float*)(c.ws + WS_SS);
    for (int row2 = (c.bx * 8 + c.wave) * 2; row2 < M; row2 += c.G * 16) {
        f32x4 v[2][4]; float s[2] = {0.f, 0.f};
#pragma unroll
        for (int r = 0; r < 2; ++r) { const int row = row2 + r; const float* src = row < MP ? c.in[0] + (size_t)row * D : c.in[1] + (size_t)(row - MP) * D;
#pragma unroll
            for (int j = 0; j < 4; ++j) v[r][j] = *(const f32x4*)(src + c.lane * 4 + 256 * j); }
#pragma unroll
        for (int r = 0; r < 2; ++r) {
#pragma unroll
            for (int j = 0; j < 4; ++j) s[r] += (v[r][j][0] * v[r][j][0] + v[r][j][1] * v[r][j][1]) + (v[r][j][2] * v[r][j][2] + v[r][j][3] * v[r][j][3]); }
#pragma unroll
        for (int o = 1; o < 64; o <<= 1) { s[0] += __shfl_xor(s[0], o); s[1] += __shfl_xor(s[1], o); }
#pragma unroll
        for (int r = 0; r < 2; ++r) { const int row = row2 + r;
#pragma unroll
            for (int j = 0; j < 4; ++j) { u32x2 w; w.x = pk2(v[r][j][0], v[r][j][1]); w.y = pk2(v[r][j][2], v[r][j][3]); *(u32x2*)(xb + (size_t)row * D + c.lane * 4 + 256 * j) = w; }
            if (c.lane < 32) ss0[(size_t)row * 32 + c.lane] = c.lane == 0 ? s[r] : 0.f; }
    }
    bf16_t* pb = (bf16_t*)(c.ws + WS_PB);
#pragma unroll 4
    for (size_t i4 = (size_t)c.bx * 512 + c.tid; i4 < (size_t)2 * M * 64; i4 += (size_t)c.G * 512) {
        const size_t e = i4 * 4; const int l = (int)(e / ((size_t)M * 256)); const size_t r = e - (size_t)l * M * 256; const int row = (int)(r >> 8), cc = (int)(r & 255);
        const float* src = row < MP ? c.in[6] + ((size_t)l * MP + row) * 256 + cc : c.in[7] + ((size_t)l * 2048 + (row - MP)) * 256 + cc;
        const f32x4 v = *(const f32x4*)src; u32x2 w; w.x = pk2(v[0], v[1]); w.y = pk2(v[2], v[3]); *(u32x2*)(pb + e) = w;
    }
}

__device__ __forceinline__ int next_item(const Ctx& c, int slot) {
    volatile int* sh = (volatile int*)(c.ldsg + 147392);
    __syncthreads();
    if (c.tid == 0) *sh = (int)__hip_atomic_fetch_add((unsigned*)(c.ws + WS_CTL) + 64 * (1 + slot), 1u, __ATOMIC_RELAXED, __HIP_MEMORY_SCOPE_AGENT);
    __syncthreads();
    return *sh;
}
__device__ __forceinline__ void gla_local_unit(const Ctx& c, int l, int g, int h) {
    float* L = (float*)c.ldsg; float* rs = L; float* wg = L + 1024; float* bg = L + 1536; float* la = L + 1600;
    bf16_t* KtT = (bf16_t*)(c.ldsg + 14848); bf16_t* Vt = KtT + 2304;
    const bf16_t* proj = (const bf16_t*)(c.ws + WS_BIG); const int m0 = g * 64, tid = c.tid;
    { const int e = tid * 2, row = e >> 4, cc = e & 15; const unsigned w = *(const unsigned*)(proj + (size_t)(m0 + row) * PW + C_RB + cc); rs[e] = bflo(w); rs[e + 1] = bfhi(w); }
    { const int j = tid >> 5, d = tid & 31; wg[tid] = c.in[13][(size_t)(l * 16 + j) * 128 + h * 32 + d]; }
    if (tid < 32) bg[tid] = c.in[14][l * 128 + h * 32 + tid];
    bf16_t kraw[4];
#pragma unroll
    for (int i = 0; i < 4; ++i) { const int o = tid + 512 * i, t = o >> 5, d = o & 31; kraw[i] = proj[(size_t)(m0 + t) * PW + C_KB + h * 32 + d]; }
    const u32x4 vraw = *(const u32x4*)(proj + (size_t)(m0 + (tid >> 3)) * PW + C_VB + h * 64 + (tid & 7) * 8);
    __syncthreads();
#pragma unroll
    for (int i = 0; i < 4; ++i) { const int o = tid + 512 * i, t = o >> 5, d = o & 31; float a = bg[d];
#pragma unroll
        for (int j = 0; j < 16; ++j) a += rs[t * 16 + j] * wg[j * 32 + d];
        la[t * 33 + d] = (fminf(a, 0.f) - flog(1.0f + fexp(-fabsf(a)))) * (1.0f / 16.0f); }
    __syncthreads();
    {
#pragma unroll
        for (int j = 0; j < 4; ++j) { const int d = c.wave * 4 + j; float v = la[c.lane * 33 + d];
#pragma unroll
            for (int o = 1; o < 64; o <<= 1) { const float n = __shfl_up(v, o); if (c.lane >= o) v += n; }
            la[c.lane * 33 + d] = v; }
    }
    __syncthreads();
    float* bws = (float*)(c.ws + WS_B);
#pragma unroll
    for (int i = 0; i < 4; ++i) { const int o = tid + 512 * i, t = o >> 5, d = o & 31; const float b = la[t * 33 + d];
        bws[(size_t)(m0 + t) * 128 + h * 32 + d] = b;
        KtT[d * 72 + t] = (bf16_t)f2bf(bf2f(kraw[i]) * fexp(-b)); }
    { const int t = tid >> 3, e0 = (tid & 7) * 8; const unsigned vw[4] = {vraw.x, vraw.y, vraw.z, vraw.w};
#pragma unroll
      for (int i = 0; i < 4; ++i) { Vt[(e0 + 2 * i) * 72 + t] = (bf16_t)(vw[i] & 0xffffu); Vt[(e0 + 2 * i + 1) * 72 + t] = (bf16_t)(vw[i] >> 16); } }
    if (tid < 32) ((float*)(c.ws + WS_DEC))[(size_t)(g * 4 + h) * 32 + tid] = fexp(la[63 * 33 + tid]);
    __syncthreads();
    { const int w = c.wave, lane = c.lane, fr = lane & 15, fq = lane >> 4, db = w >> 2, eb = w & 3;
      f32x4 acc = {0.f, 0.f, 0.f, 0.f};
#pragma unroll
      for (int k2 = 0; k2 < 2; ++k2) { const bf16x8 kf = *(const bf16x8*)(KtT + (16 * db + fr) * 72 + 32 * k2 + 8 * fq), vf = *(const bf16x8*)(Vt + (16 * eb + fr) * 72 + 32 * k2 + 8 * fq);
          acc = __builtin_amdgcn_mfma_f32_16x16x32_bf16(kf, vf, acc, 0, 0, 0); }
      float* dst = (float*)(c.ws + WS_DS) + (size_t)(g * 4 + h) * 2048 + (16 * db + 4 * fq) * 64 + 16 * eb + fr;
#pragma unroll
      for (int i = 0; i < 4; ++i) dst[i * 64] = acc[i]; }
    __syncthreads();
}
__device__ __forceinline__ void pool_unit(const Ctx& c, int l, int g) {
    float* ext = (float*)c.ldsg;
    const bf16_t* proj = (const bf16_t*)(c.ws + WS_BIG); bf16_t* Y = (bf16_t*)(c.ws + WS_Y);
    const int m0 = g * 64, tid = c.tid; const bool samp = g >= 512; const int cidx = samp ? 0 : (g & 127);
#pragma unroll
    for (int it = 0; it < 5; ++it) { const int q = tid + 512 * it;
        if (q < 79 * 32) { const int j = q >> 5, c8 = (q & 31) * 8; float* d = ext + j * 256 + c8;
            if (j >= 15 || cidx > 0) { const u32x4 w = *(const u32x4*)(proj + (size_t)(m0 + j - 15) * PW + C_UC + c8);
                *(f32x4*)d = (f32x4){bflo(w.x), bfhi(w.x), bflo(w.y), bfhi(w.y)}; *(f32x4*)(d + 4) = (f32x4){bflo(w.z), bfhi(w.z), bflo(w.w), bfhi(w.w)}; }
            else if (samp) { const float* sp = c.in[5] + ((size_t)(l * 32 + (g - 512)) * 15 + j) * 256 + c8; *(f32x4*)d = *(const f32x4*)sp; *(f32x4*)(d + 4) = *(const f32x4*)(sp + 4); }
            else { *(f32x4*)d = (f32x4){0.f, 0.f, 0.f, 0.f}; *(f32x4*)(d + 4) = (f32x4){0.f, 0.f, 0.f, 0.f}; } } }
    __syncthreads();
    { const int cc = tid & 255, ts = tid >> 8, gi = cc >> 6, w = 2 << gi;
      float s = 0.f;
      for (int j = 1; j < w; ++j) s += ext[(15 + ts * 32 - j) * 256 + cc];
      for (int i = 0; i < 32; ++i) { const int t = ts * 32 + i; s += ext[(15 + t) * 256 + cc];
          const int pos = samp ? 2048 + t : cidx * 64 + t; const float cnt = (float)min(w, pos + 1);
          const float dv = s / cnt - ext[(15 + t) * 256 + cc];
          Y[(size_t)(m0 + t) * D + 768 + cc] = (bf16_t)f2bf(dv); s -= ext[(15 + t - w + 1) * 256 + cc]; } }
    __syncthreads();
}

__device__ __forceinline__ void scan_unit(const Ctx& c, int l, int su) {
    const float* dS = (const float*)(c.ws + WS_DS); const float* dec = (const float*)(c.ws + WS_DEC); float* St = (float*)(c.ws + WS_ST);
    int g0, n, h, idx; float S; float* outp;
    if (su < 64) { const int bh = su >> 2, b = bh >> 2; h = bh & 3; idx = (su & 3) * 512 + c.tid; g0 = b * 128; n = 128; S = 0.f; outp = c.out + O_GP + ((size_t)(l * 4 + b) * 4 + h) * 2048 + idx; }
    else { const int s2 = su - 64, sbh = s2 >> 2, sb = sbh >> 2; h = sbh & 3; idx = (s2 & 3) * 512 + c.tid; g0 = 512 + sb; n = 1; S = c.in[4][((size_t)(l * 32 + sb) * 4 + h) * 2048 + idx]; outp = c.out + O_GS + ((size_t)(l * 32 + sb) * 4 + h) * 2048 + idx; }
    const int d = idx >> 6;
#pragma unroll 8
    for (int cc = 0; cc < n; ++cc) { const size_t gh = (size_t)(g0 + cc) * 4 + h; const float dd = dS[gh * 2048 + idx], de = dec[gh * 32 + d]; St[gh * 2048 + idx] = S; S = de * (S + dd); }
    *outp = S;
}
__device__ __forceinline__ void attn_unit(const Ctx& c, int l, int au) {
    bf16_t* Ks = (bf16_t*)c.ldsg; bf16_t* Vt = (bf16_t*)(c.ldsg + 18432); int* flags = (int*)(c.ldsg + 35840);
    const bf16_t* proj = (const bf16_t*)(c.ws + WS_BIG); bf16_t* Y = (bf16_t*)(c.ws + WS_Y);
    int R0, n_past, qb, hp, sb = 0;
    if (au < 2048) { const int b = au >> 9, rem = au & 511; qb = rem >> 2; hp = rem & 3; R0 = b * 8192; n_past = 0; }
    else { const int a2 = au - 2048; sb = a2 >> 2; hp = a2 & 3; qb = 0; R0 = MP + sb * 64; n_past = 2048; }
    const int tid = c.tid, w = c.wave, lane = c.lane, fr = lane & 15, fq = lane >> 4, hsel = w >> 2, hh = 2 * hp + hsel, qsub = w & 3;
    const int qrow = R0 + qb * 64 + qsub * 16 + fr, qpos = n_past + qb * 64 + qsub * 16 + fr;
    bf16x8 qf[2];
#pragma unroll
    for (int ks = 0; ks < 2; ++ks) qf[ks] = *(const bf16x8*)(proj + (size_t)qrow * PW + C_QA + hh * 64 + 32 * ks + 8 * fq);
    f32x4 O[4];
#pragma unroll
    for (int i = 0; i < 4; ++i) O[i] = (f32x4){0.f, 0.f, 0.f, 0.f};
    float carry = 0.f; bool wdone = false;
    int kt = (n_past + qb * 64) >> 6;
    const int lh = tid >> 8, lj = (tid >> 2) & 63, d0 = (tid & 3) * 16, lhead = 2 * hp + lh;
    for (;;) {
        {
            const int kpos = kt * 64 + lj; unsigned kk[8], vv[8];
            if (kpos < n_past) {
                const size_t o = (((size_t)(l * 32 + sb) * 2048 + kpos) * 512) + lhead * 64 + d0; const float* kp = c.in[2] + o; const float* vp = c.in[3] + o;
#pragma unroll
                for (int i = 0; i < 4; ++i) { const f32x4 a = *(const f32x4*)(kp + 4 * i), b = *(const f32x4*)(vp + 4 * i); kk[2 * i] = pk2(a[0], a[1]); kk[2 * i + 1] = pk2(a[2], a[3]); vv[2 * i] = pk2(b[0], b[1]); vv[2 * i + 1] = pk2(b[2], b[3]); }
            } else {
                const bf16_t* rp = proj + (size_t)(R0 + kpos - n_past) * PW + lhead * 64 + d0;
                const u32x4 a0 = *(const u32x4*)(rp + C_KA), a1 = *(const u32x4*)(rp + C_KA + 8), b0 = *(const u32x4*)(rp + C_VA), b1 = *(const u32x4*)(rp + C_VA + 8);
                kk[0] = a0.x; kk[1] = a0.y; kk[2] = a0.z; kk[3] = a0.w; kk[4] = a1.x; kk[5] = a1.y; kk[6] = a1.z; kk[7] = a1.w;
                vv[0] = b0.x; vv[1] = b0.y; vv[2] = b0.z; vv[3] = b0.w; vv[4] = b1.x; vv[5] = b1.y; vv[6] = b1.z; vv[7] = b1.w;
            }
            bf16_t* kd = Ks + (lh * 64 + lj) * 72 + d0;
            *(u32x4*)kd = (u32x4){kk[0], kk[1], kk[2], kk[3]}; *(u32x4*)(kd + 8) = (u32x4){kk[4], kk[5], kk[6], kk[7]};
#pragma unroll
            for (int i = 0; i < 8; ++i) { Vt[(lh * 64 + d0 + 2 * i) * 68 + lj] = (bf16_t)(vv[i] & 0xffffu); Vt[(lh * 64 + d0 + 2 * i + 1) * 68 + lj] = (bf16_t)(vv[i] >> 16); }
        }
        __syncthreads();
        {
            f32x4 sa[4];
#pragma unroll
            for (int u = 0; u < 4; ++u) { sa[u] = (f32x4){0.f, 0.f, 0.f, 0.f};
#pragma unroll
                for (int ks = 0; ks < 2; ++ks) { const bf16x8 kf = *(const bf16x8*)(Ks + (hsel * 64 + 16 * u + fr) * 72 + 32 * ks + 8 * fq); sa[u] = __builtin_amdgcn_mfma_f32_16x16x32_bf16(kf, qf[ks], sa[u], 0, 0, 0); } }
            float lk[4][4], lw[4][4], ls[4], suf[4], T[4];
#pragma unroll
            for (int u = 0; u < 4; ++u) { ls[u] = 0.f;
#pragma unroll
                for (int i = 0; i < 4; ++i) { const float z = sa[u][i] * 0.125f; const int kpos = kt * 64 + 16 * u + 4 * fq + i; const bool valid = kpos < qpos;
                    const float sp = softplus(z); lk[u][i] = valid ? -sp : 0.f; lw[u][i] = valid ? (z - sp) : -1e30f; ls[u] += lk[u][i]; } }
#pragma unroll
            for (int u = 0; u < 4; ++u) { const float a = __shfl_xor(ls[u], 16), t1 = ls[u] + a, o = __shfl_xor(t1, 32); T[u] = t1 + o; suf[u] = ((fq & 1) ? 0.f : a) + ((fq & 2) ? 0.f : o); }
            float base = carry; float wv[4][4];
#pragma unroll
            for (int u = 3; u >= 0; --u) { float run = base + suf[u];
#pragma unroll
                for (int i = 3; i >= 0; --i) { wv[u][i] = fexp(lw[u][i] + run); run += lk[u][i]; }
                base += T[u]; }
            carry = base;
#pragma unroll
            for (int k2 = 0; k2 < 2; ++k2) {
                u32x4 pw; pw.x = pk2(wv[2 * k2][0], wv[2 * k2][1]); pw.y = pk2(wv[2 * k2][2], wv[2 * k2][3]); pw.z = pk2(wv[2 * k2 + 1][0], wv[2 * k2 + 1][1]); pw.w = pk2(wv[2 * k2 + 1][2], wv[2 * k2 + 1][3]);
                const bf16x8 pf = __builtin_bit_cast(bf16x8, pw);
#pragma unroll
                for (int db = 0; db < 4; ++db) { const bf16_t* vp = Vt + (hsel * 64 + 16 * db + fr) * 68 + 32 * k2 + 4 * fq; const u32x2 lo = *(const u32x2*)vp, hi = *(const u32x2*)(vp + 16);
                    const bf16x8 vf = __builtin_bit_cast(bf16x8, (u32x4){lo.x, lo.y, hi.x, hi.y}); O[db] = __builtin_amdgcn_mfma_f32_16x16x32_bf16(vf, pf, O[db], 0, 0, 0); }
            }
            wdone = __all(carry < -46.f) != 0;
        }
        --kt;
        if (lane == 0) flags[w] = wdone ? 1 : 0;
        __syncthreads();
        int alld = 1;
#pragma unroll
        for (int i = 0; i < 8; ++i) alld &= flags[i];
        if (alld || kt < 0) break;
    }
#pragma unroll
    for (int db = 0; db < 4; ++db) { u32x2 o; o.x = pk2(O[db][0], O[db][1]); o.y = pk2(O[db][2], O[db][3]); *(u32x2*)(Y + (size_t)qrow * D + hh * 64 + 16 * db + 4 * fq) = o; }
    __syncthreads();
}

__device__ __forceinline__ void gla_out_unit(const Ctx& c, int l, int g, int h) {
    bf16_t* Qs = (bf16_t*)c.ldsg; bf16_t* Ks = Qs + 2560; bf16_t* Vt = Ks + 2560; bf16_t* ST = Vt + 4608; float* red = (float*)(ST + 2560);
    const bf16_t* proj = (const bf16_t*)(c.ws + WS_BIG); bf16_t* Y = (bf16_t*)(c.ws + WS_Y); const float* bws = (const float*)(c.ws + WS_B);
    const int m0 = g * 64, tid = c.tid, w = c.wave, lane = c.lane, fr = lane & 15, fq = lane >> 4;
    {
        const int t = tid >> 3, d0 = (tid & 7) * 4, e0 = (tid & 7) * 8;
        const f32x4 b4 = *(const f32x4*)(bws + (size_t)(m0 + t) * 128 + h * 32 + d0);
        const u32x2 q2 = *(const u32x2*)(proj + (size_t)(m0 + t) * PW + C_QB + h * 32 + d0), k2 = *(const u32x2*)(proj + (size_t)(m0 + t) * PW + C_KB + h * 32 + d0);
        const u32x4 v4 = *(const u32x4*)(proj + (size_t)(m0 + t) * PW + C_VB + h * 64 + e0);
        const int sd = tid >> 4, se0 = (tid & 15) * 4;
        const f32x4 s4 = *(const f32x4*)((const float*)(c.ws + WS_ST) + (size_t)(g * 4 + h) * 2048 + sd * 64 + se0);
        const float qv[4] = {bflo(q2.x), bfhi(q2.x), bflo(q2.y), bfhi(q2.y)}, kv[4] = {bflo(k2.x), bfhi(k2.x), bflo(k2.y), bfhi(k2.y)};
        float qo[4], ko[4];
#pragma unroll
        for (int i = 0; i < 4; ++i) { qo[i] = qv[i] * 0.17677669529663687f * fexp(b4[i]); ko[i] = kv[i] * fexp(-b4[i]); }
        *(u32x2*)(Qs + t * 40 + d0) = (u32x2){pk2(qo[0], qo[1]), pk2(qo[2], qo[3])};
        *(u32x2*)(Ks + t * 40 + d0) = (u32x2){pk2(ko[0], ko[1]), pk2(ko[2], ko[3])};
        const unsigned vw[4] = {v4.x, v4.y, v4.z, v4.w};
#pragma unroll
        for (int i = 0; i < 4; ++i) { Vt[(e0 + 2 * i) * 72 + t] = (bf16_t)(vw[i] & 0xffffu); Vt[(e0 + 2 * i + 1) * 72 + t] = (bf16_t)(vw[i] >> 16); }
#pragma unroll
        for (int i = 0; i < 4; ++i) ST[(se0 + i) * 40 + sd] = (bf16_t)f2bf(s4[i]);
    }
    __syncthreads();
    const int tb = w & 3, ebase = (w >> 2) * 2, tl = 16 * tb + fr;
    const bf16x8 qf = *(const bf16x8*)(Qs + tl * 40 + 8 * fq);
    f32x4 sa[4];
#pragma unroll
    for (int u = 0; u < 4; ++u) { sa[u] = (f32x4){0.f, 0.f, 0.f, 0.f};
        if (u <= tb) { const bf16x8 kf = *(const bf16x8*)(Ks + (16 * u + fr) * 40 + 8 * fq); sa[u] = __builtin_amdgcn_mfma_f32_16x16x32_bf16(kf, qf, sa[u], 0, 0, 0);
            if (u == tb) {
#pragma unroll
                for (int i = 0; i < 4; ++i) sa[u][i] = (4 * fq + i <= fr) ? sa[u][i] : 0.f; } } }
    f32x4 O[2];
#pragma unroll
    for (int eb = 0; eb < 2; ++eb) {
        const int erow = 16 * (ebase + eb) + fr;
        const bf16x8 stf = *(const bf16x8*)(ST + erow * 40 + 8 * fq);
        O[eb] = __builtin_amdgcn_mfma_f32_16x16x32_bf16(stf, qf, (f32x4){0.f, 0.f, 0.f, 0.f}, 0, 0, 0);
#pragma unroll
        for (int k2 = 0; k2 < 2; ++k2) {
            if (2 * k2 <= tb) {
                u32x4 pw; pw.x = pk2(sa[2 * k2][0], sa[2 * k2][1]); pw.y = pk2(sa[2 * k2][2], sa[2 * k2][3]); pw.z = pk2(sa[2 * k2 + 1][0], sa[2 * k2 + 1][1]); pw.w = pk2(sa[2 * k2 + 1][2], sa[2 * k2 + 1][3]);
                const bf16_t* vp = Vt + erow * 72 + 32 * k2 + 4 * fq; const u32x2 lo = *(const u32x2*)vp, hi = *(const u32x2*)(vp + 16);
                O[eb] = __builtin_amdgcn_mfma_f32_16x16x32_bf16(__builtin_bit_cast(bf16x8, (u32x4){lo.x, lo.y, hi.x, hi.y}), __builtin_bit_cast(bf16x8, pw), O[eb], 0, 0, 0);
            }
        }
    }
    float q2s = 0.f;
#pragma unroll
    for (int eb = 0; eb < 2; ++eb)
#pragma unroll
        for (int i = 0; i < 4; ++i) q2s += O[eb][i] * O[eb][i];
    q2s += __shfl_xor(q2s, 16); q2s += __shfl_xor(q2s, 32);
    if (fq == 0) red[w * 16 + fr] = q2s;
    __syncthreads();
    const float r = __builtin_amdgcn_rsqf((red[w * 16 + fr] + red[(w ^ 4) * 16 + fr]) * (1.0f / 64.0f) + EPS);
#pragma unroll
    for (int eb = 0; eb < 2; ++eb) {
        const int ecol = h * 64 + 16 * (ebase + eb) + 4 * fq;
        const u32x2 ow = *(const u32x2*)(proj + (size_t)(m0 + tl) * PW + C_OB + ecol); const f32x4 gn = *(const f32x4*)(c.in[15] + l * 256 + ecol);
        const float ob[4] = {bflo(ow.x), bfhi(ow.x), bflo(ow.y), bfhi(ow.y)}; float y[4];
#pragma unroll
        for (int i = 0; i < 4; ++i) y[i] = O[eb][i] * r * gn[i] * (ob[i] * sigm(ob[i]));
        *(u32x2*)(Y + (size_t)(m0 + tl) * D + 512 + ecol) = (u32x2){pk2(y[0], y[1]), pk2(y[2], y[3])};
    }
    __syncthreads();
}

__device__ __forceinline__ void grid_bar(unsigned* ctl, unsigned r) {
    asm volatile("s_waitcnt vmcnt(0)" ::: "memory");
    __syncthreads();
    if (threadIdx.x == 0) {
        const unsigned g = blockIdx.x & 7u, G = gridDim.x, nloc = (G - g + 7u) >> 3, ngrp = G < 8u ? G : 8u;
        unsigned* cnt = ctl + 64 * (16 + g); unsigned* gen = ctl + 64 * (24 + g); unsigned* top = ctl + 64 * 32;
        __builtin_amdgcn_fence(__ATOMIC_RELEASE, "agent");
        asm volatile("s_waitcnt vmcnt(0)" ::: "memory");
        const unsigned old = __hip_atomic_fetch_add(cnt, 1u, __ATOMIC_RELAXED, __HIP_MEMORY_SCOPE_AGENT);
        if (old + 1u == r * nloc) {
            __hip_atomic_fetch_add(top, 1u, __ATOMIC_RELAXED, __HIP_MEMORY_SCOPE_AGENT);
            while (__hip_atomic_load(top, __ATOMIC_RELAXED, __HIP_MEMORY_SCOPE_AGENT) < r * ngrp) __builtin_amdgcn_s_sleep(1);
            __hip_atomic_store(gen, r, __ATOMIC_RELAXED, __HIP_MEMORY_SCOPE_AGENT);
        } else {
            while (__hip_atomic_load(gen, __ATOMIC_RELAXED, __HIP_MEMORY_SCOPE_AGENT) < r) __builtin_amdgcn_s_sleep(1);
        }
        __builtin_amdgcn_fence(__ATOMIC_ACQUIRE, "agent");
        asm volatile("s_waitcnt vmcnt(0)" ::: "memory");
    }
    __syncthreads();
}

__global__ void __launch_bounds__(512, 2) fwd_mega(Args args) {
    extern __shared__ __attribute__((aligned(16))) unsigned char lds[];
    cg::grid_group grid = cg::this_grid();
    Ctx c; c.in = args.in; c.out = args.out; c.ws = args.ws; c.lds = (LAS unsigned char*)lds; c.ldsg = lds;
    c.tid = threadIdx.x; c.lane = c.tid & 63; c.wave = __builtin_amdgcn_readfirstlane(c.tid >> 6); c.G = gridDim.x; c.bx = blockIdx.x;
    for (int ph = args.ph_lo; ph < args.ph_hi; ++ph) {
        { int t_ = threadIdx.x; asm volatile("" : "+v"(t_)); c.tid = t_; c.lane = t_ & 63; c.wave = __builtin_amdgcn_readfirstlane(t_ >> 6); }
        unsigned char* ws = args.ws; float* outp = args.out; asm volatile("" : "+s"(ws), "+s"(outp)); c.ws = ws; c.out = outp;
        bf16_t* xb = (bf16_t*)(ws + WS_XB); bf16_t* big = (bf16_t*)(ws + WS_BIG); bf16_t* Yb = (bf16_t*)(ws + WS_Y); bf16_t* mg = (bf16_t*)(ws + WS_MG);
        float* scr = (float*)(ws + WS_SCR); float* ss0 = (float*)(ws + WS_SS); float* ss1 = ss0 + (size_t)M * 32; float* xw = outp + O_Y;
        if (ph == 0) prologue(c);
        else if (ph == 25) {
            const float* gf = args.in[28];
            for (int row = c.bx * 8 + c.wave; row < M; row += c.G * 8) { const float rs = rstd_of(ss0, row);
#pragma unroll
                for (int j = 0; j < 4; ++j) { const u32x2 h2 = *(const u32x2*)(mg + (size_t)row * D + c.lane * 4 + 256 * j); const f32x4 v = {bflo(h2.x), bfhi(h2.x), bflo(h2.y), bfhi(h2.y)}, gg = *(const f32x4*)(gf + c.lane * 4 + 256 * j);
                    *(f32x4*)(xw + (size_t)row * D + c.lane * 4 + 256 * j) = v * rs * gg; } }
        } else {
            const int l = (ph - 1) / 12, k = (ph - 1) % 12;
            if ((MK_SKIPMASK >> k) & 1) continue;
            const bf16_t* Wl = (const bf16_t*)(ws + WS_W) + (size_t)l * WL_END;
            if (k == 0 || k == 8) {
                pg8::Gemm g{(k == 0 && l > 0) ? mg : xb, Wl + (k == 0 ? WL_1IN : WL_2IN), D, D}; pg8::Sched S;     S.init(M, 2 * FF, c.G, c.bx, 16);
                EpiSwiglu E{big}; pg8::gemm_phase(c.lds, c.tid, g, S, E, ss0);
            } else if (k == 1 || k == 9 || k == 7 || k == 11) {
                pg8::Gemm g; pg8::Sched S; EpiRes E{xb, xb, nullptr, (const bf16_t*)scr, 1.f, 0, nullptr, nullptr}; const float* ssin = nullptr;
                if (k == 1 || k == 9) { g = pg8::Gemm{big, Wl + (k == 1 ? WL_1OUT : WL_2OUT), FF, FF}; S.init(M, D, c.G, c.bx, 44); S.quart = 1; E.alpha = 0.5f; E.ss_out = ss1; if (k == 1) { if (l == 0) { E.xin0 = args.in[0]; E.xin1 = args.in[1]; } else E.xsrc = mg; } }
                else if (k == 7) { g = pg8::Gemm{mg, Wl + WL_OUT, D, D}; S.init(M, D, c.G, c.bx, 16); S.quart = 1; E.ss_out = ss0; }
                else { g = pg8::Gemm{xb, Wl + WL_PG, D, D}; S.init(M, D, c.G, c.bx, 16); S.quart = 1; E.ss_out = ss0; ssin = ss1; E.mode = 1; E.xb = mg; }
                pg8::gemm_phase(c.lds, c.tid, g, S, E, ssin);
            } else if (k == 2) {
                pg8::Gemm g{xb, Wl + WL_IN, D, D}; pg8::Sched S; S.init(M, NIN, c.G, c.bx, 16); S.quart = 1;
                EpiWin E{big, outp, l}; pg8::gemm_phase(c.lds, c.tid, g, S, E, ss1);
            } else if (k == 3) {
                for (int it = next_item(c, l * 3 + 0); it < 2176 + NCH; it = next_item(c, l * 3 + 0)) { if (it < NCH) pool_unit(c, l, it); else gla_local_unit(c, l, (it - NCH) >> 2, (it - NCH) & 3); }
            } else if (k == 4) {
                for (int it = next_item(c, l * 3 + 1); it < 576 + 2176; it = next_item(c, l * 3 + 1)) { if (it < 576) scan_unit(c, l, it); else attn_unit(c, l, it - 576); }
            } else if (k == 5) {
                for (int it = next_item(c, l * 3 + 2); it < 2176; it = next_item(c, l * 3 + 2)) gla_out_unit(c, l, it >> 2, it & 3);
            } else {
                pg8::Gemm g; pg8::Sched S; EpiBranch E{big, (bf16_t*)scr, mg, 0};
                if (k == 6) { g = pg8::Gemm{Yb, Wl + WL_BR, D, D}; S.init(M, D, c.G, c.bx, 8); S.nsub = 3; S.quart = 1; }
                else { g = pg8::Gemm{(const bf16_t*)(ws + WS_PB) + (size_t)l * M * 256, Wl + WL_PP, 256, 256}; S.init(M, D, c.G, c.bx, 4); S.quart = 1; E.mode = 1; }
                pg8::gemm_phase(c.lds, c.tid, g, S, E, nullptr);
            }
        }
        if (ph + 1 < args.ph_hi) { if (args.ph_hi > 4096) grid.sync(); grid_bar((unsigned*)(args.ws + WS_CTL), (unsigned)(ph - args.ph_lo + 1)); }
    }
}

extern "C" void kernel_launch(void* const* d_in, const int* in_sizes, int n_in, void* d_out, int out_size, void* d_ws, size_t ws_size, hipStream_t stream) {
    static int grid = 0;
    if (grid == 0) {
        if (n_in != 29 || ws_size < WS_NEED) { fprintf(stderr, "kernel_launch: unexpected n_in %d / ws %zu\n", n_in, ws_size); grid = -1; return; }
        int dev = 0, cus = 0, per_cu = 0;
        (void)hipGetDevice(&dev); (void)hipDeviceGetAttribute(&cus, hipDeviceAttributeMultiprocessorCount, dev);
        (void)hipFuncSetAttribute((const void*)fwd_mega, hipFuncAttributeMaxDynamicSharedMemorySize, LDS_BYTES);
        (void)hipOccupancyMaxActiveBlocksPerMultiprocessor(&per_cu, (const void*)fwd_mega, 512, LDS_BYTES);
        (void)hipGetLastError();
        if (per_cu < 1) per_cu = 1;
        grid = cus;
    }
    if (grid < 0) return;
    (void)hipMemsetAsync((char*)d_ws + WS_CTL, 0, 16384, stream);
    Args a{};
    for (int i = 0; i < 29; ++i) a.in[i] = (const float*)d_in[i];
    a.out = (float*)d_out; a.ws = (unsigned char*)d_ws;
#if MK_ONE_LAUNCH
    a.ph_lo = 0; a.ph_hi = NPH;
    void* kargs[] = {&a};
    hipError_t e = hipLaunchCooperativeKernel((const void*)fwd_mega, dim3(grid), dim3(512), kargs, LDS_BYTES, stream);
    if (e != hipSuccess) fprintf(stderr, "cooperative launch failed: %s (grid %d)\n", hipGetErrorString(e), grid);
#else
    for (int ph = 0; ph < NPH; ++ph) { a.ph_lo = ph; a.ph_hi = ph + 1; hipLaunchKernelGGL(fwd_mega, dim3(grid), dim3(512), LDS_BYTES, stream, a); }
#endif
}
```

```cpp
#include <hip/hip_runtime.h>
#include <hip/hip_cooperative_groups.h>
#include <cstdio>
#include <cstdint>
namespace cg = cooperative_groups;

#ifndef MK_SKIPMASK
#define MK_SKIPMASK 0
#endif
#ifndef MK_NOATTN
#define MK_NOATTN 0
#endif
#ifndef MK_NOGLAOUT
#define MK_NOGLAOUT 0
#endif
#ifndef MK_ONE_LAUNCH
#define MK_ONE_LAUNCH 1
#endif

#define LAS __attribute__((address_space(3)))
typedef unsigned short bf16_t;
typedef short bf16x8 __attribute__((ext_vector_type(8)));
typedef float f32x4 __attribute__((ext_vector_type(4)));
typedef unsigned u32x4 __attribute__((ext_vector_type(4)));
typedef unsigned u32x2 __attribute__((ext_vector_type(2)));

constexpr int M = 34816;
constexpr int MP = 32768;
constexpr int D = 1024, FF = 2816, NIN = 5888, PW = 5888  , INW = 5648;
constexpr int NCH = 544;
constexpr float EPS = 1e-6f;
constexpr size_t O_Y = 0, O_KP = 35651584, O_VP = 69206016, O_GP = 102760448, O_PP = 102825984, O_KS = 102856704, O_VS = 104953856, O_GS = 107051008, O_PS = 107575296;
constexpr int C_QA = 0, C_KA = 512, C_VA = 1024, C_QB = 1536, C_KB = 1664, C_VB = 1792, C_OB = 2048, C_UC = 2304, C_G = 2560, C_RB = 5632;

constexpr size_t WL_1IN = 0, WL_1OUT = WL_1IN + (size_t)5632 * 1024, WL_IN = WL_1OUT + (size_t)1024 * 2816, WL_BR = WL_IN + (size_t)5888 * 1024, WL_OUT = WL_BR + 1048576,
                 WL_2IN = WL_OUT + 1048576, WL_2OUT = WL_2IN + (size_t)5632 * 1024, WL_PG = WL_2OUT + (size_t)1024 * 2816, WL_PP = WL_PG + 1048576, WL_END = WL_PP + 262144;
constexpr size_t MiB = 1u << 20;
constexpr size_t WS_W = 0;
constexpr size_t WS_XB = 104 * MiB;
constexpr size_t WS_PB = 172 * MiB;
constexpr size_t WS_BIG = 208 * MiB;
constexpr size_t WS_Y = 600 * MiB;
constexpr size_t WS_MG = 668 * MiB;
constexpr size_t WS_SCR = 736 * MiB;
constexpr size_t WS_SS = 934 * MiB;
constexpr size_t WS_DS = 878 * MiB;
constexpr size_t WS_ST = 896 * MiB;
constexpr size_t WS_B = 914 * MiB;
constexpr size_t WS_DEC = 932 * MiB;
constexpr size_t WS_CTL = 933 * MiB;
constexpr size_t WS_NEED = 944 * MiB;
static_assert(2 * WL_END * 2 <= 104 * MiB, "weights fit");

__device__ __forceinline__ unsigned f2bf(float f) { unsigned u = __builtin_bit_cast(unsigned, f); return (u + 0x7fffu + ((u >> 16) & 1u)) >> 16; }
__device__ __forceinline__ unsigned pk2(float lo, float hi) { unsigned r; asm("v_cvt_pk_bf16_f32 %0, %1, %2" : "=v"(r) : "v"(lo), "v"(hi)); return r; }
__device__ __forceinline__ float bflo(unsigned u) { return __uint_as_float(u << 16); }
__device__ __forceinline__ float bfhi(unsigned u) { return __uint_as_float(u & 0xffff0000u); }
__device__ __forceinline__ float bf2f(bf16_t b) { return __uint_as_float((unsigned)b << 16); }
__device__ __forceinline__ float fexp(float x) { return __builtin_amdgcn_exp2f(x * 1.4426950408889634f); }
__device__ __forceinline__ float flog(float x) { return __builtin_amdgcn_logf(x) * 0.6931471805599453f; }
__device__ __forceinline__ float sigm(float x) { return __builtin_amdgcn_rcpf(1.0f + fexp(-x)); }
__device__ __forceinline__ float softplus(float z) { return fmaxf(z, 0.f) + flog(1.0f + fexp(-fabsf(z))); }
__device__ __forceinline__ float rstd_of(const float* ss, int row) {
    const f32x4* p = (const f32x4*)(ss + (size_t)row * 32);
    float s = 0.f;
#pragma unroll
    for (int i = 0; i < 8; ++i) { const f32x4 a = p[i]; s += (a[0] + a[1]) + (a[2] + a[3]); }
    return __builtin_amdgcn_rsqf(s * (1.0f / 1024.0f) + EPS);
}

namespace pg8 {
constexpr int BM = 256, BK = 64, HALF = 128, HTB = HALF * BK * 2, STAGE_BYTES = 8 * HTB, NXCD = 8, WGM = 8;
__host__ __device__ __forceinline__ int lds_byte(int r, int c) { const int st = (r >> 4) * 2 + (c >> 5), rr = r & 15, cc = c & 31, ob = rr * 64 + cc * 2; return st * 1024 + (ob ^ (((ob >> 9) & 1) << 5)); }
__host__ __device__ __forceinline__ void stage_rc(int b, int& R, int& C) { const int st = b / 1024, sb = b % 1024, swz = sb ^ (((sb >> 9) & 1) << 5); R = (st >> 1) * 16 + swz / 64; C = (st & 1) * 32 + (swz % 64) / 2; }
__host__ __device__ __forceinline__ int perm32(int rho) { const int n = rho >> 4, i = rho & 15; return 8 * (i >> 2) + 4 * n + (i & 3); }

struct Unit { int pm, pn, kind, k0, nt, qm; };
struct Gemm { const bf16_t* A; const bf16_t* Bt; int lda, ldb; };

struct Sched {
    int nM, nN, nwg, G, c, nsub, nt0, quart;
    __device__ __forceinline__ void init(int M_, int N_, int G_, int c_, int nt) { nM = M_ / BM; nN = N_ / BM; nwg = nM * nN; G = G_; c = c_; nsub = 1; nt0 = nt; quart = 0; }
    __device__ __forceinline__ bool next(int i, Unit& u) const {
        const int ti = i / nsub, sk = i - ti * nsub;
        long L = (long)ti * G + c; int qm = 0xF;
        const int nfull = nwg / G;
        if (quart && ti >= nfull) {
            const long li = (long)(ti - nfull) * G + c; if (li >= 4L * (nwg - nfull * G)) return false;
            L = (long)nfull * G + (li >> 2); qm = 1 << (int)(li & 3);
        } else if (L >= nwg) return false;
        u.qm = qm;
        int wgid = (int)L; { const int q = nwg / NXCD, r = nwg % NXCD, xcd = wgid % NXCD, off = wgid / NXCD; wgid = (xcd < r ? xcd * (q + 1) : r * (q + 1) + (xcd - r) * q) + off; }
        const int nig = WGM * nN, gid = wgid / nig, fm = gid * WGM, gsz = (nM - fm) < WGM ? (nM - fm) : WGM;
        u.pm = fm + ((wgid % nig) % gsz); u.pn = (wgid % nig) / gsz; u.kind = sk; u.k0 = (sk > 0) ? 256 + 256 * sk : 0; u.nt = (sk > 0) ? 4 : nt0; return true;
    }
};

#define PG8_KLOOP(C0, C1, C2, C3) \
        for (int t = 0; t < nt; t += 2) { \
            const bool last = (t == nt - 2); \
            const char* a1 = cA + (size_t)(t + 1) * kstep; \
            const char* a2 = last ? nA : cA + (size_t)(t + 2) * kstep; const char* b2 = last ? nB : cB + (size_t)(t + 2) * kstep; \
            const char* a3 = a2 + kstep; const char* b3 = b2 + kstep; \
            PG8_LDB(B0, 0, 0); PG8_LDB(B1, 0, 1); PG8_SCHED; PG8_LDA(At, 0, 0); PG8_STAGE(PG8_SA(1, 1), a1 + hstepA, voffA); \
            PG8_WAIT_V(8); PG8_WAIT_L(0); PG8_BAR; if (C0) PG8_MMA(0, 0, At, B0); if (C1) PG8_MMA(0, 1, At, B1); PG8_BAR; PG8_SCHED; \
            PG8_LDA(At, 0, 1); PG8_STAGE(PG8_SB(0, 0), b2, voffB); PG8_STAGE(PG8_SB(0, 1), b2 + hstepB, voffB); PG8_STAGE(PG8_SA(0, 0), a2, voffA); \
            PG8_WAIT_V(8); PG8_WAIT_L(0); PG8_BAR; if (C2) PG8_MMA(1, 0, At, B0); if (C3) PG8_MMA(1, 1, At, B1); PG8_BAR; PG8_SCHED; \
            PG8_LDB(B0, 1, 0); PG8_LDB(B1, 1, 1); PG8_SCHED; PG8_LDA(At, 1, 0); PG8_STAGE(PG8_SA(0, 1), a2 + hstepA, voffA); \
            PG8_WAIT_V(8); PG8_WAIT_L(0); PG8_BAR; if (C0) PG8_MMA(0, 0, At, B0); if (C1) PG8_MMA(0, 1, At, B1); PG8_BAR; PG8_SCHED; \
            PG8_LDA(At, 1, 1); PG8_STAGE(PG8_SB(1, 0), b3, voffB); PG8_STAGE(PG8_SB(1, 1), b3 + hstepB, voffB); PG8_STAGE(PG8_SA(1, 0), a3, voffA); \
            PG8_WAIT_V(8); PG8_WAIT_L(0); PG8_BAR; if (C2) PG8_MMA(1, 0, At, B0); if (C3) PG8_MMA(1, 1, At, B1); PG8_BAR; PG8_SCHED; \
        }
template <class Epi, class Sch>
__device__ __forceinline__ void gemm_phase(LAS unsigned char* lds, const int tid, const Gemm g, const Sch& S, const Epi& E, const float* ss) {
    const int wid = __builtin_amdgcn_readfirstlane(tid >> 6), lane = tid & 63, wr = wid >> 2, wc = wid & 3, fr = lane & 15, fq = lane >> 4;
    unsigned voffA[2], voffB[2];
#pragma unroll
    for (int i = 0; i < 2; ++i) { int R, C; stage_rc(tid * 16 + i * 8192, R, C); const int Rb = (R & ~31) + perm32(R & 31);
        voffA[i] = (unsigned)(R * g.lda + C) * 2u; voffB[i] = (unsigned)(Rb * g.ldb + C) * 2u; }
    const size_t kstep = (size_t)(BK * 2);
    const size_t hstepA = (size_t)HALF * g.lda * 2, hstepB = (size_t)HALF * g.ldb * 2;
    const size_t tstepA = 2 * hstepA, tstepB = 2 * hstepB;
    const unsigned ldsw = (unsigned)wid * 1024u;
    const int aoff = lds_byte(wr * 64 + fr, fq * 8), boff = lds_byte(wc * 32 + fr, fq * 8);
    LAS float* rtab = (LAS float*)(lds + STAGE_BYTES);
    f32x4 rt_a = {0.f, 0.f, 0.f, 0.f}, rt_b = rt_a, rt_c = rt_a, rt_d = rt_a;
#define PG8_RTAB_LOAD(pm_) do { if (ss) { const f32x4* p_ = (const f32x4*)(ss + ((size_t)(pm_) * 256 + (tid >> 1)) * 32 + (tid & 1) * 16); rt_a = p_[0]; rt_b = p_[1]; rt_c = p_[2]; rt_d = p_[3]; } } while (0)
#define PG8_RTAB_FIN(buf_) do { if (ss) { float s_ = (((rt_a[0] + rt_a[1]) + (rt_a[2] + rt_a[3])) + ((rt_b[0] + rt_b[1]) + (rt_b[2] + rt_b[3]))) + (((rt_c[0] + rt_c[1]) + (rt_c[2] + rt_c[3])) + ((rt_d[0] + rt_d[1]) + (rt_d[2] + rt_d[3]))); \
        s_ += __shfl_xor(s_, 1); if (!(tid & 1)) rtab[(buf_) * 256 + (tid >> 1)] = __builtin_amdgcn_rsqf(s_ * (1.0f / 1024.0f) + EPS); } } while (0)
#define PG8_SA(b, h) (((b) * 2 + (h)) * HTB)
#define PG8_SB(b, h) ((4 + (b) * 2 + (h)) * HTB)
#define PG8_STAGE(bufoff, gbase, voff) do { _Pragma("unroll") for (int _i = 0; _i < 2; ++_i) \
        __builtin_amdgcn_global_load_lds((const unsigned*)((const char*)(gbase) + (voff)[_i]), (LAS unsigned*)(lds + (bufoff) + ldsw + _i * 8192), 16, 0, 0); } while (0)
#define PG8_LDA(dst, b, h) do { _Pragma("unroll") for (int m = 0; m < 4; ++m) _Pragma("unroll") for (int k = 0; k < 2; ++k) dst[m][k] = *(const LAS bf16x8*)(lds + PG8_SA(b, h) + aoff + m * 2048 + k * 1024); } while (0)
#define PG8_LDB(dst, b, h) do { _Pragma("unroll") for (int n = 0; n < 2; ++n) _Pragma("unroll") for (int k = 0; k < 2; ++k) dst[n][k] = *(const LAS bf16x8*)(lds + PG8_SB(b, h) + boff + n * 2048 + k * 1024); } while (0)
#define PG8_MMA(ai, bj, At, Bt) do { __builtin_amdgcn_s_setprio(1); _Pragma("unroll") for (int m = 0; m < 4; ++m) _Pragma("unroll") for (int n = 0; n < 2; ++n) _Pragma("unroll") for (int k = 0; k < 2; ++k) \
        acc[ai][bj][m][n] = __builtin_amdgcn_mfma_f32_16x16x32_bf16(Bt[n][k], At[m][k], acc[ai][bj][m][n], 0, 0, 0); __builtin_amdgcn_s_setprio(0); } while (0)
#define PG8_WAIT_V(n) asm volatile("s_waitcnt vmcnt(" #n ")" ::: "memory")
#define PG8_WAIT_L(n) asm volatile("s_waitcnt lgkmcnt(" #n ")" ::: "memory")
#define PG8_BAR __builtin_amdgcn_s_barrier()
#define PG8_SCHED __builtin_amdgcn_sched_barrier(0)
    Unit cur, nxt; int ui = 0;
    if (!S.next(0, cur)) return;
    f32x4 acc[2][2][4][2];
#pragma unroll
    for (int a = 0; a < 2; ++a)
#pragma unroll
        for (int b = 0; b < 2; ++b)
#pragma unroll
            for (int m = 0; m < 4; ++m)
#pragma unroll
                for (int n = 0; n < 2; ++n) acc[a][b][m][n] = (f32x4){0.f, 0.f, 0.f, 0.f};
    bf16x8 At[4][2], B0[2][2], B1[2][2];
    const char* cA = (const char*)g.A + (size_t)cur.pm * tstepA + (size_t)cur.k0 * 2; const char* cB = (const char*)g.Bt + (size_t)cur.pn * tstepB + (size_t)cur.k0 * 2;
    PG8_RTAB_LOAD(cur.pm); PG8_RTAB_FIN(0);
    PG8_STAGE(PG8_SB(0, 0), cB, voffB); PG8_STAGE(PG8_SB(0, 1), cB + hstepB, voffB); PG8_STAGE(PG8_SA(0, 0), cA, voffA); PG8_STAGE(PG8_SA(0, 1), cA + hstepA, voffA);
    if (wr == 1) PG8_BAR;
    PG8_WAIT_V(2); PG8_BAR;
    PG8_STAGE(PG8_SB(1, 0), cB + kstep, voffB); PG8_STAGE(PG8_SA(1, 0), cA + kstep, voffA); PG8_STAGE(PG8_SB(1, 1), cB + hstepB + kstep, voffB);
    PG8_WAIT_V(6); PG8_BAR;
    for (;;) {
        const bool has_next = S.next(ui + 1, nxt);
        const char* nA = has_next ? (const char*)g.A + (size_t)nxt.pm * tstepA + (size_t)nxt.k0 * 2 : cA; const char* nB = has_next ? (const char*)g.Bt + (size_t)nxt.pn * tstepB + (size_t)nxt.k0 * 2 : cB;
        const int nt = cur.nt, qm = cur.qm;
        if (qm == 0xF) { PG8_KLOOP(true, true, true, true) } else { PG8_KLOOP((qm & 1), (qm & 2), (qm & 4), (qm & 8)) }
        if (wr == 0) PG8_BAR;
        if (has_next) PG8_RTAB_LOAD(nxt.pm);
        E(acc, cur, wr, wc, fr, fq, rtab + (ui & 1) * 256);
        if (!has_next) break;
#pragma unroll
        for (int a = 0; a < 2; ++a)
#pragma unroll
            for (int b = 0; b < 2; ++b)
#pragma unroll
                for (int m = 0; m < 4; ++m)
#pragma unroll
                    for (int n = 0; n < 2; ++n) acc[a][b][m][n] = (f32x4){0.f, 0.f, 0.f, 0.f};
        cur = nxt; cA = nA; cB = nB; ++ui;
        PG8_RTAB_FIN(ui & 1);
        if (wr == 1) PG8_BAR;
    }
    PG8_WAIT_V(0);
    PG8_BAR;
#undef PG8_SA
#undef PG8_RTAB_LOAD
#undef PG8_RTAB_FIN
#undef PG8_SB
#undef PG8_STAGE
#undef PG8_LDA
#undef PG8_LDB
#undef PG8_MMA
#undef PG8_WAIT_V
#undef PG8_WAIT_L
#undef PG8_BAR
#undef PG8_SCHED
}
}
using pg8::Unit;

#define EPI_FENCE() asm volatile("" ::: "memory")
struct EpiSwiglu {
    bf16_t* hid;
    __device__ __forceinline__ void operator()(const f32x4 (&acc)[2][2][4][2], const Unit& u, int wr, int wc, int fr, int fq, const LAS float* rt) const {
        const int row0 = u.pm * 256 + wr * 64 + fr, col = u.pn * 128 + wc * 32 + 8 * fq;
#pragma unroll
        for (int ai = 0; ai < 2; ++ai)
#pragma unroll
            for (int m = 0; m < 4; ++m) {
                const int rl = ai * 128 + m * 16; const int row = row0 + rl; const float rs = rt[wr * 64 + fr + rl];
                float h[8];
#pragma unroll
                for (int n = 0; n < 2; ++n)
#pragma unroll
                    for (int i = 0; i < 4; ++i) { const float a = acc[ai][0][m][n][i] * rs, b = acc[ai][1][m][n][i] * rs; h[4 * n + i] = a * sigm(a) * b; }
                u32x4 w; w.x = pk2(h[0], h[1]); w.y = pk2(h[2], h[3]); w.z = pk2(h[4], h[5]); w.w = pk2(h[6], h[7]);
                *(u32x4*)(hid + (size_t)row * FF + col) = w;
            }
    }
};
struct EpiWin {
    bf16_t* proj; float* out; int layer;
    __device__ __forceinline__ void operator()(const f32x4 (&acc)[2][2][4][2], const Unit& u, int wr, int wc, int fr, int fq, const LAS float* rt) const {
        const int row0 = u.pm * 256 + wr * 64 + fr, pn = u.pn;
        const bool isgate = (pn >= 10 && pn < 22), iskv = (pn >= 2 && pn < 6), ispool = (pn == 9);
#pragma unroll
        for (int ai = 0; ai < 2; ++ai)
#pragma unroll
            for (int m = 0; m < 4; ++m) {
                const int rl = ai * 128 + m * 16; const int row = row0 + rl; const float rs = rt[wr * 64 + fr + rl];
#pragma unroll
                for (int bj = 0; bj < 2; ++bj) {
                    if (!((u.qm >> (ai * 2 + bj)) & 1)) continue;
                    const int ct = bj * 128 + wc * 32 + 8 * fq;
                    f32x4 v0 = acc[ai][bj][m][0] * rs, v1 = acc[ai][bj][m][1] * rs;
                    if (isgate) {
#pragma unroll
                        for (int i = 0; i < 4; ++i) { v0[i] = sigm(v0[i]); v1[i] = sigm(v1[i]); }
                    }
                    u32x4 w; w.x = pk2(v0[0], v0[1]); w.y = pk2(v0[2], v0[3]); w.z = pk2(v1[0], v1[1]); w.w = pk2(v1[2], v1[3]);
                    *(u32x4*)(proj + (size_t)row * PW + pn * 256 + ct) = w;
                    if (iskv) {
                        const int c512 = (pn & 1) * 256 + ct; const bool isv = pn >= 4;
                        float* dst = row < MP ? out + (isv ? O_VP : O_KP) + ((size_t)layer * MP + row) * 512 + c512
                                              : out + (isv ? O_VS : O_KS) + ((size_t)layer * 2048 + (row - MP)) * 512 + c512;
                        *(f32x4*)dst = v0; *(f32x4*)(dst + 4) = v1;
                    }
                    if (ispool) {
                        if (row < MP) { const int t = row & 8191, b = row >> 13; if (t >= 8177) { float* dst = out + O_PP + ((size_t)(layer * 4 + b) * 15 + (t - 8177)) * 256 + ct; *(f32x4*)dst = v0; *(f32x4*)(dst + 4) = v1; } }
                        else { const int r = row - MP, t = r & 63, sb = r >> 6; if (t >= 49) { float* dst = out + O_PS + ((size_t)(layer * 32 + sb) * 15 + (t - 49)) * 256 + ct; *(f32x4*)dst = v0; *(f32x4*)(dst + 4) = v1; } }
                    }
                }
            }
    }
};
struct EpiRes {
    const bf16_t* xsrc; bf16_t* xb; float* ss_out; const bf16_t* scr; float alpha; int mode; const float* xin0; const float* xin1;
    __device__ __forceinline__ void operator()(const f32x4 (&acc)[2][2][4][2], const Unit& u, int wr, int wc, int fr, int fq, const LAS float* rt) const {
        const int row0 = u.pm * 256 + wr * 64 + fr, colb = u.pn * 256 + wc * 32 + 8 * fq;
        const float* xr = xin0 ? (u.pm < MP / 256 ? xin0 : xin1 - (size_t)MP * D) : nullptr;
        if (mode == 0 && !xr) {
#pragma unroll
            for (int ai = 0; ai < 2; ++ai) {
                if (!((u.qm >> (2 * ai)) & 3)) continue;
                u32x4 xh[4][2];
#pragma unroll
                for (int m = 0; m < 4; ++m)
#pragma unroll
                    for (int bj = 0; bj < 2; ++bj) xh[m][bj] = *(const u32x4*)(xsrc + (size_t)(row0 + ai * 128 + m * 16) * D + colb + bj * 128);
#pragma unroll
                for (int m = 0; m < 4; ++m)
#pragma unroll
                    for (int bj = 0; bj < 2; ++bj) {
                        if (!((u.qm >> (ai * 2 + bj)) & 1)) continue;
                        const int row = row0 + ai * 128 + m * 16; const size_t off = (size_t)row * D + colb + bj * 128;
                        const u32x4 h4 = xh[m][bj];
                        const f32x4 x0 = (f32x4){bflo(h4.x), bfhi(h4.x), bflo(h4.y), bfhi(h4.y)} + acc[ai][bj][m][0] * alpha, x1 = (f32x4){bflo(h4.z), bfhi(h4.z), bflo(h4.w), bfhi(h4.w)} + acc[ai][bj][m][1] * alpha;
                        u32x4 w; w.x = pk2(x0[0], x0[1]); w.y = pk2(x0[2], x0[3]); w.z = pk2(x1[0], x1[1]); w.w = pk2(x1[2], x1[3]);
                        *(u32x4*)(xb + off) = w;
                        float ssum = (x0[0] * x0[0] + x0[1] * x0[1]) + (x0[2] * x0[2] + x0[3] * x0[3]) + (x1[0] * x1[0] + x1[1] * x1[1]) + (x1[2] * x1[2] + x1[3] * x1[3]);
                        ssum += __shfl_xor(ssum, 16); ssum += __shfl_xor(ssum, 32);
                        if (fq == 0) ss_out[(size_t)row * 32 + u.pn * 8 + bj * 4 + wc] = ssum;
                    }
                EPI_FENCE();
            }
            return;
        }
#pragma unroll
        for (int ai = 0; ai < 2; ++ai) {
            if (!((u.qm >> (2 * ai)) & 3)) continue;
#pragma unroll
            for (int mp = 0; mp < 2; ++mp) {
                f32x4 xv[2][2][2]; u32x4 sv[2][2];
#pragma unroll
                for (int mi = 0; mi < 2; ++mi)
#pragma unroll
                    for (int bj = 0; bj < 2; ++bj) {
                        const size_t off = (size_t)(row0 + ai * 128 + (2 * mp + mi) * 16) * D + colb + bj * 128;
                        if (xr) { xv[mi][bj][0] = *(const f32x4*)(xr + off); xv[mi][bj][1] = *(const f32x4*)(xr + off + 4); }
                        else xv[mi][bj][0] = __builtin_bit_cast(f32x4, *(const u32x4*)(xsrc + off));
                        if (mode == 1) sv[mi][bj] = *(const u32x4*)(scr + off);
                    }
#pragma unroll
                for (int mi = 0; mi < 2; ++mi) {
                    const int m = 2 * mp + mi, rl = ai * 128 + m * 16, row = row0 + rl;
                    const float rs = (mode == 1) ? rt[wr * 64 + fr + rl] : 1.f;
#pragma unroll
                    for (int bj = 0; bj < 2; ++bj) {
                        if (!((u.qm >> (ai * 2 + bj)) & 1)) continue;
                        const size_t off = (size_t)row * D + colb + bj * 128;
                        f32x4 v0 = acc[ai][bj][m][0], v1 = acc[ai][bj][m][1];
                        if (mode == 1) {
#pragma unroll
                            for (int i = 0; i < 4; ++i) { v0[i] = sigm(v0[i] * rs); v1[i] = sigm(v1[i] * rs); }
                            { const u32x4 p4 = sv[mi][bj]; v0[0] *= bflo(p4.x); v0[1] *= bfhi(p4.x); v0[2] *= bflo(p4.y); v0[3] *= bfhi(p4.y); v1[0] *= bflo(p4.z); v1[1] *= bfhi(p4.z); v1[2] *= bflo(p4.w); v1[3] *= bfhi(p4.w); }
                        } else { v0 = v0 * alpha; v1 = v1 * alpha; }
                        f32x4 o0, o1;
                        if (xr) { o0 = xv[mi][bj][0]; o1 = xv[mi][bj][1]; }
                        else { const u32x4 h4 = __builtin_bit_cast(u32x4, xv[mi][bj][0]); o0 = (f32x4){bflo(h4.x), bfhi(h4.x), bflo(h4.y), bfhi(h4.y)}; o1 = (f32x4){bflo(h4.z), bfhi(h4.z), bflo(h4.w), bfhi(h4.w)}; }
                        const f32x4 x0 = o0 + v0, x1 = o1 + v1;
                        u32x4 w; w.x = pk2(x0[0], x0[1]); w.y = pk2(x0[2], x0[3]); w.z = pk2(x1[0], x1[1]); w.w = pk2(x1[2], x1[3]);
                        *(u32x4*)(xb + off) = w;
                        float ssum = (x0[0] * x0[0] + x0[1] * x0[1]) + (x0[2] * x0[2] + x0[3] * x0[3]) + (x1[0] * x1[0] + x1[1] * x1[1]) + (x1[2] * x1[2] + x1[3] * x1[3]);
                        ssum += __shfl_xor(ssum, 16); ssum += __shfl_xor(ssum, 32);
                        if (fq == 0) ss_out[(size_t)row * 32 + u.pn * 8 + bj * 4 + wc] = ssum;
                    }
                }
                EPI_FENCE();
            }
        }
    }
};
struct EpiBranch {
    const bf16_t* proj; bf16_t* scr; bf16_t* merged; int mode;
    template <int BR>
    __device__ __forceinline__ void run(const f32x4 (&acc)[2][2][4][2], const Unit& u, int wr, int wc, int fr, int fq) const {
        const int row0 = u.pm * 256 + wr * 64 + fr, colb = u.pn * 256 + wc * 32 + 8 * fq;
#pragma unroll
        for (int ai = 0; ai < 2; ++ai) {
            if (!((u.qm >> (2 * ai)) & 3)) continue;
#pragma unroll
            for (int mp = 0; mp < 1; ++mp) {
                u32x4 gt[4][2], sv[4][2];
#pragma unroll
                for (int mi = 0; mi < 4; ++mi)
#pragma unroll
                    for (int bj = 0; bj < 2; ++bj) {
                        const int row = row0 + ai * 128 + mi * 16, col = colb + bj * 128; const size_t off = (size_t)row * D + col;
                        if (BR < 3) gt[mi][bj] = *(const u32x4*)(proj + (size_t)row * PW + C_G + BR * 1024 + col);
                        if (BR == 1 || BR == 2) sv[mi][bj] = *(const u32x4*)(scr + off);
                    }
#pragma unroll
                for (int mi = 0; mi < 4; ++mi)
#pragma unroll
                    for (int bj = 0; bj < 2; ++bj) {
                        if (!((u.qm >> (ai * 2 + bj)) & 1)) continue;
                        const int m = mi, row = row0 + ai * 128 + m * 16, col = colb + bj * 128; const size_t off = (size_t)row * D + col;
                        f32x4 v0 = acc[ai][bj][m][0], v1 = acc[ai][bj][m][1];
                        if (BR < 3) { const u32x4 g4 = gt[mi][bj];
                            v0[0] *= bflo(g4.x); v0[1] *= bfhi(g4.x); v0[2] *= bflo(g4.y); v0[3] *= bfhi(g4.y);
                            v1[0] *= bflo(g4.z); v1[1] *= bfhi(g4.z); v1[2] *= bflo(g4.w); v1[3] *= bfhi(g4.w); }
                        if (BR == 1 || BR == 2) { const u32x4 p4 = sv[mi][bj]; v0[0] += bflo(p4.x); v0[1] += bfhi(p4.x); v0[2] += bflo(p4.y); v0[3] += bfhi(p4.y); v1[0] += bflo(p4.z); v1[1] += bfhi(p4.z); v1[2] += bflo(p4.w); v1[3] += bfhi(p4.w); }
                        { u32x4 w; w.x = pk2(v0[0], v0[1]); w.y = pk2(v0[2], v0[3]); w.z = pk2(v1[0], v1[1]); w.w = pk2(v1[2], v1[3]); *(u32x4*)((BR == 2 ? merged : scr) + off) = w; }
                    }
                EPI_FENCE();
            }
        }
    }
    __device__ __forceinline__ void operator()(const f32x4 (&acc)[2][2][4][2], const Unit& u, int wr, int wc, int fr, int fq, const LAS float* rt) const {
        if (mode == 1) run<3>(acc, u, wr, wc, fr, fq);
        else if (u.kind == 0) run<0>(acc, u, wr, wc, fr, fq);
        else if (u.kind == 1) run<1>(acc, u, wr, wc, fr, fq);
        else run<2>(acc, u, wr, wc, fr, fq);
    }
};

struct Args { const float* in[29]; float* out; unsigned char* ws; int ph_lo, ph_hi; };
constexpr int NPH = 26;
constexpr int LDS_BYTES = 147456;

struct Ctx {
    const float* const* in; float* out; unsigned char* ws; LAS unsigned char* lds; unsigned char* ldsg; int tid, lane, wave, G, bx;
};

enum { MAP_ID = 0, MAP_SWIGLU = 1, MAP_WIN = 2 };
__device__ __forceinline__ int map_col(int mode, int n) {
    if (mode == MAP_ID) return n;
    if (mode == MAP_SWIGLU) { const int p = n >> 8, j = n & 255; return j < 128 ? p * 128 + j : FF + p * 128 + (j - 128); }
    if (n < 2048) return n;
    if (n < 2304) return 2064 + (n - 2048);
    if (n < 2560) return 2320 + (n - 2304);
    if (n < 5632) return 2576 + (n - 2560);
    if (n < 5648) return 2048 + (n - 5632);
    return -1;
}
__device__ __forceinline__ void tconv(const Ctx& c, const float* src, int ldsrc, int K, bf16_t* dst, int lddst, int Nout, int mode, const float* g, int& toff) {
    float* tile = (float*)c.ldsg;
    const int ntn = Nout / 64, ntk = K / 256, nt = ntn * ntk;
    const int first = (c.bx + c.G - (toff % c.G)) % c.G; toff += nt;
    for (int it = first; it < nt; it += c.G) {
        const int tn = it % ntn, tk = it / ntn, n0 = tn * 64, k0 = tk * 256;
        const int nn = c.tid & 63, sc = map_col(mode, n0 + nn), kq = c.tid >> 6;
        float v[32];
#pragma unroll
        for (int i = 0; i < 32; ++i) { const int kk = kq + 8 * i; v[i] = (sc >= 0) ? src[(size_t)(k0 + kk) * ldsrc + sc] : 0.f; }
        if (g) {
#pragma unroll
            for (int i = 0; i < 32; ++i) v[i] *= g[k0 + kq + 8 * i];
        }
#pragma unroll
        for (int i = 0; i < 32; ++i) tile[(kq + 8 * i) * 65 + nn] = v[i];
        __syncthreads();
        { const int n2 = c.tid >> 3, kg = c.tid & 7;
#pragma unroll
          for (int j = 0; j < 4; ++j) { const float* s = tile + (kg * 8 + 64 * j) * 65 + n2;
              u32x4 o; o.x = pk2(s[0], s[65]); o.y = pk2(s[130], s[195]); o.z = pk2(s[260], s[325]); o.w = pk2(s[390], s[455]);
              *(u32x4*)(dst + (size_t)(n0 + n2) * lddst + k0 + kg * 8 + 64 * j) = o; } }
        __syncthreads();
    }
}
__device__ __forceinline__ float wave_sum(float v) {
#pragma unroll
    for (int o = 1; o < 64; o <<= 1) v += __shfl_xor(v, o);
    return v;
}
__device__ __forceinline__ void prologue(const Ctx& c) {
    bf16_t* W = (bf16_t*)(c.ws + WS_W);
    int toff = 0;
    for (int l = 0; l < 2; ++l) {
        bf16_t* Wl = W + (size_t)l * WL_END;
        tconv(c, c.in[9] + (size_t)l * D * 2 * FF, 2 * FF, D, Wl + WL_1IN, D, 2 * FF, MAP_SWIGLU, c.in[8] + l * D, toff);
        tconv(c, c.in[10] + (size_t)l * FF * D, D, FF, Wl + WL_1OUT, FF, D, MAP_ID, nullptr, toff);
        tconv(c, c.in[12] + (size_t)l * D * INW, INW, D, Wl + WL_IN, D, NIN, MAP_WIN, c.in[11] + l * D, toff);
        tconv(c, c.in[18] + (size_t)l * 512 * D, D, 512, Wl + WL_BR, D, D, MAP_ID, nullptr, toff);
        tconv(c, c.in[19] + (size_t)l * 256 * D, D, 256, Wl + WL_BR + 512, D, D, MAP_ID, nullptr, toff);
        tconv(c, c.in[21] + (size_t)l * D * D, D, D, Wl + WL_OUT, D, D, MAP_ID, nullptr, toff);
        tconv(c, c.in[23] + (size_t)l * D * 2 * FF, 2 * FF, D, Wl + WL_2IN, D, 2 * FF, MAP_SWIGLU, c.in[22] + l * D, toff);
        tconv(c, c.in[24] + (size_t)l * FF * D, D, FF, Wl + WL_2OUT, FF, D, MAP_ID, nullptr, toff);
        tconv(c, c.in[26] + (size_t)l * D * D, D, D, Wl + WL_PG, D, D, MAP_ID, c.in[25] + l * D, toff);
        tconv(c, c.in[27] + (size_t)l * 256 * D, D, 256, Wl + WL_PP, 256, D, MAP_ID, nullptr, toff);
        const float* pw = c.in[16] + (size_t)l * 4 * 64 * 64; const float* psc = c.in[17] + l * 256; const float* wc = c.in[20] + (size_t)l * 256 * D;
        for (int idx = c.bx * 512 + c.tid; idx < 256 * 1024; idx += c.G * 512) {
            const int n = idx & 1023, kc = idx >> 10, gq = kc >> 6, cc = kc & 63; float s = 0.f;
#pragma unroll 8
            for (int dd = 0; dd < 64; ++dd) s += pw[(gq * 64 + cc) * 64 + dd] * psc[gq * 64 + dd] * wc[(size_t)(gq * 64 + dd) * D + n];
            Wl[WL_BR + (size_t)n * D + 768 + kc] = (bf16_t)f2bf(s);
        }
    }
    bf16_t* xb = (bf16_t*)(c.ws + WS_XB); float* ss0 = (float*)(c.ws + WS_SS);
    for (int row2 = (c.bx * 8 + c.wave) * 2; row2 < M; row2 += c.G * 16) {
        f32x4 v[2][4]; float s[2] = {0.f, 0.f};
#pragma unroll
        for (int r = 0; r < 2; ++r) { const int row = row2 + r; const float* src = row < MP ? c.in[0] + (size_t)row * D : c.in[1] + (size_t)(row - MP) * D;
#pragma unroll
            for (int j = 0; j < 4; ++j) v[r][j] = *(const f32x4*)(src + c.lane * 4 + 256 * j); }
#pragma unroll
        for (int r = 0; r < 2; ++r) {
#pragma unroll
            for (int j = 0; j < 4; ++j) s[r] += (v[r][j][0] * v[r][j][0] + v[r][j][1] * v[r][j][1]) + (v[r][j][2] * v[r][j][2] + v[r][j][3] * v[r][j][3]); }
#pragma unroll
        for (int o = 1; o < 64; o <<= 1) { s[0] += __shfl_xor(s[0], o); s[1] += __shfl_xor(s[1], o); }
#pragma unroll
        for (int r = 0; r < 2; ++r) { const int row = row2 + r;
#pragma unroll
            for (int j = 0; j < 4; ++j) { u32x2 w; w.x = pk2(v[r][j][0], v[r][j][1]); w.y = pk2(v[r][j][2], v[r][j][3]); *(u32x2*)(xb + (size_t)row * D + c.lane * 4 + 256 * j) = w; }
            if (c.lane < 32) ss0[(size_t)row * 32 + c.lane] = c.lane == 0 ? s[r] : 0.f; }
    }
    bf16_t* pb = (bf16_t*)(c.ws + WS_PB);
#pragma unroll 4
    for (size_t i4 = (size_t)c.bx * 512 + c.tid; i4 < (size_t)2 * M * 64; i4 += (size_t)c.G * 512) {
        const size_t e = i4 * 4; const int l = (int)(e / ((size_t)M * 256)); const size_t r = e - (size_t)l * M * 256; const int row = (int)(r >> 8), cc = (int)(r & 255);
        const float* src = row < MP ? c.in[6] + ((size_t)l * MP + row) * 256 + cc : c.in[7] + ((size_t)l * 2048 + (row - MP)) * 256 + cc;
        const f32x4 v = *(const f32x4*)src; u32x2 w; w.x = pk2(v[0], v[1]); w.y = pk2(v[2], v[3]); *(u32x2*)(pb + e) = w;
    }
}

__device__ __forceinline__ int next_item(const Ctx& c, int slot) {
    volatile int* sh = (volatile int*)(c.ldsg + 147392);
    __syncthreads();
    if (c.tid == 0) *sh = (int)__hip_atomic_fetch_add((unsigned*)(c.ws + WS_CTL) + 64 * (1 + slot), 1u, __ATOMIC_RELAXED, __HIP_MEMORY_SCOPE_AGENT);
    __syncthreads();
    return *sh;
}
__device__ __forceinline__ void gla_local_unit(const Ctx& c, int l, int g, int h) {
    float* L = (float*)c.ldsg; float* rs = L; float* wg = L + 1024; float* bg = L + 1536; float* la = L + 1600;
    bf16_t* KtT = (bf16_t*)(c.ldsg + 14848); bf16_t* Vt = KtT + 2304;
    const bf16_t* proj = (const bf16_t*)(c.ws + WS_BIG); const int m0 = g * 64, tid = c.tid;
    { const int e = tid * 2, row = e >> 4, cc = e & 15; const unsigned w = *(const unsigned*)(proj + (size_t)(m0 + row) * PW + C_RB + cc); rs[e] = bflo(w); rs[e + 1] = bfhi(w); }
    { const int j = tid >> 5, d = tid & 31; wg[tid] = c.in[13][(size_t)(l * 16 + j) * 128 + h * 32 + d]; }
    if (tid < 32) bg[tid] = c.in[14][l * 128 + h * 32 + tid];
    bf16_t kraw[4];
#pragma unroll
    for (int i = 0; i < 4; ++i) { const int o = tid + 512 * i, t = o >> 5, d = o & 31; kraw[i] = proj[(size_t)(m0 + t) * PW + C_KB + h * 32 + d]; }
    const u32x4 vraw = *(const u32x4*)(proj + (size_t)(m0 + (tid >> 3)) * PW + C_VB + h * 64 + (tid & 7) * 8);
    __syncthreads();
#pragma unroll
    for (int i = 0; i < 4; ++i) { const int o = tid + 512 * i, t = o >> 5, d = o & 31; float a = bg[d];
#pragma unroll
        for (int j = 0; j < 16; ++j) a += rs[t * 16 + j] * wg[j * 32 + d];
        la[t * 33 + d] = (fminf(a, 0.f) - flog(1.0f + fexp(-fabsf(a)))) * (1.0f / 16.0f); }
    __syncthreads();
    {
#pragma unroll
        for (int j = 0; j < 4; ++j) { const int d = c.wave * 4 + j; float v = la[c.lane * 33 + d];
#pragma unroll
            for (int o = 1; o < 64; o <<= 1) { const float n = __shfl_up(v, o); if (c.lane >= o) v += n; }
            la[c.lane * 33 + d] = v; }
    }
    __syncthreads();
    float* bws = (float*)(c.ws + WS_B);
#pragma unroll
    for (int i = 0; i < 4; ++i) { const int o = tid + 512 * i, t = o >> 5, d = o & 31; const float b = la[t * 33 + d];
        bws[(size_t)(m0 + t) * 128 + h * 32 + d] = b;
        KtT[d * 72 + t] = (bf16_t)f2bf(bf2f(kraw[i]) * fexp(-b)); }
    { const int t = tid >> 3, e0 = (tid & 7) * 8; const unsigned vw[4] = {vraw.x, vraw.y, vraw.z, vraw.w};
#pragma unroll
      for (int i = 0; i < 4; ++i) { Vt[(e0 + 2 * i) * 72 + t] = (bf16_t)(vw[i] & 0xffffu); Vt[(e0 + 2 * i + 1) * 72 + t] = (bf16_t)(vw[i] >> 16); } }
    if (tid < 32) ((float*)(c.ws + WS_DEC))[(size_t)(g * 4 + h) * 32 + tid] = fexp(la[63 * 33 + tid]);
    __syncthreads();
    { const int w = c.wave, lane = c.lane, fr = lane & 15, fq = lane >> 4, db = w >> 2, eb = w & 3;
      f32x4 acc = {0.f, 0.f, 0.f, 0.f};
#pragma unroll
      for (int k2 = 0; k2 < 2; ++k2) { const bf16x8 kf = *(const bf16x8*)(KtT + (16 * db + fr) * 72 + 32 * k2 + 8 * fq), vf = *(const bf16x8*)(Vt + (16 * eb + fr) * 72 + 32 * k2 + 8 * fq);
          acc = __builtin_amdgcn_mfma_f32_16x16x32_bf16(kf, vf, acc, 0, 0, 0); }
      float* dst = (float*)(c.ws + WS_DS) + (size_t)(g * 4 + h) * 2048 + (16 * db + 4 * fq) * 64 + 16 * eb + fr;
#pragma unroll
      for (int i = 0; i < 4; ++i) dst[i * 64] = acc[i]; }
    __syncthreads();
}
__device__ __forceinline__ void pool_unit(const Ctx& c, int l, int g) {
    float* ext = (float*)c.ldsg;
    const bf16_t* proj = (const bf16_t*)(c.ws + WS_BIG); bf16_t* Y = (bf16_t*)(c.ws + WS_Y);
    const int m0 = g * 64, tid = c.tid; const bool samp = g >= 512; const int cidx = samp ? 0 : (g & 127);
#pragma unroll
    for (int it = 0; it < 5; ++it) { const int q = tid + 512 * it;
        if (q < 79 * 32) { const int j = q >> 5, c8 = (q & 31) * 8; float* d = ext + j * 256 + c8;
            if (j >= 15 || cidx > 0) { const u32x4 w = *(const u32x4*)(proj + (size_t)(m0 + j - 15) * PW + C_UC + c8);
                *(f32x4*)d = (f32x4){bflo(w.x), bfhi(w.x), bflo(w.y), bfhi(w.y)}; *(f32x4*)(d + 4) = (f32x4){bflo(w.z), bfhi(w.z), bflo(w.w), bfhi(w.w)}; }
            else if (samp) { const float* sp = c.in[5] + ((size_t)(l * 32 + (g - 512)) * 15 + j) * 256 + c8; *(f32x4*)d = *(const f32x4*)sp; *(f32x4*)(d + 4) = *(const f32x4*)(sp + 4); }
            else { *(f32x4*)d = (f32x4){0.f, 0.f, 0.f, 0.f}; *(f32x4*)(d + 4) = (f32x4){0.f, 0.f, 0.f, 0.f}; } } }
    __syncthreads();
    { const int cc = tid & 255, ts = tid >> 8, gi = cc >> 6, w = 2 << gi;
      float s = 0.f;
      for (int j = 1; j < w; ++j) s += ext[(15 + ts * 32 - j) * 256 + cc];
      for (int i = 0; i < 32; ++i) { const int t = ts * 32 + i; s += ext[(15 + t) * 256 + cc];
          const int pos = samp ? 2048 + t : cidx * 64 + t; const float cnt = (float)min(w, pos + 1);
          const float dv = s / cnt - ext[(15 + t) * 256 + cc];
          Y[(size_t)(m0 + t) * D + 768 + cc] = (bf16_t)f2bf(dv); s -= ext[(15 + t - w + 1) * 256 + cc]; } }
    __syncthreads();
}

__device__ __forceinline__ void scan_unit(const Ctx& c, int l, int su) {
    const float* dS = (const float*)(c.ws + WS_DS); const float* dec = (const float*)(c.ws + WS_DEC); float* St = (float*)(c.ws + WS_ST);
    int g0, n, h, idx; float S; float* outp;
    if (su < 64) { const int bh = su >> 2, b = bh >> 2; h = bh & 3; idx = (su & 3) * 512 + c.tid; g0 = b * 128; n = 128; S = 0.f; outp = c.out + O_GP + ((size_t)(l * 4 + b) * 4 + h) * 2048 + idx; }
    else { const int s2 = su - 64, sbh = s2 >> 2, sb = sbh >> 2; h = sbh & 3; idx = (s2 & 3) * 512 + c.tid; g0 = 512 + sb; n = 1; S = c.in[4][((size_t)(l * 32 + sb) * 4 + h) * 2048 + idx]; outp = c.out + O_GS + ((size_t)(l * 32 + sb) * 4 + h) * 2048 + idx; }
    const int d = idx >> 6;
#pragma unroll 8
    for (int cc = 0; cc < n; ++cc) { const size_t gh = (size_t)(g0 + cc) * 4 + h; const float dd = dS[gh * 2048 + idx], de = dec[gh * 32 + d]; St[gh * 2048 + idx] = S; S = de * (S + dd); }
    *outp = S;
}
__device__ __forceinline__ void attn_unit(const Ctx& c, int l, int au) {
    bf16_t* Ks = (bf16_t*)c.ldsg; bf16_t* Vt = (bf16_t*)(c.ldsg + 18432); int* flags = (int*)(c.ldsg + 35840);
    const bf16_t* proj = (const bf16_t*)(c.ws + WS_BIG); bf16_t* Y = (bf16_t*)(c.ws + WS_Y);
    int R0, n_past, qb, hp, sb = 0;
    if (au < 2048) { const int b = au >> 9, rem = au & 511; qb = rem >> 2; hp = rem & 3; R0 = b * 8192; n_past = 0; }
    else { const int a2 = au - 2048; sb = a2 >> 2; hp = a2 & 3; qb = 0; R0 = MP + sb * 64; n_past = 2048; }
    const int tid = c.tid, w = c.wave, lane = c.lane, fr = lane & 15, fq = lane >> 4, hsel = w >> 2, hh = 2 * hp + hsel, qsub = w & 3;
    const int qrow = R0 + qb * 64 + qsub * 16 + fr, qpos = n_past + qb * 64 + qsub * 16 + fr;
    bf16x8 qf[2];
#pragma unroll
    for (int ks = 0; ks < 2; ++ks) qf[ks] = *(const bf16x8*)(proj + (size_t)qrow * PW + C_QA + hh * 64 + 32 * ks + 8 * fq);
    f32x4 O[4];
#pragma unroll
    for (int i = 0; i < 4; ++i) O[i] = (f32x4){0.f, 0.f, 0.f, 0.f};
    float carry = 0.f; bool wdone = false;
    int kt = (n_past + qb * 64) >> 6;
    const int lh = tid >> 8, lj = (tid >> 2) & 63, d0 = (tid & 3) * 16, lhead = 2 * hp + lh;
    for (;;) {
        {
            const int kpos = kt * 64 + lj; unsigned kk[8], vv[8];
            if (kpos < n_past) {
                const size_t o = (((size_t)(l * 32 + sb) * 2048 + kpos) * 512) + lhead * 64 + d0; const float* kp = c.in[2] + o; const float* vp = c.in[3] + o;
#pragma unroll
                for (int i = 0; i < 4; ++i) { const f32x4 a = *(const f32x4*)(kp + 4 * i), b = *(const f32x4*)(vp + 4 * i); kk[2 * i] = pk2(a[0], a[1]); kk[2 * i + 1] = pk2(a[2], a[3]); vv[2 * i] = pk2(b[0], b[1]); vv[2 * i + 1] = pk2(b[2], b[3]); }
            } else {
                const bf16_t* rp = proj + (size_t)(R0 + kpos - n_past) * PW + lhead * 64 + d0;
                const u32x4 a0 = *(const u32x4*)(rp + C_KA), a1 = *(const u32x4*)(rp + C_KA + 8), b0 = *(const u32x4*)(rp + C_VA), b1 = *(const u32x4*)(rp + C_VA + 8);
                kk[0] = a0.x; kk[1] = a0.y; kk[2] = a0.z; kk[3] = a0.w; kk[4] = a1.x; kk[5] = a1.y; kk[6] = a1.z; kk[7] = a1.w;
                vv[0] = b0.x; vv[1] = b0.y; vv[2] = b0.z; vv[3] = b0.w; vv[4] = b1.x; vv[5] = b1.y; vv[6] = b1.z; vv[7] = b1.w;
            }
            bf16_t* kd = Ks + (lh * 64 + lj) * 72 + d0;
            *(u32x4*)kd = (u32x4){kk[0], kk[1], kk[2], kk[3]}; *(u32x4*)(kd + 8) = (u32x4){kk[4], kk[5], kk[6], kk[7]};
#pragma unroll
            for (int i = 0; i < 8; ++i) { Vt[(lh * 64 + d0 + 2 * i) * 68 + lj] = (bf16_t)(vv[i] & 0xffffu); Vt[(lh * 64 + d0 + 2 * i + 1) * 68 + lj] = (bf16_t)(vv[i] >> 16); }
        }
        __syncthreads();
        {
            f32x4 sa[4];
#pragma unroll
            for (int u = 0; u < 4; ++u) { sa[u] = (f32x4){0.f, 0.f, 0.f, 0.f};
#pragma unroll
                for (int ks = 0; ks < 2; ++ks) { const bf16x8 kf = *(const bf16x8*)(Ks + (hsel * 64 + 16 * u + fr) * 72 + 32 * ks + 8 * fq); sa[u] = __builtin_amdgcn_mfma_f32_16x16x32_bf16(kf, qf[ks], sa[u], 0, 0, 0); } }
            float lk[4][4], lw[4][4], ls[4], suf[4], T[4];
#pragma unroll
            for (int u = 0; u < 4; ++u) { ls[u] = 0.f;
#pragma unroll
                for (int i = 0; i < 4; ++i) { const float z = sa[u][i] * 0.125f; const int kpos = kt * 64 + 16 * u + 4 * fq + i; const bool valid = kpos < qpos;
                    const float sp = softplus(z); lk[u][i] = valid ? -sp : 0.f; lw[u][i] = valid ? (z - sp) : -1e30f; ls[u] += lk[u][i]; } }
#pragma unroll
            for (int u = 0; u < 4; ++u) { const float a = __shfl_xor(ls[u], 16), t1 = ls[u] + a, o = __shfl_xor(t1, 32); T[u] = t1 + o; suf[u] = ((fq & 1) ? 0.f : a) + ((fq & 2) ? 0.f : o); }
            float base = carry; float wv[4][4];
#pragma unroll
            for (int u = 3; u >= 0; --u) { float run = base + suf[u];
#pragma unroll
                for (int i = 3; i >= 0; --i) { wv[u][i] = fexp(lw[u][i] + run); run += lk[u][i]; }
                base += T[u]; }
            carry = base;
#pragma unroll
            for (int k2 = 0; k2 < 2; ++k2) {
                u32x4 pw; pw.x = pk2(wv[2 * k2][0], wv[2 * k2][1]); pw.y = pk2(wv[2 * k2][2], wv[2 * k2][3]); pw.z = pk2(wv[2 * k2 + 1][0], wv[2 * k2 + 1][1]); pw.w = pk2(wv[2 * k2 + 1][2], wv[2 * k2 + 1][3]);
                const bf16x8 pf = __builtin_bit_cast(bf16x8, pw);
#pragma unroll
                for (int db = 0; db < 4; ++db) { const bf16_t* vp = Vt + (hsel * 64 + 16 * db + fr) * 68 + 32 * k2 + 4 * fq; const u32x2 lo = *(const u32x2*)vp, hi = *(const u32x2*)(vp + 16);
                    const bf16x8 vf = __builtin_bit_cast(bf16x8, (u32x4){lo.x, lo.y, hi.x, hi.y}); O[db] = __builtin_amdgcn_mfma_f32_16x16x32_bf16(vf, pf, O[db], 0, 0, 0); }
            }
            wdone = __all(carry < -46.f) != 0;
        }
        --kt;
        if (lane == 0) flags[w] = wdone ? 1 : 0;
        __syncthreads();
        int alld = 1;
#pragma unroll
        for (int i = 0; i < 8; ++i) alld &= flags[i];
        if (alld || kt < 0) break;
    }
#pragma unroll
    for (int db = 0; db < 4; ++db) { u32x2 o; o.x = pk2(O[db][0], O[db][1]); o.y = pk2(O[db][2], O[db][3]); *(u32x2*)(Y + (size_t)qrow * D + hh * 64 + 16 * db + 4 * fq) = o; }
    __syncthreads();
}

__device__ __forceinline__ void gla_out_unit(const Ctx& c, int l, int g, int h) {
    bf16_t* Qs = (bf16_t*)c.ldsg; bf16_t* Ks = Qs + 2560; bf16_t* Vt = Ks + 2560; bf16_t* ST = Vt + 4608; float* red = (float*)(ST + 2560);
    const bf16_t* proj = (const bf16_t*)(c.ws + WS_BIG); bf16_t* Y = (bf16_t*)(c.ws + WS_Y); const float* bws = (const float*)(c.ws + WS_B);
    const int m0 = g * 64, tid = c.tid, w = c.wave, lane = c.lane, fr = lane & 15, fq = lane >> 4;
    {
        const int t = tid >> 3, d0 = (tid & 7) * 4, e0 = (tid & 7) * 8;
        const f32x4 b4 = *(const f32x4*)(bws + (size_t)(m0 + t) * 128 + h * 32 + d0);
        const u32x2 q2 = *(const u32x2*)(proj + (size_t)(m0 + t) * PW + C_QB + h * 32 + d0), k2 = *(const u32x2*)(proj + (size_t)(m0 + t) * PW + C_KB + h * 32 + d0);
        const u32x4 v4 = *(const u32x4*)(proj + (size_t)(m0 + t) * PW + C_VB + h * 64 + e0);
        const int sd = tid >> 4, se0 = (tid & 15) * 4;
        const f32x4 s4 = *(const f32x4*)((const float*)(c.ws + WS_ST) + (size_t)(g * 4 + h) * 2048 + sd * 64 + se0);
        const float qv[4] = {bflo(q2.x), bfhi(q2.x), bflo(q2.y), bfhi(q2.y)}, kv[4] = {bflo(k2.x), bfhi(k2.x), bflo(k2.y), bfhi(k2.y)};
        float qo[4], ko[4];
#pragma unroll
        for (int i = 0; i < 4; ++i) { qo[i] = qv[i] * 0.17677669529663687f * fexp(b4[i]); ko[i] = kv[i] * fexp(-b4[i]); }
        *(u32x2*)(Qs + t * 40 + d0) = (u32x2){pk2(qo[0], qo[1]), pk2(qo[2], qo[3])};
        *(u32x2*)(Ks + t * 40 + d0) = (u32x2){pk2(ko[0], ko[1]), pk2(ko[2], ko[3])};
        const unsigned vw[4] = {v4.x, v4.y, v4.z, v4.w};
#pragma unroll
        for (int i = 0; i < 4; ++i) { Vt[(e0 + 2 * i) * 72 + t] = (bf16_t)(vw[i] & 0xffffu); Vt[(e0 + 2 * i + 1) * 72 + t] = (bf16_t)(vw[i] >> 16); }
#pragma unroll
        for (int i = 0; i < 4; ++i) ST[(se0 + i) * 40 + sd] = (bf16_t)f2bf(s4[i]);
    }
    __syncthreads();
    const int tb = w & 3, ebase = (w >> 2) * 2, tl = 16 * tb + fr;
    const bf16x8 qf = *(const bf16x8*)(Qs + tl * 40 + 8 * fq);
    f32x4 sa[4];
#pragma unroll
    for (int u = 0; u < 4; ++u) { sa[u] = (f32x4){0.f, 0.f, 0.f, 0.f};
        if (u <= tb) { const bf16x8 kf = *(const bf16x8*)(Ks + (16 * u + fr) * 40 + 8 * fq); sa[u] = __builtin_amdgcn_mfma_f32_16x16x32_bf16(kf, qf, sa[u], 0, 0, 0);
            if (u == tb) {
#pragma unroll
                for (int i = 0; i < 4; ++i) sa[u][i] = (4 * fq + i <= fr) ? sa[u][i] : 0.f; } } }
    f32x4 O[2];
#pragma unroll
    for (int eb = 0; eb < 2; ++eb) {
        const int erow = 16 * (ebase + eb) + fr;
        const bf16x8 stf = *(const bf16x8*)(ST + erow * 40 + 8 * fq);
        O[eb] = __builtin_amdgcn_mfma_f32_16x16x32_bf16(stf, qf, (f32x4){0.f, 0.f, 0.f, 0.f}, 0, 0, 0);
#pragma unroll
        for (int k2 = 0; k2 < 2; ++k2) {
            if (2 * k2 <= tb) {
                u32x4 pw; pw.x = pk2(sa[2 * k2][0], sa[2 * k2][1]); pw.y = pk2(sa[2 * k2][2], sa[2 * k2][3]); pw.z = pk2(sa[2 * k2 + 1][0], sa[2 * k2 + 1][1]); pw.w = pk2(sa[2 * k2 + 1][2], sa[2 * k2 + 1][3]);
                const bf16_t* vp = Vt + erow * 72 + 32 * k2 + 4 * fq; const u32x2 lo = *(const u32x2*)vp, hi = *(const u32x2*)(vp + 16);
                O[eb] = __builtin_amdgcn_mfma_f32_16x16x32_bf16(__builtin_bit_cast(bf16x8, (u32x4){lo.x, lo.y, hi.x, hi.y}), __builtin_bit_cast(bf16x8, pw), O[eb], 0, 0, 0);
            }
        }
    }
    float q2s = 0.f;
#pragma unroll
    for (int eb = 0; eb < 2; ++eb)
#pragma unroll
        for (int i = 0; i < 4; ++i) q2s += O[eb][i] * O[eb][i];
    q2s += __shfl_xor(q2s, 16); q2s += __shfl_xor(q2s, 32);
    if (fq == 0) red[w * 16 + fr] = q2s;
    __syncthreads();
    const float r = __builtin_amdgcn_rsqf((red[w * 16 + fr] + red[(w ^ 4) * 16 + fr]) * (1.0f / 64.0f) + EPS);
#pragma unroll
    for (int eb = 0; eb < 2; ++eb) {
        const int ecol = h * 64 + 16 * (ebase + eb) + 4 * fq;
        const u32x2 ow = *(const u32x2*)(proj + (size_t)(m0 + tl) * PW + C_OB + ecol); const f32x4 gn = *(const f32x4*)(c.in[15] + l * 256 + ecol);
        const float ob[4] = {bflo(ow.x), bfhi(ow.x), bflo(ow.y), bfhi(ow.y)}; float y[4];
#pragma unroll
        for (int i = 0; i < 4; ++i) y[i] = O[eb][i] * r * gn[i] * (ob[i] * sigm(ob[i]));
        *(u32x2*)(Y + (size_t)(m0 + tl) * D + 512 + ecol) = (u32x2){pk2(y[0], y[1]), pk2(y[2], y[3])};
    }
    __syncthreads();
}

__device__ __forceinline__ void grid_bar(unsigned* ctl, unsigned r) {
    asm volatile("s_waitcnt vmcnt(0)" ::: "memory");
    __syncthreads();
    if (threadIdx.x == 0) {
        const unsigned g = blockIdx.x & 7u, G = gridDim.x, nloc = (G - g + 7u) >> 3, ngrp = G < 8u ? G : 8u;
        unsigned* cnt = ctl + 64 * (16 + g); unsigned* gen = ctl + 64 * (24 + g); unsigned* top = ctl + 64 * 32;
        __builtin_amdgcn_fence(__ATOMIC_RELEASE, "agent");
        asm volatile("s_waitcnt vmcnt(0)" ::: "memory");
        const unsigned old = __hip_atomic_fetch_add(cnt, 1u, __ATOMIC_RELAXED, __HIP_MEMORY_SCOPE_AGENT);
        if (old + 1u == r * nloc) {
            __hip_atomic_fetch_add(top, 1u, __ATOMIC_RELAXED, __HIP_MEMORY_SCOPE_AGENT);
            while (__hip_atomic_load(top, __ATOMIC_RELAXED, __HIP_MEMORY_SCOPE_AGENT) < r * ngrp) __builtin_amdgcn_s_sleep(1);
            __hip_atomic_store(gen, r, __ATOMIC_RELAXED, __HIP_MEMORY_SCOPE_AGENT);
        } else {
            while (__hip_atomic_load(gen, __ATOMIC_RELAXED, __HIP_MEMORY_SCOPE_AGENT) < r) __builtin_amdgcn_s_sleep(1);
        }
        __builtin_amdgcn_fence(__ATOMIC_ACQUIRE, "agent");
        asm volatile("s_waitcnt vmcnt(0)" ::: "memory");
    }
    __syncthreads();
}

__global__ void __launch_bounds__(512, 2) fwd_mega(Args args) {
    extern __shared__ __attribute__((aligned(16))) unsigned char lds[];
    cg::grid_group grid = cg::this_grid();
    Ctx c; c.in = args.in; c.out = args.out; c.ws = args.ws; c.lds = (LAS unsigned char*)lds; c.ldsg = lds;
    c.tid = threadIdx.x; c.lane = c.tid & 63; c.wave = __builtin_amdgcn_readfirstlane(c.tid >> 6); c.G = gridDim.x; c.bx = blockIdx.x;
    for (int ph = args.ph_lo; ph < args.ph_hi; ++ph) {
        { int t_ = threadIdx.x; asm volatile("" : "+v"(t_)); c.tid = t_; c.lane = t_ & 63; c.wave = __builtin_amdgcn_readfirstlane(t_ >> 6); }
        unsigned char* ws = args.ws; float* outp = args.out; asm volatile("" : "+s"(ws), "+s"(outp)); c.ws = ws; c.out = outp;
        bf16_t* xb = (bf16_t*)(ws + WS_XB); bf16_t* big = (bf16_t*)(ws + WS_BIG); bf16_t* Yb = (bf16_t*)(ws + WS_Y); bf16_t* mg = (bf16_t*)(ws + WS_MG);
        float* scr = (float*)(ws + WS_SCR); float* ss0 = (float*)(ws + WS_SS); float* ss1 = ss0 + (size_t)M * 32; float* xw = outp + O_Y;
        if (ph == 0) prologue(c);
        else if (ph == 25) {
            const float* gf = args.in[28];
            for (int row = c.bx * 8 + c.wave; row < M; row += c.G * 8) { const float rs = rstd_of(ss0, row);
#pragma unroll
                for (int j = 0; j < 4; ++j) { const u32x2 h2 = *(const u32x2*)(mg + (size_t)row * D + c.lane * 4 + 256 * j); const f32x4 v = {bflo(h2.x), bfhi(h2.x), bflo(h2.y), bfhi(h2.y)}, gg = *(const f32x4*)(gf + c.lane * 4 + 256 * j);
                    *(f32x4*)(xw + (size_t)row * D + c.lane * 4 + 256 * j) = v * rs * gg; } }
        } else {
            const int l = (ph - 1) / 12, k = (ph - 1) % 12;
            if ((MK_SKIPMASK >> k) & 1) continue;
            const bf16_t* Wl = (const bf16_t*)(ws + WS_W) + (size_t)l * WL_END;
            if (k == 0 || k == 8) {
                pg8::Gemm g{(k == 0 && l > 0) ? mg : xb, Wl + (k == 0 ? WL_1IN : WL_2IN), D, D}; pg8::Sched S;     S.init(M, 2 * FF, c.G, c.bx, 16);
                EpiSwiglu E{big}; pg8::gemm_phase(c.lds, c.tid, g, S, E, ss0);
            } else if (k == 1 || k == 9 || k == 7 || k == 11) {
                pg8::Gemm g; pg8::Sched S; EpiRes E{xb, xb, nullptr, (const bf16_t*)scr, 1.f, 0, nullptr, nullptr}; const float* ssin = nullptr;
                if (k == 1 || k == 9) { g = pg8::Gemm{big, Wl + (k == 1 ? WL_1OUT : WL_2OUT), FF, FF}; S.init(M, D, c.G, c.bx, 44); S.quart = 1; E.alpha = 0.5f; E.ss_out = ss1; if (k == 1) { if (l == 0) { E.xin0 = args.in[0]; E.xin1 = args.in[1]; } else E.xsrc = mg; } }
                else if (k == 7) { g = pg8::Gemm{mg, Wl + WL_OUT, D, D}; S.init(M, D, c.G, c.bx, 16); S.quart = 1; E.ss_out = ss0; }
                else { g = pg8::Gemm{xb, Wl + WL_PG, D, D}; S.init(M, D, c.G, c.bx, 16); S.quart = 1; E.ss_out = ss0; ssin = ss1; E.mode = 1; E.xb = mg; }
                pg8::gemm_phase(c.lds, c.tid, g, S, E, ssin);
            } else if (k == 2) {
                pg8::Gemm g{xb, Wl + WL_IN, D, D}; pg8::Sched S; S.init(M, NIN, c.G, c.bx, 16); S.quart = 1;
                EpiWin E{big, outp, l}; pg8::gemm_phase(c.lds, c.tid, g, S, E, ss1);
            } else if (k == 3) {
                for (int it = next_item(c, l * 3 + 0); it < 2176 + NCH; it = next_item(c, l * 3 + 0)) { if (it < NCH) pool_unit(c, l, it); else gla_local_unit(c, l, (it - NCH) >> 2, (it - NCH) & 3); }
            } else if (k == 4) {
                for (int it = next_item(c, l * 3 + 1); it < 576 + 2176; it = next_item(c, l * 3 + 1)) { if (it < 576) scan_unit(c, l, it); else attn_unit(c, l, it - 576); }
            } else if (k == 5) {
                for (int it = next_item(c, l * 3 + 2); it < 2176; it = next_item(c, l * 3 + 2)) gla_out_unit(c, l, it >> 2, it & 3);
            } else {
                pg8::Gemm g; pg8::Sched S; EpiBranch E{big, (bf16_t*)scr, mg, 0};
                if (k == 6) { g = pg8::Gemm{Yb, Wl + WL_BR, D, D}; S.init(M, D, c.G, c.bx, 8); S.nsub = 3; S.quart = 1; }
                else { g = pg8::Gemm{(const bf16_t*)(ws + WS_PB) + (size_t)l * M * 256, Wl + WL_PP, 256, 256}; S.init(M, D, c.G, c.bx, 4); S.quart = 1; E.mode = 1; }
                pg8::gemm_phase(c.lds, c.tid, g, S, E, nullptr);
            }
        }
        if (ph + 1 < args.ph_hi) { if (args.ph_hi > 4096) grid.sync(); grid_bar((unsigned*)(args.ws + WS_CTL), (unsigned)(ph - args.ph_lo + 1)); }
    }
}

extern "C" void kernel_launch(void* const* d_in, const int* in_sizes, int n_in, void* d_out, int out_size, void* d_ws, size_t ws_size, hipStream_t stream) {
    static int grid = 0;
    if (grid == 0) {
        if (n_in != 29 || ws_size < WS_NEED) { fprintf(stderr, "kernel_launch: unexpected n_in %d / ws %zu\n", n_in, ws_size); grid = -1; return; }
        int dev = 0, cus = 0, per_cu = 0;
        (void)hipGetDevice(&dev); (void)hipDeviceGetAttribute(&cus, hipDeviceAttributeMultiprocessorCount, dev);
        (void)hipFuncSetAttribute((const void*)fwd_mega, hipFuncAttributeMaxDynamicSharedMemorySize, LDS_BYTES);
        (void)hipOccupancyMaxActiveBlocksPerMultiprocessor(&per_cu, (const void*)fwd_mega, 512, LDS_BYTES);
        (void)hipGetLastError();
        if (per_cu < 1) per_cu = 1;
        grid = cus;
    }
    if (grid < 0) return;
    (void)hipMemsetAsync((char*)d_ws + WS_CTL, 0, 16384, stream);
    Args a{};
    for (int i = 0; i < 29; ++i) a.in[i] = (const float*)d_in[i];
    a.out = (float*)d_out; a.ws = (unsigned char*)d_ws;
#if MK_ONE_LAUNCH
    a.ph_lo = 0; a.ph_hi = NPH;
    void* kargs[] = {&a};
    hipError_t e = hipLaunchCooperativeKernel((const void*)fwd_mega, dim3(grid), dim3(512), kargs, LDS_BYTES, stream);
    if (e != hipSuccess) fprintf(stderr, "cooperative launch failed: %s (grid %d)\n", hipGetErrorString(e), grid);
#else
    for (int ph = 0; ph < NPH; ++ph) { a.ph_lo = ph; a.ph_hi = ph + 1; hipLaunchKernelGGL(fwd_mega, dim3(grid), dim3(512), LDS_BYTES, stream, a); }
#endif
}
```

```cpp
#include <hip/hip_runtime.h>
#include <hip/hip_cooperative_groups.h>
#include <cstdio>
#include <cstdint>
namespace cg = cooperative_groups;

#ifndef MK_SKIPMASK
#define MK_SKIPMASK 0
#endif
#ifndef MK_NOATTN
#define MK_NOATTN 0
#endif
#ifndef MK_NOGLAOUT
#define MK_NOGLAOUT 0
#endif
#ifndef MK_ONE_LAUNCH
#define MK_ONE_LAUNCH 1
#endif

#define LAS __attribute__((address_space(3)))
typedef unsigned short bf16_t;
typedef short bf16x8 __attribute__((ext_vector_type(8)));
typedef float f32x4 __attribute__((ext_vector_type(4)));
typedef unsigned u32x4 __attribute__((ext_vector_type(4)));
typedef unsigned u32x2 __attribute__((ext_vector_type(2)));

constexpr int M = 34816;
constexpr int MP = 32768;
constexpr int D = 1024, FF = 2816, NIN = 5888, PW = 5888  , INW = 5648;
constexpr int NCH = 544;
constexpr float EPS = 1e-6f;
constexpr size_t O_Y = 0, O_KP = 35651584, O_VP = 69206016, O_GP = 102760448, O_PP = 102825984, O_KS = 102856704, O_VS = 104953856, O_GS = 107051008, O_PS = 107575296;
constexpr int C_QA = 0, C_KA = 512, C_VA = 1024, C_QB = 1536, C_KB = 1664, C_VB = 1792, C_OB = 2048, C_UC = 2304, C_G = 2560, C_RB = 5632;

constexpr size_t WL_1IN = 0, WL_1OUT = WL_1IN + (size_t)5632 * 1024, WL_IN = WL_1OUT + (size_t)1024 * 2816, WL_BR = WL_IN + (size_t)5888 * 1024, WL_OUT = WL_BR + 1048576,
                 WL_2IN = WL_OUT + 1048576, WL_2OUT = WL_2IN + (size_t)5632 * 1024, WL_PG = WL_2OUT + (size_t)1024 * 2816, WL_PP = WL_PG + 1048576, WL_END = WL_PP + 262144;
constexpr size_t MiB = 1u << 20;
constexpr size_t WS_W = 0;
constexpr size_t WS_XB = 104 * MiB;
constexpr size_t WS_PB = 172 * MiB;
constexpr size_t WS_BIG = 208 * MiB;
constexpr size_t WS_Y = 600 * MiB;
constexpr size_t WS_MG = 668 * MiB;
constexpr size_t WS_SCR = 736 * MiB;
constexpr size_t WS_SS = 934 * MiB;
constexpr size_t WS_DS = 878 * MiB;
constexpr size_t WS_ST = 896 * MiB;
constexpr size_t WS_B = 914 * MiB;
constexpr size_t WS_DEC = 932 * MiB;
constexpr size_t WS_CTL = 933 * MiB;
constexpr size_t WS_NEED = 944 * MiB;
static_assert(2 * WL_END * 2 <= 104 * MiB, "weights fit");

__device__ __forceinline__ unsigned f2bf(float f) { unsigned u = __builtin_bit_cast(unsigned, f); return (u + 0x7fffu + ((u >> 16) & 1u)) >> 16; }
__device__ __forceinline__ unsigned pk2(float lo, float hi) { unsigned r; asm("v_cvt_pk_bf16_f32 %0, %1, %2" : "=v"(r) : "v"(lo), "v"(hi)); return r; }
__device__ __forceinline__ float bflo(unsigned u) { return __uint_as_float(u << 16); }
__device__ __forceinline__ float bfhi(unsigned u) { return __uint_as_float(u & 0xffff0000u); }
__device__ __forceinline__ float bf2f(bf16_t b) { return __uint_as_float((unsigned)b << 16); }
__device__ __forceinline__ float fexp(float x) { return __builtin_amdgcn_exp2f(x * 1.4426950408889634f); }
__device__ __forceinline__ float flog(float x) { return __builtin_amdgcn_logf(x) * 0.6931471805599453f; }
__device__ __forceinline__ float sigm(float x) { return __builtin_amdgcn_rcpf(1.0f + fexp(-x)); }
__device__ __forceinline__ float softplus(float z) { return fmaxf(z, 0.f) + flog(1.0f + fexp(-fabsf(z))); }
__device__ __forceinline__ float rstd_of(const float* ss, int row) {
    const f32x4* p = (const f32x4*)(ss + (size_t)row * 32);
    float s = 0.f;
#pragma unroll
    for (int i = 0; i < 8; ++i) { const f32x4 a = p[i]; s += (a[0] + a[1]) + (a[2] + a[3]); }
    return __builtin_amdgcn_rsqf(s * (1.0f / 1024.0f) + EPS);
}

namespace pg8 {
constexpr int BM = 256, BK = 64, HALF = 128, HTB = HALF * BK * 2, STAGE_BYTES = 8 * HTB, NXCD = 8, WGM = 8;
__host__ __device__ __forceinline__ int lds_byte(int r, int c) { const int st = (r >> 4) * 2 + (c >> 5), rr = r & 15, cc = c & 31, ob = rr * 64 + cc * 2; return st * 1024 + (ob ^ (((ob >> 9) & 1) << 5)); }
__host__ __device__ __forceinline__ void stage_rc(int b, int& R, int& C) { const int st = b / 1024, sb = b % 1024, swz = sb ^ (((sb >> 9) & 1) << 5); R = (st >> 1) * 16 + swz / 64; C = (st & 1) * 32 + (swz % 64) / 2; }
__host__ __device__ __forceinline__ int perm32(int rho) { const int n = rho >> 4, i = rho & 15; return 8 * (i >> 2) + 4 * n + (i & 3); }

struct Unit { int pm, pn, kind, k0, nt, qm; };
struct Gemm { const bf16_t* A; const bf16_t* Bt; int lda, ldb; };

struct Sched {
    int nM, nN, nwg, G, c, nsub, nt0, quart;
    __device__ __forceinline__ void init(int M_, int N_, int G_, int c_, int nt) { nM = M_ / BM; nN = N_ / BM; nwg = nM * nN; G = G_; c = c_; nsub = 1; nt0 = nt; quart = 0; }
    __device__ __forceinline__ bool next(int i, Unit& u) const {
        const int ti = i / nsub, sk = i - ti * nsub;
        long L = (long)ti * G + c; int qm = 0xF;
        const int nfull = nwg / G;
        if (quart && ti >= nfull) {
            const long li = (long)(ti - nfull) * G + c; if (li >= 4L * (nwg - nfull * G)) return false;
            L = (long)nfull * G + (li >> 2); qm = 1 << (int)(li & 3);
        } else if (L >= nwg) return false;
        u.qm = qm;
        int wgid = (int)L; { const int q = nwg / NXCD, r = nwg % NXCD, xcd = wgid % NXCD, off = wgid / NXCD; wgid = (xcd < r ? xcd * (q + 1) : r * (q + 1) + (xcd - r) * q) + off; }
        const int nig = WGM * nN, gid = wgid / nig, fm = gid * WGM, gsz = (nM - fm) < WGM ? (nM - fm) : WGM;
        u.pm = fm + ((wgid % nig) % gsz); u.pn = (wgid % nig) / gsz; u.kind = sk; u.k0 = (sk > 0) ? 256 + 256 * sk : 0; u.nt = (sk > 0) ? 4 : nt0; return true;
    }
};

#define PG8_KLOOP(C0, C1, C2, C3) \
        for (int t = 0; t < nt; t += 2) { \
            const bool last = (t == nt - 2); \
            const char* a1 = cA + (size_t)(t + 1) * kstep; \
            const char* a2 = last ? nA : cA + (size_t)(t + 2) * kstep; const char* b2 = last ? nB : cB + (size_t)(t + 2) * kstep; \
            const char* a3 = a2 + kstep; const char* b3 = b2 + kstep; \
            PG8_LDB(B0, 0, 0); PG8_LDB(B1, 0, 1); PG8_SCHED; PG8_LDA(At, 0, 0); PG8_STAGE(PG8_SA(1, 1), a1 + hstepA, voffA); \
            PG8_WAIT_V(8); PG8_WAIT_L(0); PG8_BAR; if (C0) PG8_MMA(0, 0, At, B0); if (C1) PG8_MMA(0, 1, At, B1); PG8_BAR; PG8_SCHED; \
            PG8_LDA(At, 0, 1); PG8_STAGE(PG8_SB(0, 0), b2, voffB); PG8_STAGE(PG8_SB(0, 1), b2 + hstepB, voffB); PG8_STAGE(PG8_SA(0, 0), a2, voffA); \
            PG8_WAIT_V(8); PG8_WAIT_L(0); PG8_BAR; if (C2) PG8_MMA(1, 0, At, B0); if (C3) PG8_MMA(1, 1, At, B1); PG8_BAR; PG8_SCHED; \
            PG8_LDB(B0, 1, 0); PG8_LDB(B1, 1, 1); PG8_SCHED; PG8_LDA(At, 1, 0); PG8_STAGE(PG8_SA(0, 1), a2 + hstepA, voffA); \
            PG8_WAIT_V(8); PG8_WAIT_L(0); PG8_BAR; if (C0) PG8_MMA(0, 0, At, B0); if (C1) PG8_MMA(0, 1, At, B1); PG8_BAR; PG8_SCHED; \
            PG8_LDA(At, 1, 1); PG8_STAGE(PG8_SB(1, 0), b3, voffB); PG8_STAGE(PG8_SB(1, 1), b3 + hstepB, voffB); PG8_STAGE(PG8_SA(1, 0), a3, voffA); \
            PG8_WAIT_V(8); PG8_WAIT_L(0); PG8_BAR; if (C2) PG8_MMA(1, 0, At, B0); if (C3) PG8_MMA(1, 1, At, B1); PG8_BAR; PG8_SCHED; \
        }
template <class Epi, class Sch>
__device__ __forceinline__ void gemm_phase(LAS unsigned char* lds, const int tid, const Gemm g, const Sch& S, const Epi& E, const float* ss) {
    const int wid = __builtin_amdgcn_readfirstlane(tid >> 6), lane = tid & 63, wr = wid >> 2, wc = wid & 3, fr = lane & 15, fq = lane >> 4;
    unsigned voffA[2], voffB[2];
#pragma unroll
    for (int i = 0; i < 2; ++i) { int R, C; stage_rc(tid * 16 + i * 8192, R, C); const int Rb = (R & ~31) + perm32(R & 31);
        voffA[i] = (unsigned)(R * g.lda + C) * 2u; voffB[i] = (unsigned)(Rb * g.ldb + C) * 2u; }
    const size_t kstep = (size_t)(BK * 2);
    const size_t hstepA = (size_t)HALF * g.lda * 2, hstepB = (size_t)HALF * g.ldb * 2;
    const size_t tstepA = 2 * hstepA, tstepB = 2 * hstepB;
    const unsigned ldsw = (unsigned)wid * 1024u;
    const int aoff = lds_byte(wr * 64 + fr, fq * 8), boff = lds_byte(wc * 32 + fr, fq * 8);
    LAS float* rtab = (LAS float*)(lds + STAGE_BYTES);
    f32x4 rt_a = {0.f, 0.f, 0.f, 0.f}, rt_b = rt_a, rt_c = rt_a, rt_d = rt_a;
#define PG8_RTAB_LOAD(pm_) do { if (ss) { const f32x4* p_ = (const f32x4*)(ss + ((size_t)(pm_) * 256 + (tid >> 1)) * 32 + (tid & 1) * 16); rt_a = p_[0]; rt_b = p_[1]; rt_c = p_[2]; rt_d = p_[3]; } } while (0)
#define PG8_RTAB_FIN(buf_) do { if (ss) { float s_ = (((rt_a[0] + rt_a[1]) + (rt_a[2] + rt_a[3])) + ((rt_b[0] + rt_b[1]) + (rt_b[2] + rt_b[3]))) + (((rt_c[0] + rt_c[1]) + (rt_c[2] + rt_c[3])) + ((rt_d[0] + rt_d[1]) + (rt_d[2] + rt_d[3]))); \
        s_ += __shfl_xor(s_, 1); if (!(tid & 1)) rtab[(buf_) * 256 + (tid >> 1)] = __builtin_amdgcn_rsqf(s_ * (1.0f / 1024.0f) + EPS); } } while (0)
#define PG8_SA(b, h) (((b) * 2 + (h)) * HTB)
#define PG8_SB(b, h) ((4 + (b) * 2 + (h)) * HTB)
#define PG8_STAGE(bufoff, gbase, voff) do { _Pragma("unroll") for (int _i = 0; _i < 2; ++_i) \
        __builtin_amdgcn_global_load_lds((const unsigned*)((const char*)(gbase) + (voff)[_i]), (LAS unsigned*)(lds + (bufoff) + ldsw + _i * 8192), 16, 0, 0); } while (0)
#define PG8_LDA(dst, b, h) do { _Pragma("unroll") for (int m = 0; m < 4; ++m) _Pragma("unroll") for (int k = 0; k < 2; ++k) dst[m][k] = *(const LAS bf16x8*)(lds + PG8_SA(b, h) + aoff + m * 2048 + k * 1024); } while (0)
#define PG8_LDB(dst, b, h) do { _Pragma("unroll") for (int n = 0; n < 2; ++n) _Pragma("unroll") for (int k = 0; k < 2; ++k) dst[n][k] = *(const LAS bf16x8*)(lds + PG8_SB(b, h) + boff + n * 2048 + k * 1024); } while (0)
#define PG8_MMA(ai, bj, At, Bt) do { __builtin_amdgcn_s_setprio(1); _Pragma("unroll") for (int m = 0; m < 4; ++m) _Pragma("unroll") for (int n = 0; n < 2; ++n) _Pragma("unroll") for (int k = 0; k < 2; ++k) \
        acc[ai][bj][m][n] = __builtin_amdgcn_mfma_f32_16x16x32_bf16(Bt[n][k], At[m][k], acc[ai][bj][m][n], 0, 0, 0); __builtin_amdgcn_s_setprio(0); } while (0)
#define PG8_WAIT_V(n) asm volatile("s_waitcnt vmcnt(" #n ")" ::: "memory")
#define PG8_WAIT_L(n) asm volatile("s_waitcnt lgkmcnt(" #n ")" ::: "memory")
#define PG8_BAR __builtin_amdgcn_s_barrier()
#define PG8_SCHED __builtin_amdgcn_sched_barrier(0)
    Unit cur, nxt; int ui = 0;
    if (!S.next(0, cur)) return;
    f32x4 acc[2][2][4][2];
#pragma unroll
    for (int a = 0; a < 2; ++a)
#pragma unroll
        for (int b = 0; b < 2; ++b)
#pragma unroll
            for (int m = 0; m < 4; ++m)
#pragma unroll
                for (int n = 0; n < 2; ++n) acc[a][b][m][n] = (f32x4){0.f, 0.f, 0.f, 0.f};
    bf16x8 At[4][2], B0[2][2], B1[2][2];
    const char* cA = (const char*)g.A + (size_t)cur.pm * tstepA + (size_t)cur.k0 * 2; const char* cB = (const char*)g.Bt + (size_t)cur.pn * tstepB + (size_t)cur.k0 * 2;
    PG8_RTAB_LOAD(cur.pm); PG8_RTAB_FIN(0);
    PG8_STAGE(PG8_SB(0, 0), cB, voffB); PG8_STAGE(PG8_SB(0, 1), cB + hstepB, voffB); PG8_STAGE(PG8_SA(0, 0), cA, voffA); PG8_STAGE(PG8_SA(0, 1), cA + hstepA, voffA);
    if (wr == 1) PG8_BAR;
    PG8_WAIT_V(2); PG8_BAR;
    PG8_STAGE(PG8_SB(1, 0), cB + kstep, voffB); PG8_STAGE(PG8_SA(1, 0), cA + kstep, voffA); PG8_STAGE(PG8_SB(1, 1), cB + hstepB + kstep, voffB);
    PG8_WAIT_V(6); PG8_BAR;
    for (;;) {
        const bool has_next = S.next(ui + 1, nxt);
        const char* nA = has_next ? (const char*)g.A + (size_t)nxt.pm * tstepA + (size_t)nxt.k0 * 2 : cA; const char* nB = has_next ? (const char*)g.Bt + (size_t)nxt.pn * tstepB + (size_t)nxt.k0 * 2 : cB;
        const int nt = cur.nt, qm = cur.qm;
        if (qm == 0xF) { PG8_KLOOP(true, true, true, true) } else { PG8_KLOOP((qm & 1), (qm & 2), (qm & 4), (qm & 8)) }
        if (wr == 0) PG8_BAR;
        if (has_next) PG8_RTAB_LOAD(nxt.pm);
        E(acc, cur, wr, wc, fr, fq, rtab + (ui & 1) * 256);
        if (!has_next) break;
#pragma unroll
        for (int a = 0; a < 2; ++a)
#pragma unroll
            for (int b = 0; b < 2; ++b)
#pragma unroll
                for (int m = 0; m < 4; ++m)
#pragma unroll
                    for (int n = 0; n < 2; ++n) acc[a][b][m][n] = (f32x4){0.f, 0.f, 0.f, 0.f};
        cur = nxt; cA = nA; cB = nB; ++ui;
        PG8_RTAB_FIN(ui & 1);
        if (wr == 1) PG8_BAR;
    }
    PG8_WAIT_V(0);
    PG8_BAR;
#undef PG8_SA
#undef PG8_RTAB_LOAD
#undef PG8_RTAB_FIN
#undef PG8_SB
#undef PG8_STAGE
#undef PG8_LDA
#undef PG8_LDB
#undef PG8_MMA
#undef PG8_WAIT_V
#undef PG8_WAIT_L
#undef PG8_BAR
#undef PG8_SCHED
}
}
using pg8::Unit;

#define EPI_FENCE() asm volatile("" ::: "memory")
struct EpiSwiglu {
    bf16_t* hid;
    __device__ __forceinline__ void operator()(const f32x4 (&acc)[2][2][4][2], const Unit& u, int wr, int wc, int fr, int fq, const LAS float* rt) const {
        const int row0 = u.pm * 256 + wr * 64 + fr, col = u.pn * 128 + wc * 32 + 8 * fq;
#pragma unroll
        for (int ai = 0; ai < 2; ++ai)
#pragma unroll
            for (int m = 0; m < 4; ++m) {
                const int rl = ai * 128 + m * 16; const int row = row0 + rl; const float rs = rt[wr * 64 + fr + rl];
                float h[8];
#pragma unroll
                for (int n = 0; n < 2; ++n)
#pragma unroll
                    for (int i = 0; i < 4; ++i) { const float a = acc[ai][0][m][n][i] * rs, b = acc[ai][1][m][n][i] * rs; h[4 * n + i] = a * sigm(a) * b; }
                u32x4 w; w.x = pk2(h[0], h[1]); w.y = pk2(h[2], h[3]); w.z = pk2(h[4], h[5]); w.w = pk2(h[6], h[7]);
                *(u32x4*)(hid + (size_t)row * FF + col) = w;
            }
    }
};
struct EpiWin {
    bf16_t* proj; float* out; int layer;
    __device__ __forceinline__ void operator()(const f32x4 (&acc)[2][2][4][2], const Unit& u, int wr, int wc, int fr, int fq, const LAS float* rt) const {
        const int row0 = u.pm * 256 + wr * 64 + fr, pn = u.pn;
        const bool isgate = (pn >= 10 && pn < 22), iskv = (pn >= 2 && pn < 6), ispool = (pn == 9);
#pragma unroll
        for (int ai = 0; ai < 2; ++ai)
#pragma unroll
            for (int m = 0; m < 4; ++m) {
                const int rl = ai * 128 + m * 16; const int row = row0 + rl; const float rs = rt[wr * 64 + fr + rl];
#pragma unroll
                for (int bj = 0; bj < 2; ++bj) {
                    if (!((u.qm >> (ai * 2 + bj)) & 1)) continue;
                    const int ct = bj * 128 + wc * 32 + 8 * fq;
                    f32x4 v0 = acc[ai][bj][m][0] * rs, v1 = acc[ai][bj][m][1] * rs;
                    if (isgate) {
#pragma unroll
                        for (int i = 0; i < 4; ++i) { v0[i] = sigm(v0[i]); v1[i] = sigm(v1[i]); }
                    }
                    u32x4 w; w.x = pk2(v0[0], v0[1]); w.y = pk2(v0[2], v0[3]); w.z = pk2(v1[0], v1[1]); w.w = pk2(v1[2], v1[3]);
                    *(u32x4*)(proj + (size_t)row * PW + pn * 256 + ct) = w;
                    if (iskv) {
                        const int c512 = (pn & 1) * 256 + ct; const bool isv = pn >= 4;
                        float* dst = row < MP ? out + (isv ? O_VP : O_KP) + ((size_t)layer * MP + row) * 512 + c512
                                              : out + (isv ? O_VS : O_KS) + ((size_t)layer * 2048 + (row - MP)) * 512 + c512;
                        *(f32x4*)dst = v0; *(f32x4*)(dst + 4) = v1;
                    }
                    if (ispool) {
                        if (row < MP) { const int t = row & 8191, b = row >> 13; if (t >= 8177) { float* dst = out + O_PP + ((size_t)(layer * 4 + b) * 15 + (t - 8177)) * 256 + ct; *(f32x4*)dst = v0; *(f32x4*)(dst + 4) = v1; } }
                        else { const int r = row - MP, t = r & 63, sb = r >> 6; if (t >= 49) { float* dst = out + O_PS + ((size_t)(layer * 32 + sb) * 15 + (t - 49)) * 256 + ct; *(f32x4*)dst = v0; *(f32x4*)(dst + 4) = v1; } }
                    }
                }
            }
    }
};
struct EpiRes {
    const bf16_t* xsrc; bf16_t* xb; float* ss_out; const bf16_t* scr; float alpha; int mode; const float* xin0; const float* xin1;
    __device__ __forceinline__ void operator()(const f32x4 (&acc)[2][2][4][2], const Unit& u, int wr, int wc, int fr, int fq, const LAS float* rt) const {
        const int row0 = u.pm * 256 + wr * 64 + fr, colb = u.pn * 256 + wc * 32 + 8 * fq;
        const float* xr = xin0 ? (u.pm < MP / 256 ? xin0 : xin1 - (size_t)MP * D) : nullptr;
        if (mode == 0 && !xr) {
#pragma unroll
            for (int ai = 0; ai < 2; ++ai) {
                if (!((u.qm >> (2 * ai)) & 3)) continue;
                u32x4 xh[4][2];
#pragma unroll
                for (int m = 0; m < 4; ++m)
#pragma unroll
                    for (int bj = 0; bj < 2; ++bj) xh[m][bj] = *(const u32x4*)(xsrc + (size_t)(row0 + ai * 128 + m * 16) * D + colb + bj * 128);
#pragma unroll
                for (int m = 0; m < 4; ++m)
#pragma unroll
                    for (int bj = 0; bj < 2; ++bj) {
                        if (!((u.qm >> (ai * 2 + bj)) & 1)) continue;
                        const int row = row0 + ai * 128 + m * 16; const size_t off = (size_t)row * D + colb + bj * 128;
                        const u32x4 h4 = xh[m][bj];
                        const f32x4 x0 = (f32x4){bflo(h4.x), bfhi(h4.x), bflo(h4.y), bfhi(h4.y)} + acc[ai][bj][m][0] * alpha, x1 = (f32x4){bflo(h4.z), bfhi(h4.z), bflo(h4.w), bfhi(h4.w)} + acc[ai][bj][m][1] * alpha;
                        u32x4 w; w.x = pk2(x0[0], x0[1]); w.y = pk2(x0[2], x0[3]); w.z = pk2(x1[0], x1[1]); w.w = pk2(x1[2], x1[3]);
                        *(u32x4*)(xb + off) = w;
                        float ssum = (x0[0] * x0[0] + x0[1] * x0[1]) + (x0[2] * x0[2] + x0[3] * x0[3]) + (x1[0] * x1[0] + x1[1] * x1[1]) + (x1[2] * x1[2] + x1[3] * x1[3]);
                        ssum += __shfl_xor(ssum, 16); ssum += __shfl_xor(ssum, 32);
                        if (fq == 0) ss_out[(size_t)row * 32 + u.pn * 8 + bj * 4 + wc] = ssum;
                    }
                EPI_FENCE();
            }
            return;
        }
#pragma unroll
        for (int ai = 0; ai < 2; ++ai) {
            if (!((u.qm >> (2 * ai)) & 3)) continue;
#pragma unroll
            for (int mp = 0; mp < 2; ++mp) {
                f32x4 xv[2][2][2]; u32x4 sv[2][2];
#pragma unroll
                for (int mi = 0; mi < 2; ++mi)
#pragma unroll
                    for (int bj = 0; bj < 2; ++bj) {
                        const size_t off = (size_t)(row0 + ai * 128 + (2 * mp + mi) * 16) * D + colb + bj * 128;
                        if (xr) { xv[mi][bj][0] = *(const f32x4*)(xr + off); xv[mi][bj][1] = *(const f32x4*)(xr + off + 4); }
                        else xv[mi][bj][0] = __builtin_bit_cast(f32x4, *(const u32x4*)(xsrc + off));
                        if (mode == 1) sv[mi][bj] = *(const u32x4*)(scr + off);
                    }
#pragma unroll
                for (int mi = 0; mi < 2; ++mi) {
                    const int m = 2 * mp + mi, rl = ai * 128 + m * 16, row = row0 + rl;
                    const float rs = (mode == 1) ? rt[wr * 64 + fr + rl] : 1.f;
#pragma unroll
                    for (int bj = 0; bj < 2; ++bj) {
                        if (!((u.qm >> (ai * 2 + bj)) & 1)) continue;
                        const size_t off = (size_t)row * D + colb + bj * 128;
                        f32x4 v0 = acc[ai][bj][m][0], v1 = acc[ai][bj][m][1];
                        if (mode == 1) {
#pragma unroll
                            for (int i = 0; i < 4; ++i) { v0[i] = sigm(v0[i] * rs); v1[i] = sigm(v1[i] * rs); }
                            { const u32x4 p4 = sv[mi][bj]; v0[0] *= bflo(p4.x); v0[1] *= bfhi(p4.x); v0[2] *= bflo(p4.y); v0[3] *= bfhi(p4.y); v1[0] *= bflo(p4.z); v1[1] *= bfhi(p4.z); v1[2] *= bflo(p4.w); v1[3] *= bfhi(p4.w); }
                        } else { v0 = v0 * alpha; v1 = v1 * alpha; }
                        f32x4 o0, o1;
                        if (xr) { o0 = xv[mi][bj][0]; o1 = xv[mi][bj][1]; }
                        else { const u32x4 h4 = __builtin_bit_cast(u32x4, xv[mi][bj][0]); o0 = (f32x4){bflo(h4.x), bfhi(h4.x), bflo(h4.y), bfhi(h4.y)}; o1 = (f32x4){bflo(h4.z), bfhi(h4.z), bflo(h4.w), bfhi(h4.w)}; }
                        const f32x4 x0 = o0 + v0, x1 = o1 + v1;
                        u32x4 w; w.x = pk2(x0[0], x0[1]); w.y = pk2(x0[2], x0[3]); w.z = pk2(x1[0], x1[1]); w.w = pk2(x1[2], x1[3]);
                        *(u32x4*)(xb + off) = w;
                        float ssum = (x0[0] * x0[0] + x0[1] * x0[1]) + (x0[2] * x0[2] + x0[3] * x0[3]) + (x1[0] * x1[0] + x1[1] * x1[1]) + (x1[2] * x1[2] + x1[3] * x1[3]);
                        ssum += __shfl_xor(ssum, 16); ssum += __shfl_xor(ssum, 32);
                        if (fq == 0) ss_out[(size_t)row * 32 + u.pn * 8 + bj * 4 + wc] = ssum;
                    }
                }
                EPI_FENCE();
            }
        }
    }
};
struct EpiBranch {
    const bf16_t* proj; bf16_t* scr; bf16_t* merged; int mode;
    template <int BR>
    __device__ __forceinline__ void run(const f32x4 (&acc)[2][2][4][2], const Unit& u, int wr, int wc, int fr, int fq) const {
        const int row0 = u.pm * 256 + wr * 64 + fr, colb = u.pn * 256 + wc * 32 + 8 * fq;
#pragma unroll
        for (int ai = 0; ai < 2; ++ai) {
            if (!((u.qm >> (2 * ai)) & 3)) continue;
#pragma unroll
            for (int mp = 0; mp < 1; ++mp) {
                u32x4 gt[4][2], sv[4][2];
#pragma unroll
                for (int mi = 0; mi < 4; ++mi)
#pragma unroll
                    for (int bj = 0; bj < 2; ++bj) {
                        const int row = row0 + ai * 128 + mi * 16, col = colb + bj * 128; const size_t off = (size_t)row * D + col;
                        if (BR < 3) gt[mi][bj] = *(const u32x4*)(proj + (size_t)row * PW + C_G + BR * 1024 + col);
                        if (BR == 1 || BR == 2) sv[mi][bj] = *(const u32x4*)(scr + off);
                    }
#pragma unroll
                for (int mi = 0; mi < 4; ++mi)
#pragma unroll
                    for (int bj = 0; bj < 2; ++bj) {
                        if (!((u.qm >> (ai * 2 + bj)) & 1)) continue;
                        const int m = mi, row = row0 + ai * 128 + m * 16, col = colb + bj * 128; const size_t off = (size_t)row * D + col;
                        f32x4 v0 = acc[ai][bj][m][0], v1 = acc[ai][bj][m][1];
                        if (BR < 3) { const u32x4 g4 = gt[mi][bj];
                            v0[0] *= bflo(g4.x); v0[1] *= bfhi(g4.x); v0[2] *= bflo(g4.y); v0[3] *= bfhi(g4.y);
                            v1[0] *= bflo(g4.z); v1[1] *= bfhi(g4.z); v1[2] *= bflo(g4.w); v1[3] *= bfhi(g4.w); }
                        if (BR == 1 || BR == 2) { const u32x4 p4 = sv[mi][bj]; v0[0] += bflo(p4.x); v0[1] += bfhi(p4.x); v0[2] += bflo(p4.y); v0[3] += bfhi(p4.y); v1[0] += bflo(p4.z); v1[1] += bfhi(p4.z); v1[2] += bflo(p4.w); v1[3] += bfhi(p4.w); }
                        { u32x4 w; w.x = pk2(v0[0], v0[1]); w.y = pk2(v0[2], v0[3]); w.z = pk2(v1[0], v1[1]); w.w = pk2(v1[2], v1[3]); *(u32x4*)((BR == 2 ? merged : scr) + off) = w; }
                    }
                EPI_FENCE();
            }
        }
    }
    __device__ __forceinline__ void operator()(const f32x4 (&acc)[2][2][4][2], const Unit& u, int wr, int wc, int fr, int fq, const LAS float* rt) const {
        if (mode == 1) run<3>(acc, u, wr, wc, fr, fq);
        else if (u.kind == 0) run<0>(acc, u, wr, wc, fr, fq);
        else if (u.kind == 1) run<1>(acc, u, wr, wc, fr, fq);
        else run<2>(acc, u, wr, wc, fr, fq);
    }
};

struct Args { const float* in[29]; float* out; unsigned char* ws; int ph_lo, ph_hi; };
constexpr int NPH = 26;
constexpr int LDS_BYTES = 147456;

struct Ctx {
    const float* const* in; float* out; unsigned char* ws; LAS unsigned char* lds; unsigned char* ldsg; int tid, lane, wave, G, bx;
};

enum { MAP_ID = 0, MAP_SWIGLU = 1, MAP_WIN = 2 };
__device__ __forceinline__ int map_col(int mode, int n) {
    if (mode == MAP_ID) return n;
    if (mode == MAP_SWIGLU) { const int p = n >> 8, j = n & 255; return j < 128 ? p * 128 + j : FF + p * 128 + (j - 128); }
    if (n < 2048) return n;
    if (n < 2304) return 2064 + (n - 2048);
    if (n < 2560) return 2320 + (n - 2304);
    if (n < 5632) return 2576 + (n - 2560);
    if (n < 5648) return 2048 + (n - 5632);
    return -1;
}
__device__ __forceinline__ void tconv(const Ctx& c, const float* src, int ldsrc, int K, bf16_t* dst, int lddst, int Nout, int mode, const float* g, int& toff) {
    float* tile = (float*)c.ldsg;
    const int ntn = Nout / 64, ntk = K / 256, nt = ntn * ntk;
    const int first = (c.bx + c.G - (toff % c.G)) % c.G; toff += nt;
    for (int it = first; it < nt; it += c.G) {
        const int tn = it % ntn, tk = it / ntn, n0 = tn * 64, k0 = tk * 256;
        const int nn = c.tid & 63, sc = map_col(mode, n0 + nn), kq = c.tid >> 6;
        float v[32];
#pragma unroll
        for (int i = 0; i < 32; ++i) { const int kk = kq + 8 * i; v[i] = (sc >= 0) ? src[(size_t)(k0 + kk) * ldsrc + sc] : 0.f; }
        if (g) {
#pragma unroll
            for (int i = 0; i < 32; ++i) v[i] *= g[k0 + kq + 8 * i];
        }
#pragma unroll
        for (int i = 0; i < 32; ++i) tile[(kq + 8 * i) * 65 + nn] = v[i];
        __syncthreads();
        { const int n2 = c.tid >> 3, kg = c.tid & 7;
#pragma unroll
          for (int j = 0; j < 4; ++j) { const float* s = tile + (kg * 8 + 64 * j) * 65 + n2;
              u32x4 o; o.x = pk2(s[0], s[65]); o.y = pk2(s[130], s[195]); o.z = pk2(s[260], s[325]); o.w = pk2(s[390], s[455]);
              *(u32x4*)(dst + (size_t)(n0 + n2) * lddst + k0 + kg * 8 + 64 * j) = o; } }
        __syncthreads();
    }
}
__device__ __forceinline__ float wave_sum(float v) {
#pragma unroll
    for (int o = 1; o < 64; o <<= 1) v += __shfl_xor(v, o);
    return v;
}
__device__ __forceinline__ void prologue(const Ctx& c) {
    bf16_t* W = (bf16_t*)(c.ws + WS_W);
    int toff = 0;
    for (int l = 0; l < 2; ++l) {
        bf16_t* Wl = W + (size_t)l * WL_END;
        tconv(c, c.in[9] + (size_t)l * D * 2 * FF, 2 * FF, D, Wl + WL_1IN, D, 2 * FF, MAP_SWIGLU, c.in[8] + l * D, toff);
        tconv(c, c.in[10] + (size_t)l * FF * D, D, FF, Wl + WL_1OUT, FF, D, MAP_ID, nullptr, toff);
        tconv(c, c.in[12] + (size_t)l * D * INW, INW, D, Wl + WL_IN, D, NIN, MAP_WIN, c.in[11] + l * D, toff);
        tconv(c, c.in[18] + (size_t)l * 512 * D, D, 512, Wl + WL_BR, D, D, MAP_ID, nullptr, toff);
        tconv(c, c.in[19] + (size_t)l * 256 * D, D, 256, Wl + WL_BR + 512, D, D, MAP_ID, nullptr, toff);
        tconv(c, c.in[21] + (size_t)l * D * D, D, D, Wl + WL_OUT, D, D, MAP_ID, nullptr, toff);
        tconv(c, c.in[23] + (size_t)l * D * 2 * FF, 2 * FF, D, Wl + WL_2IN, D, 2 * FF, MAP_SWIGLU, c.in[22] + l * D, toff);
        tconv(c, c.in[24] + (size_t)l * FF * D, D, FF, Wl + WL_2OUT, FF, D, MAP_ID, nullptr, toff);
        tconv(c, c.in[26] + (size_t)l * D * D, D, D, Wl + WL_PG, D, D, MAP_ID, c.in[25] + l * D, toff);
        tconv(c, c.in[27] + (size_t)l * 256 * D, D, 256, Wl + WL_PP, 256, D, MAP_ID, nullptr, toff);
        const float* pw = c.in[16] + (size_t)l * 4 * 64 * 64; const float* psc = c.in[17] + l * 256; const float* wc = c.in[20] + (size_t)l * 256 * D;
        for (int idx = c.bx * 512 + c.tid; idx < 256 * 1024; idx += c.G * 512) {
            const int n = idx & 1023, kc = idx >> 10, gq = kc >> 6, cc = kc & 63; float s = 0.f;
#pragma unroll 8
            for (int dd = 0; dd < 64; ++dd) s += pw[(gq * 64 + cc) * 64 + dd] * psc[gq * 64 + dd] * wc[(size_t)(gq * 64 + dd) * D + n];
            Wl[WL_BR + (size_t)n * D + 768 + kc] = (bf16_t)f2bf(s);
        }
    }
    bf16_t* xb = (bf16_t*)(c.ws + WS_XB); float* ss0 = (float*)(c.ws + WS_SS);
    for (int row2 = (c.bx * 8 + c.wave) * 2; row2 < M; row2 += c.G * 16) {
        f32x4 v[2][4]; float s[2] = {0.f, 0.f};
#pragma unroll
        for (int r = 0; r < 2; ++r) { const int row = row2 + r; const float* src = row < MP ? c.in[0] + (size_t)row * D : c.in[1] + (size_t)(row - MP) * D;
#pragma unroll
            for (int j = 0; j < 4; ++j) v[r][j] = *(const f32x4*)(src + c.lane * 4 + 256 * j); }
#pragma unroll
        for (int r = 0; r < 2; ++r) {
#pragma unroll
            for (int j = 0; j < 4; ++j) s[r] += (v[r][j][0] * v[r][j][0] + v[r][j][1] * v[r][j][1]) + (v[r][j][2] * v[r][j][2] + v[r][j][3] * v[r][j][3]); }
#pragma unroll
        for (int o = 1; o < 64; o <<= 1) { s[0] += __shfl_xor(s[0], o); s[1] += __shfl_xor(s[1], o); }
#pragma unroll
        for (int r = 0; r < 2; ++r) { const int row = row2 + r;
#pragma unroll
            for (int j = 0; j < 4; ++j) { u32x2 w; w.x = pk2(v[r][j][0], v[r][j][1]); w.y = pk2(v[r][j][2], v[r][j][3]); *(u32x2*)(xb + (size_t)row * D + c.lane * 4 + 256 * j) = w; }
            if (c.lane < 32) ss0[(size_t)row * 32 + c.lane] = c.lane == 0 ? s[r] : 0.f; }
    }
    bf16_t* pb = (bf16_t*)(c.ws + WS_PB);
#pragma unroll 4
    for (size_t i4 = (size_t)c.bx * 512 + c.tid; i4 < (size_t)2 * M * 64; i4 += (size_t)c.G * 512) {
        const size_t e = i4 * 4; const int l = (int)(e / ((size_t)M * 256)); const size_t r = e - (size_t)l * M * 256; const int row = (int)(r >> 8), cc = (int)(r & 255);
        const float* src = row < MP ? c.in[6] + ((size_t)l * MP + row) * 256 + cc : c.in[7] + ((size_t)l * 2048 + (row - MP)) * 256 + cc;
        const f32x4 v = *(const f32x4*)src; u32x2 w; w.x = pk2(v[0], v[1]); w.y = pk2(v[2], v[3]); *(u32x2*)(pb + e) = w;
    }
}

__device__ __forceinline__ int next_item(const Ctx& c, int slot) {
    volatile int* sh = (volatile int*)(c.ldsg + 147392);
    __syncthreads();
    if (c.tid == 0) *sh = (int)__hip_atomic_fetch_add((unsigned*)(c.ws + WS_CTL) + 64 * (1 + slot), 1u, __ATOMIC_RELAXED, __HIP_MEMORY_SCOPE_AGENT);
    __syncthreads();
    return *sh;
}
__device__ __forceinline__ void gla_local_unit(const Ctx& c, int l, int g, int h) {
    float* L = (float*)c.ldsg; float* rs = L; float* wg = L + 1024; float* bg = L + 1536; float* la = L + 1600;
    bf16_t* KtT = (bf16_t*)(c.ldsg + 14848); bf16_t* Vt = KtT + 2304;
    const bf16_t* proj = (const bf16_t*)(c.ws + WS_BIG); const int m0 = g * 64, tid = c.tid;
    { const int e = tid * 2, row = e >> 4, cc = e & 15; const unsigned w = *(const unsigned*)(proj + (size_t)(m0 + row) * PW + C_RB + cc); rs[e] = bflo(w); rs[e + 1] = bfhi(w); }
    { const int j = tid >> 5, d = tid & 31; wg[tid] = c.in[13][(size_t)(l * 16 + j) * 128 + h * 32 + d]; }
    if (tid < 32) bg[tid] = c.in[14][l * 128 + h * 32 + tid];
    bf16_t kraw[4];
#pragma unroll
    for (int i = 0; i < 4; ++i) { const int o = tid + 512 * i, t = o >> 5, d = o & 31; kraw[i] = proj[(size_t)(m0 + t) * PW + C_KB + h * 32 + d]; }
    const u32x4 vraw = *(const u32x4*)(proj + (size_t)(m0 + (tid >> 3)) * PW + C_VB + h * 64 + (tid & 7) * 8);
    __syncthreads();
#pragma unroll
    for (int i = 0; i < 4; ++i) { const int o = tid + 512 * i, t = o >> 5, d = o & 31; float a = bg[d];
#pragma unroll
        for (int j = 0; j < 16; ++j) a += rs[t * 16 + j] * wg[j * 32 + d];
        la[t * 33 + d] = (fminf(a, 0.f) - flog(1.0f + fexp(-fabsf(a)))) * (1.0f / 16.0f); }
    __syncthreads();
    {
#pragma unroll
        for (int j = 0; j < 4; ++j) { const int d = c.wave * 4 + j; float v = la[c.lane * 33 + d];
#pragma unroll
            for (int o = 1; o < 64; o <<= 1) { const float n = __shfl_up(v, o); if (c.lane >= o) v += n; }
            la[c.lane * 33 + d] = v; }
    }
    __syncthreads();
    float* bws = (float*)(c.ws + WS_B);
#pragma unroll
    for (int i = 0; i < 4; ++i) { const int o = tid + 512 * i, t = o >> 5, d = o & 31; const float b = la[t * 33 + d];
        bws[(size_t)(m0 + t) * 128 + h * 32 + d] = b;
        KtT[d * 72 + t] = (bf16_t)f2bf(bf2f(kraw[i]) * fexp(-b)); }
    { const int t = tid >> 3, e0 = (tid & 7) * 8; const unsigned vw[4] = {vraw.x, vraw.y, vraw.z, vraw.w};
#pragma unroll
      for (int i = 0; i < 4; ++i) { Vt[(e0 + 2 * i) * 72 + t] = (bf16_t)(vw[i] & 0xffffu); Vt[(e0 + 2 * i + 1) * 72 + t] = (bf16_t)(vw[i] >> 16); } }
    if (tid < 32) ((float*)(c.ws + WS_DEC))[(size_t)(g * 4 + h) * 32 + tid] = fexp(la[63 * 33 + tid]);
    __syncthreads();
    { const int w = c.wave, lane = c.lane, fr = lane & 15, fq = lane >> 4, db = w >> 2, eb = w & 3;
      f32x4 acc = {0.f, 0.f, 0.f, 0.f};
#pragma unroll
      for (int k2 = 0; k2 < 2; ++k2) { const bf16x8 kf = *(const bf16x8*)(KtT + (16 * db + fr) * 72 + 32 * k2 + 8 * fq), vf = *(const bf16x8*)(Vt + (16 * eb + fr) * 72 + 32 * k2 + 8 * fq);
          acc = __builtin_amdgcn_mfma_f32_16x16x32_bf16(kf, vf, acc, 0, 0, 0); }
      float* dst = (float*)(c.ws + WS_DS) + (size_t)(g * 4 + h) * 2048 + (16 * db + 4 * fq) * 64 + 16 * eb + fr;
#pragma unroll
      for (int i = 0; i < 4; ++i) dst[i * 64] = acc[i]; }
    __syncthreads();
}
__device__ __forceinline__ void pool_unit(const Ctx& c, int l, int g) {
    float* ext = (float*)c.ldsg;
    const bf16_t* proj = (const bf16_t*)(c.ws + WS_BIG); bf16_t* Y = (bf16_t*)(c.ws + WS_Y);
    const int m0 = g * 64, tid = c.tid; const bool samp = g >= 512; const int cidx = samp ? 0 : (g & 127);
#pragma unroll
    for (int it = 0; it < 5; ++it) { const int q = tid + 512 * it;
        if (q < 79 * 32) { const int j = q >> 5, c8 = (q & 31) * 8; float* d = ext + j * 256 + c8;
            if (j >= 15 || cidx > 0) { const u32x4 w = *(const u32x4*)(proj + (size_t)(m0 + j - 15) * PW + C_UC + c8);
                *(f32x4*)d = (f32x4){bflo(w.x), bfhi(w.x), bflo(w.y), bfhi(w.y)}; *(f32x4*)(d + 4) = (f32x4){bflo(w.z), bfhi(w.z), bflo(w.w), bfhi(w.w)}; }
            else if (samp) { const float* sp = c.in[5] + ((size_t)(l * 32 + (g - 512)) * 15 + j) * 256 + c8; *(f32x4*)d = *(const f32x4*)sp; *(f32x4*)(d + 4) = *(const f32x4*)(sp + 4); }
            else { *(f32x4*)d = (f32x4){0.f, 0.f, 0.f, 0.f}; *(f32x4*)(d + 4) = (f32x4){0.f, 0.f, 0.f, 0.f}; } } }
    __syncthreads();
    { const int cc = tid & 255, ts = tid >> 8, gi = cc >> 6, w = 2 << gi;
      float s = 0.f;
      for (int j = 1; j < w; ++j) s += ext[(15 + ts * 32 - j) * 256 + cc];
      for (int i = 0; i < 32; ++i) { const int t = ts * 32 + i; s += ext[(15 + t) * 256 + cc];
          const int pos = samp ? 2048 + t : cidx * 64 + t; const float cnt = (float)min(w, pos + 1);
          const float dv = s / cnt - ext[(15 + t) * 256 + cc];
          Y[(size_t)(m0 + t) * D + 768 + cc] = (bf16_t)f2bf(dv); s -= ext[(15 + t - w + 1) * 256 + cc]; } }
    __syncthreads();
}

__device__ __forceinline__ void scan_unit(const Ctx& c, int l, int su) {
    const float* dS = (const float*)(c.ws + WS_DS); const float* dec = (const float*)(c.ws + WS_DEC); float* St = (float*)(c.ws + WS_ST);
    int g0, n, h, idx; float S; float* outp;
    if (su < 64) { const int bh = su >> 2, b = bh >> 2; h = bh & 3; idx = (su & 3) * 512 + c.tid; g0 = b * 128; n = 128; S = 0.f; outp = c.out + O_GP + ((size_t)(l * 4 + b) * 4 + h) * 2048 + idx; }
    else { const int s2 = su - 64, sbh = s2 >> 2, sb = sbh >> 2; h = sbh & 3; idx = (s2 & 3) * 512 + c.tid; g0 = 512 + sb; n = 1; S = c.in[4][((size_t)(l * 32 + sb) * 4 + h) * 2048 + idx]; outp = c.out + O_GS + ((size_t)(l * 32 + sb) * 4 + h) * 2048 + idx; }
    const int d = idx >> 6;
#pragma unroll 8
    for (int cc = 0; cc < n; ++cc) { const size_t gh = (size_t)(g0 + cc) * 4 + h; const float dd = dS[gh * 2048 + idx], de = dec[gh * 32 + d]; St[gh * 2048 + idx] = S; S = de * (S + dd); }
    *outp = S;
}
__device__ __forceinline__ void attn_unit(const Ctx& c, int l, int au) {
    bf16_t* Ks = (bf16_t*)c.ldsg; bf16_t* Vt = (bf16_t*)(c.ldsg + 18432); int* flags = (int*)(c.ldsg + 35840);
    const bf16_t* proj = (const bf16_t*)(c.ws + WS_BIG); bf16_t* Y = (bf16_t*)(c.ws + WS_Y);
    int R0, n_past, qb, hp, sb = 0;
    if (au < 2048) { const int b = au >> 9, rem = au & 511; qb = rem >> 2; hp = rem & 3; R0 = b * 8192; n_past = 0; }
    else { const int a2 = au - 2048; sb = a2 >> 2; hp = a2 & 3; qb = 0; R0 = MP + sb * 64; n_past = 2048; }
    const int tid = c.tid, w = c.wave, lane = c.lane, fr = lane & 15, fq = lane >> 4, hsel = w >> 2, hh = 2 * hp + hsel, qsub = w & 3;
    const int qrow = R0 + qb * 64 + qsub * 16 + fr, qpos = n_past + qb * 64 + qsub * 16 + fr;
    bf16x8 qf[2];
#pragma unroll
    for (int ks = 0; ks < 2; ++ks) qf[ks] = *(const bf16x8*)(proj + (size_t)qrow * PW + C_QA + hh * 64 + 32 * ks + 8 * fq);
    f32x4 O[4];
#pragma unroll
    for (int i = 0; i < 4; ++i) O[i] = (f32x4){0.f, 0.f, 0.f, 0.f};
    float carry = 0.f; bool wdone = false;
    int kt = (n_past + qb * 64) >> 6;
    const int lh = tid >> 8, lj = (tid >> 2) & 63, d0 = (tid & 3) * 16, lhead = 2 * hp + lh;
    for (;;) {
        {
            const int kpos = kt * 64 + lj; unsigned kk[8], vv[8];
            if (kpos < n_past) {
                const size_t o = (((size_t)(l * 32 + sb) * 2048 + kpos) * 512) + lhead * 64 + d0; const float* kp = c.in[2] + o; const float* vp = c.in[3] + o;
#pragma unroll
                for (int i = 0; i < 4; ++i) { const f32x4 a = *(const f32x4*)(kp + 4 * i), b = *(const f32x4*)(vp + 4 * i); kk[2 * i] = pk2(a[0], a[1]); kk[2 * i + 1] = pk2(a[2], a[3]); vv[2 * i] = pk2(b[0], b[1]); vv[2 * i + 1] = pk2(b[2], b[3]); }
            } else {
                const bf16_t* rp = proj + (size_t)(R0 + kpos - n_past) * PW + lhead * 64 + d0;
                const u32x4 a0 = *(const u32x4*)(rp + C_KA), a1 = *(const u32x4*)(rp + C_KA + 8), b0 = *(const u32x4*)(rp + C_VA), b1 = *(const u32x4*)(rp + C_VA + 8);
                kk[0] = a0.x; kk[1] = a0.y; kk[2] = a0.z; kk[3] = a0.w; kk[4] = a1.x; kk[5] = a1.y; kk[6] = a1.z; kk[7] = a1.w;
                vv[0] = b0.x; vv[1] = b0.y; vv[2] = b0.z; vv[3] = b0.w; vv[4] = b1.x; vv[5] = b1.y; vv[6] = b1.z; vv[7] = b1.w;
            }
            bf16_t* kd = Ks + (lh * 64 + lj) * 72 + d0;
            *(u32x4*)kd = (u32x4){kk[0], kk[1], kk[2], kk[3]}; *(u32x4*)(kd + 8) = (u32x4){kk[4], kk[5], kk[6], kk[7]};
#pragma unroll
            for (int i = 0; i < 8; ++i) { Vt[(lh * 64 + d0 + 2 * i) * 68 + lj] = (bf16_t)(vv[i] & 0xffffu); Vt[(lh * 64 + d0 + 2 * i + 1) * 68 + lj] = (bf16_t)(vv[i] >> 16); }
        }
        __syncthreads();
        {
            f32x4 sa[4];
#pragma unroll
            for (int u = 0; u < 4; ++u) { sa[u] = (f32x4){0.f, 0.f, 0.f, 0.f};
#pragma unroll
                for (int ks = 0; ks < 2; ++ks) { const bf16x8 kf = *(const bf16x8*)(Ks + (hsel * 64 + 16 * u + fr) * 72 + 32 * ks + 8 * fq); sa[u] = __builtin_amdgcn_mfma_f32_16x16x32_bf16(kf, qf[ks], sa[u], 0, 0, 0); } }
            float lk[4][4], lw[4][4], ls[4], suf[4], T[4];
#pragma unroll
            for (int u = 0; u < 4; ++u) { ls[u] = 0.f;
#pragma unroll
                for (int i = 0; i < 4; ++i) { const float z = sa[u][i] * 0.125f; const int kpos = kt * 64 + 16 * u + 4 * fq + i; const bool valid = kpos < qpos;
                    const float sp = softplus(z); lk[u][i] = valid ? -sp : 0.f; lw[u][i] = valid ? (z - sp) : -1e30f; ls[u] += lk[u][i]; } }
#pragma unroll
            for (int u = 0; u < 4; ++u) { const float a = __shfl_xor(ls[u], 16), t1 = ls[u] + a, o = __shfl_xor(t1, 32); T[u] = t1 + o; suf[u] = ((fq & 1) ? 0.f : a) + ((fq & 2) ? 0.f : o); }
            float base = carry; float wv[4][4];
#pragma unroll
            for (int u = 3; u >= 0; --u) { float run = base + suf[u];
#pragma unroll
                for (int i = 3; i >= 0; --i) { wv[u][i] = fexp(lw[u][i] + run); run += lk[u][i]; }
                base += T[u]; }
            carry = base;
#pragma unroll
            for (int k2 = 0; k2 < 2; ++k2) {
                u32x4 pw; pw.x = pk2(wv[2 * k2][0], wv[2 * k2][1]); pw.y = pk2(wv[2 * k2][2], wv[2 * k2][3]); pw.z = pk2(wv[2 * k2 + 1][0], wv[2 * k2 + 1][1]); pw.w = pk2(wv[2 * k2 + 1][2], wv[2 * k2 + 1][3]);
                const bf16x8 pf = __builtin_bit_cast(bf16x8, pw);
#pragma unroll
                for (int db = 0; db < 4; ++db) { const bf16_t* vp = Vt + (hsel * 64 + 16 * db + fr) * 68 + 32 * k2 + 4 * fq; const u32x2 lo = *(const u32x2*)vp, hi = *(const u32x2*)(vp + 16);
                    const bf16x8 vf = __builtin_bit_cast(bf16x8, (u32x4){lo.x, lo.y, hi.x, hi.y}); O[db] = __builtin_amdgcn_mfma_f32_16x16x32_bf16(vf, pf, O[db], 0, 0, 0); }
            }
            wdone = __all(carry < -46.f) != 0;
        }
        --kt;
        if (lane == 0) flags[w] = wdone ? 1 : 0;
        __syncthreads();
        int alld = 1;
#pragma unroll
        for (int i = 0; i < 8; ++i) alld &= flags[i];
        if (alld || kt < 0) break;
    }
#pragma unroll
    for (int db = 0; db < 4; ++db) { u32x2 o; o.x = pk2(O[db][0], O[db][1]); o.y = pk2(O[db][2], O[db][3]); *(u32x2*)(Y + (size_t)qrow * D + hh * 64 + 16 * db + 4 * fq) = o; }
    __syncthreads();
}

__device__ __forceinline__ void gla_out_unit(const Ctx& c, int l, int g, int h) {
    bf16_t* Qs = (bf16_t*)c.ldsg; bf16_t* Ks = Qs + 2560; bf16_t* Vt = Ks + 2560; bf16_t* ST = Vt + 4608; float* red = (float*)(ST + 2560);
    const bf16_t* proj = (const bf16_t*)(c.ws + WS_BIG); bf16_t* Y = (bf16_t*)(c.ws + WS_Y); const float* bws = (const float*)(c.ws + WS_B);
    const int m0 = g * 64, tid = c.tid, w = c.wave, lane = c.lane, fr = lane & 15, fq = lane >> 4;
    {
        const int t = tid >> 3, d0 = (tid & 7) * 4, e0 = (tid & 7) * 8;
        const f32x4 b4 = *(const f32x4*)(bws + (size_t)(m0 + t) * 128 + h * 32 + d0);
        const u32x2 q2 = *(const u32x2*)(proj + (size_t)(m0 + t) * PW + C_QB + h * 32 + d0), k2 = *(const u32x2*)(proj + (size_t)(m0 + t) * PW + C_KB + h * 32 + d0);
        const u32x4 v4 = *(const u32x4*)(proj + (size_t)(m0 + t) * PW + C_VB + h * 64 + e0);
        const int sd = tid >> 4, se0 = (tid & 15) * 4;
        const f32x4 s4 = *(const f32x4*)((const float*)(c.ws + WS_ST) + (size_t)(g * 4 + h) * 2048 + sd * 64 + se0);
        const float qv[4] = {bflo(q2.x), bfhi(q2.x), bflo(q2.y), bfhi(q2.y)}, kv[4] = {bflo(k2.x), bfhi(k2.x), bflo(k2.y), bfhi(k2.y)};
        float qo[4], ko[4];
#pragma unroll
        for (int i = 0; i < 4; ++i) { qo[i] = qv[i] * 0.17677669529663687f * fexp(b4[i]); ko[i] = kv[i] * fexp(-b4[i]); }
        *(u32x2*)(Qs + t * 40 + d0) = (u32x2){pk2(qo[0], qo[1]), pk2(qo[2], qo[3])};
        *(u32x2*)(Ks + t * 40 + d0) = (u32x2){pk2(ko[0], ko[1]), pk2(ko[2], ko[3])};
        const unsigned vw[4] = {v4.x, v4.y, v4.z, v4.w};
#pragma unroll
        for (int i = 0; i < 4; ++i) { Vt[(e0 + 2 * i) * 72 + t] = (bf16_t)(vw[i] & 0xffffu); Vt[(e0 + 2 * i + 1) * 72 + t] = (bf16_t)(vw[i] >> 16); }
#pragma unroll
        for (int i = 0; i < 4; ++i) ST[(se0 + i) * 40 + sd] = (bf16_t)f2bf(s4[i]);
    }
    const int tb = w & 3, ebase = (w >> 2) * 2, tl = 16 * tb + fr;
    u32x2 owp[2]; f32x4 gnp[2];
#pragma unroll
    for (int eb = 0; eb < 2; ++eb) { const int ecol = h * 64 + 16 * (ebase + eb) + 4 * fq; owp[eb] = *(const u32x2*)(proj + (size_t)(m0 + tl) * PW + C_OB + ecol); gnp[eb] = *(const f32x4*)(c.in[15] + l * 256 + ecol); }
    __syncthreads();
    const bf16x8 qf = *(const bf16x8*)(Qs + tl * 40 + 8 * fq);
    f32x4 sa[4];
#pragma unroll
    for (int u = 0; u < 4; ++u) { sa[u] = (f32x4){0.f, 0.f, 0.f, 0.f};
        if (u <= tb) { const bf16x8 kf = *(const bf16x8*)(Ks + (16 * u + fr) * 40 + 8 * fq); sa[u] = __builtin_amdgcn_mfma_f32_16x16x32_bf16(kf, qf, sa[u], 0, 0, 0);
            if (u == tb) {
#pragma unroll
                for (int i = 0; i < 4; ++i) sa[u][i] = (4 * fq + i <= fr) ? sa[u][i] : 0.f; } } }
    f32x4 O[2];
#pragma unroll
    for (int eb = 0; eb < 2; ++eb) {
        const int erow = 16 * (ebase + eb) + fr;
        const bf16x8 stf = *(const bf16x8*)(ST + erow * 40 + 8 * fq);
        O[eb] = __builtin_amdgcn_mfma_f32_16x16x32_bf16(stf, qf, (f32x4){0.f, 0.f, 0.f, 0.f}, 0, 0, 0);
#pragma unroll
        for (int k2 = 0; k2 < 2; ++k2) {
            if (2 * k2 <= tb) {
                u32x4 pw; pw.x = pk2(sa[2 * k2][0], sa[2 * k2][1]); pw.y = pk2(sa[2 * k2][2], sa[2 * k2][3]); pw.z = pk2(sa[2 * k2 + 1][0], sa[2 * k2 + 1][1]); pw.w = pk2(sa[2 * k2 + 1][2], sa[2 * k2 + 1][3]);
                const bf16_t* vp = Vt + erow * 72 + 32 * k2 + 4 * fq; const u32x2 lo = *(const u32x2*)vp, hi = *(const u32x2*)(vp + 16);
                O[eb] = __builtin_amdgcn_mfma_f32_16x16x32_bf16(__builtin_bit_cast(bf16x8, (u32x4){lo.x, lo.y, hi.x, hi.y}), __builtin_bit_cast(bf16x8, pw), O[eb], 0, 0, 0);
            }
        }
    }
    float q2s = 0.f;
#pragma unroll
    for (int eb = 0; eb < 2; ++eb)
#pragma unroll
        for (int i = 0; i < 4; ++i) q2s += O[eb][i] * O[eb][i];
    q2s += __shfl_xor(q2s, 16); q2s += __shfl_xor(q2s, 32);
    if (fq == 0) red[w * 16 + fr] = q2s;
    __syncthreads();
    const float r = __builtin_amdgcn_rsqf((red[w * 16 + fr] + red[(w ^ 4) * 16 + fr]) * (1.0f / 64.0f) + EPS);
#pragma unroll
    for (int eb = 0; eb < 2; ++eb) {
        const int ecol = h * 64 + 16 * (ebase + eb) + 4 * fq;
        const u32x2 ow = owp[eb]; const f32x4 gn = gnp[eb];
        const float ob[4] = {bflo(ow.x), bfhi(ow.x), bflo(ow.y), bfhi(ow.y)}; float y[4];
#pragma unroll
        for (int i = 0; i < 4; ++i) y[i] = O[eb][i] * r * gn[i] * (ob[i] * sigm(ob[i]));
        *(u32x2*)(Y + (size_t)(m0 + tl) * D + 512 + ecol) = (u32x2){pk2(y[0], y[1]), pk2(y[2], y[3])};
    }
    __syncthreads();
}

__device__ __forceinline__ void grid_bar(unsigned* ctl, unsigned r) {
    asm volatile("s_waitcnt vmcnt(0)" ::: "memory");
    __syncthreads();
    if (threadIdx.x == 0) {
        const unsigned g = blockIdx.x & 7u, G = gridDim.x, nloc = (G - g + 7u) >> 3, ngrp = G < 8u ? G : 8u;
        unsigned* cnt = ctl + 64 * (16 + g); unsigned* gen = ctl + 64 * (24 + g); unsigned* top = ctl + 64 * 32;
        __builtin_amdgcn_fence(__ATOMIC_RELEASE, "agent");
        asm volatile("s_waitcnt vmcnt(0)" ::: "memory");
        const unsigned old = __hip_atomic_fetch_add(cnt, 1u, __ATOMIC_RELAXED, __HIP_MEMORY_SCOPE_AGENT);
        if (old + 1u == r * nloc) {
            __hip_atomic_fetch_add(top, 1u, __ATOMIC_RELAXED, __HIP_MEMORY_SCOPE_AGENT);
            while (__hip_atomic_load(top, __ATOMIC_RELAXED, __HIP_MEMORY_SCOPE_AGENT) < r * ngrp) __builtin_amdgcn_s_sleep(1);
            __hip_atomic_store(gen, r, __ATOMIC_RELAXED, __HIP_MEMORY_SCOPE_AGENT);
        } else {
            while (__hip_atomic_load(gen, __ATOMIC_RELAXED, __HIP_MEMORY_SCOPE_AGENT) < r) __builtin_amdgcn_s_sleep(1);
        }
        __builtin_amdgcn_fence(__ATOMIC_ACQUIRE, "agent");
        asm volatile("s_waitcnt vmcnt(0)" ::: "memory");
    }
    __syncthreads();
}

__global__ void __launch_bounds__(512, 2) fwd_mega(Args args) {
    extern __shared__ __attribute__((aligned(16))) unsigned char lds[];
    cg::grid_group grid = cg::this_grid();
    Ctx c; c.in = args.in; c.out = args.out; c.ws = args.ws; c.lds = (LAS unsigned char*)lds; c.ldsg = lds;
    c.tid = threadIdx.x; c.lane = c.tid & 63; c.wave = __builtin_amdgcn_readfirstlane(c.tid >> 6); c.G = gridDim.x; c.bx = blockIdx.x;
    for (int ph = args.ph_lo; ph < args.ph_hi; ++ph) {
        { int t_ = threadIdx.x; asm volatile("" : "+v"(t_)); c.tid = t_; c.lane = t_ & 63; c.wave = __builtin_amdgcn_readfirstlane(t_ >> 6); }
        unsigned char* ws = args.ws; float* outp = args.out; asm volatile("" : "+s"(ws), "+s"(outp)); c.ws = ws; c.out = outp;
        bf16_t* xb = (bf16_t*)(ws + WS_XB); bf16_t* big = (bf16_t*)(ws + WS_BIG); bf16_t* Yb = (bf16_t*)(ws + WS_Y); bf16_t* mg = (bf16_t*)(ws + WS_MG);
        float* scr = (float*)(ws + WS_SCR); float* ss0 = (float*)(ws + WS_SS); float* ss1 = ss0 + (size_t)M * 32; float* xw = outp + O_Y;
        if (ph == 0) prologue(c);
        else if (ph == 25) {
            const float* gf = args.in[28];
            for (int row = c.bx * 8 + c.wave; row < M; row += c.G * 8) { const float rs = rstd_of(ss0, row);
#pragma unroll
                for (int j = 0; j < 4; ++j) { const u32x2 h2 = *(const u32x2*)(mg + (size_t)row * D + c.lane * 4 + 256 * j); const f32x4 v = {bflo(h2.x), bfhi(h2.x), bflo(h2.y), bfhi(h2.y)}, gg = *(const f32x4*)(gf + c.lane * 4 + 256 * j);
                    *(f32x4*)(xw + (size_t)row * D + c.lane * 4 + 256 * j) = v * rs * gg; } }
        } else {
            const int l = (ph - 1) / 12, k = (ph - 1) % 12;
            if ((MK_SKIPMASK >> k) & 1) continue;
            const bf16_t* Wl = (const bf16_t*)(ws + WS_W) + (size_t)l * WL_END;
            if (k == 0 || k == 8) {
                pg8::Gemm g{(k == 0 && l > 0) ? mg : xb, Wl + (k == 0 ? WL_1IN : WL_2IN), D, D}; pg8::Sched S;     S.init(M, 2 * FF, c.G, c.bx, 16);
                EpiSwiglu E{big}; pg8::gemm_phase(c.lds, c.tid, g, S, E, ss0);
            } else if (k == 1 || k == 9 || k == 7 || k == 11) {
                pg8::Gemm g; pg8::Sched S; EpiRes E{xb, xb, nullptr, (const bf16_t*)scr, 1.f, 0, nullptr, nullptr}; const float* ssin = nullptr;
                if (k == 1 || k == 9) { g = pg8::Gemm{big, Wl + (k == 1 ? WL_1OUT : WL_2OUT), FF, FF}; S.init(M, D, c.G, c.bx, 44); S.quart = 1; E.alpha = 0.5f; E.ss_out = ss1; if (k == 1) { if (l == 0) { E.xin0 = args.in[0]; E.xin1 = args.in[1]; } else E.xsrc = mg; } }
                else if (k == 7) { g = pg8::Gemm{mg, Wl + WL_OUT, D, D}; S.init(M, D, c.G, c.bx, 16); S.quart = 1; E.ss_out = ss0; }
                else { g = pg8::Gemm{xb, Wl + WL_PG, D, D}; S.init(M, D, c.G, c.bx, 16); S.quart = 1; E.ss_out = ss0; ssin = ss1; E.mode = 1; E.xb = mg; }
                pg8::gemm_phase(c.lds, c.tid, g, S, E, ssin);
            } else if (k == 2) {
                pg8::Gemm g{xb, Wl + WL_IN, D, D}; pg8::Sched S; S.init(M, NIN, c.G, c.bx, 16); S.quart = 1;
                EpiWin E{big, outp, l}; pg8::gemm_phase(c.lds, c.tid, g, S, E, ss1);
            } else if (k == 3) {
                for (int it = next_item(c, l * 3 + 0); it < 2176 + NCH; it = next_item(c, l * 3 + 0)) { if (it < NCH) pool_unit(c, l, it); else gla_local_unit(c, l, (it - NCH) >> 2, (it - NCH) & 3); }
            } else if (k == 4) {
                for (int it = next_item(c, l * 3 + 1); it < 576 + 2176; it = next_item(c, l * 3 + 1)) { if (it < 576) scan_unit(c, l, it); else attn_unit(c, l, it - 576); }
            } else if (k == 5) {
                for (int it = next_item(c, l * 3 + 2); it < 2176; it = next_item(c, l * 3 + 2)) gla_out_unit(c, l, it >> 2, it & 3);
            } else {
                pg8::Gemm g; pg8::Sched S; EpiBranch E{big, (bf16_t*)scr, mg, 0};
                if (k == 6) { g = pg8::Gemm{Yb, Wl + WL_BR, D, D}; S.init(M, D, c.G, c.bx, 8); S.nsub = 3; S.quart = 1; }
                else { g = pg8::Gemm{(const bf16_t*)(ws + WS_PB) + (size_t)l * M * 256, Wl + WL_PP, 256, 256}; S.init(M, D, c.G, c.bx, 4); S.quart = 1; E.mode = 1; }
                pg8::gemm_phase(c.lds, c.tid, g, S, E, nullptr);
            }
        }
        if (ph + 1 < args.ph_hi) { if (args.ph_hi > 4096) grid.sync(); grid_bar((unsigned*)(args.ws + WS_CTL), (unsigned)(ph - args.ph_lo + 1)); }
    }
}

extern "C" void kernel_launch(void* const* d_in, const int* in_sizes, int n_in, void* d_out, int out_size, void* d_ws, size_t ws_size, hipStream_t stream) {
    static int grid = 0;
    if (grid == 0) {
        if (n_in != 29 || ws_size < WS_NEED) { fprintf(stderr, "kernel_launch: unexpected n_in %d / ws %zu\n", n_in, ws_size); grid = -1; return; }
        int dev = 0, cus = 0, per_cu = 0;
        (void)hipGetDevice(&dev); (void)hipDeviceGetAttribute(&cus, hipDeviceAttributeMultiprocessorCount, dev);
        (void)hipFuncSetAttribute((const void*)fwd_mega, hipFuncAttributeMaxDynamicSharedMemorySize, LDS_BYTES);
        (void)hipOccupancyMaxActiveBlocksPerMultiprocessor(&per_cu, (const void*)fwd_mega, 512, LDS_BYTES);
        (void)hipGetLastError();
        if (per_cu < 1) per_cu = 1;
        grid = cus;
    }
    if (grid < 0) return;
    (void)hipMemsetAsync((char*)d_ws + WS_CTL, 0, 16384, stream);
    Args a{};
    for (int i = 0; i < 29; ++i) a.in[i] = (const float*)d_in[i];
    a.out = (float*)d_out; a.ws = (unsigned char*)d_ws;
#if MK_ONE_LAUNCH
    a.ph_lo = 0; a.ph_hi = NPH;
    void* kargs[] = {&a};
    hipError_t e = hipLaunchCooperativeKernel((const void*)fwd_mega, dim3(grid), dim3(512), kargs, LDS_BYTES, stream);
    if (e != hipSuccess) fprintf(stderr, "cooperative launch failed: %s (grid %d)\n", hipGetErrorString(e), grid);
#else
    for (int ph = 0; ph < NPH; ++ph) { a.ph_lo = ph; a.ph_hi = ph + 1; hipLaunchKernelGGL(fwd_mega, dim3(grid), dim3(512), LDS_BYTES, stream, a); }
#endif
}
```
